# Optimizing an MI355X kernel written in HIP

```python
import math
import jax, jax.numpy as jnp
from jax import lax
import numpy as np

D_MODEL = 4096
BATCH = 2
SEQ = 8192
DEPTH = 2

HEAD_DIM = 128
D_MIX = D_MODEL
GROUP_WIDTH = D_MIX // 4
SC_KERNEL = 3
SC_GROUPS = GROUP_WIDTH // HEAD_DIM
DIFF_HEADS = GROUP_WIDTH // (2 * HEAD_DIM)
DN_HEADS = GROUP_WIDTH // HEAD_DIM
DN_CONV = 4
DN_CHUNK = 64
FOX_HEADS = GROUP_WIDTH // HEAD_DIM
BLOCK_Q = 128
D_FF = ((8 * D_MODEL // 3 + 255) // 256) * 256
FFN_KERNEL = 3
EPS = 1e-6
IN_WIDTHS = (
    GROUP_WIDTH, GROUP_WIDTH, GROUP_WIDTH,
    GROUP_WIDTH, GROUP_WIDTH, GROUP_WIDTH,
    GROUP_WIDTH, GROUP_WIDTH, GROUP_WIDTH, GROUP_WIDTH,
    DN_HEADS, DN_HEADS,
    GROUP_WIDTH, GROUP_WIDTH, GROUP_WIDTH,
    FOX_HEADS,
)
D_IN = sum(IN_WIDTHS)

kernel_name = "hybrid_parallel_groups_trunk"


def rms_norm(x, g):
    xf = x.astype(jnp.float32)
    y = xf * lax.rsqrt(jnp.mean(xf * xf, axis=-1, keepdims=True) + EPS)
    return (y * g.astype(jnp.float32)).astype(x.dtype)


def l2_norm(x):
    return x * lax.rsqrt(jnp.sum(x * x, axis=-1, keepdims=True) + EPS)


def causal_dwconv(x, w):
    K = w.shape[0]
    T = x.shape[1]
    xp = jnp.pad(x, ((0, 0), (K - 1, 0), (0, 0)))
    w = w.astype(x.dtype)
    return sum(xp[:, j:j + T] * w[j] for j in range(K))


def split_columns(p):
    offsets = np.cumsum(np.array(IN_WIDTHS))[:-1].tolist()
    return jnp.split(p, offsets, axis=-1)


def diff_attention(q, k, v, lam, lam_init, norm_g):
    B, T, _ = q.shape
    H, d = DIFF_HEADS, HEAD_DIM
    nb = T // BLOCK_Q
    q = q.reshape(B, T, H, 2, d)
    k = k.reshape(B, T, H, 2, d)
    v = v.reshape(B, T, H, 2 * d)
    qb = q.reshape(B, nb, BLOCK_Q, H, 2, d).transpose(1, 0, 2, 3, 4, 5)
    scale = d ** -0.5
    kpos = jnp.arange(T)

    def block(args):
        qi, i = args
        s = jnp.einsum('bqhmd,bkhmd->bhmqk', qi, k).astype(jnp.float32) * scale
        qpos = i * BLOCK_Q + jnp.arange(BLOCK_Q)
        causal = kpos[None, :] <= qpos[:, None]
        p = jax.nn.softmax(jnp.where(causal, s, -jnp.inf), axis=-1)
        wts = p[:, :, 0] - lam * p[:, :, 1]
        return jnp.einsum('bhqk,bkhe->bqhe', wts.astype(v.dtype), v)

    o = lax.map(block, (qb, jnp.arange(nb)))
    o = o.transpose(1, 0, 2, 3, 4).reshape(B, T, H, 2 * d)
    o = rms_norm(o, norm_g) * (1.0 - lam_init)
    return o.reshape(B, T, H * 2 * d)


def forgetting_attention(q, k, v, f_logit):
    B, T, _ = q.shape
    H, d = FOX_HEADS, HEAD_DIM
    nb = T // BLOCK_Q
    q = q.reshape(B, T, H, d)
    k = k.reshape(B, T, H, d)
    v = v.reshape(B, T, H, d)
    cum = jnp.cumsum(jax.nn.log_sigmoid(f_logit.astype(jnp.float32)), axis=1)
    cum_k = cum.transpose(0, 2, 1)
    qb = q.reshape(B, nb, BLOCK_Q, H, d).transpose(1, 0, 2, 3, 4)
    cb = cum.reshape(B, nb, BLOCK_Q, H).transpose(1, 0, 3, 2)
    scale = d ** -0.5
    kpos = jnp.arange(T)

    def block(args):
        qi, ci, i = args
        s = jnp.einsum('bqhd,bkhd->bhqk', qi, k).astype(jnp.float32) * scale
        s = s + ci[..., :, None] - cum_k[:, :, None, :]
        qpos = i * BLOCK_Q + jnp.arange(BLOCK_Q)
        causal = kpos[None, :] <= qpos[:, None]
        p = jax.nn.softmax(jnp.where(causal, s, -jnp.inf), axis=-1)
        return jnp.einsum('bhqk,bkhd->bqhd', p.astype(v.dtype), v)

    o = lax.map(block, (qb, cb, jnp.arange(nb)))
    return o.transpose(1, 0, 2, 3, 4).reshape(B, T, H * d)


def chunk_gated_delta_rule(q, k, v, g, beta):
    B, T, H, dk = q.shape
    dv = v.shape[-1]
    C = DN_CHUNK
    N = T // C
    f32 = jnp.float32

    def to_chunks(t):
        return t.astype(f32).transpose(0, 2, 1, 3).reshape(B, H, N, C, t.shape[-1])

    q, k, v = to_chunks(q), to_chunks(k), to_chunks(v)
    g = g.astype(f32).transpose(0, 2, 1).reshape(B, H, N, C)
    beta = beta.astype(f32).transpose(0, 2, 1).reshape(B, H, N, C)
    q = q * dk ** -0.5
    gc = jnp.cumsum(g, axis=-1)
    idx = jnp.arange(C)
    incl = idx[:, None] >= idx[None, :]
    strict = idx[:, None] > idx[None, :]
    decay = jnp.exp(jnp.where(incl, gc[..., :, None] - gc[..., None, :], -jnp.inf))
    kb = k * beta[..., None]
    a = jnp.where(strict, jnp.einsum('bhnid,bhnjd->bhnij', kb, k) * decay, 0.0)
    tmat = a + jnp.eye(C, dtype=f32)

    def solve(rhs):
        return lax.linalg.triangular_solve(tmat, rhs, left_side=True, lower=True, unit_diagonal=True)

    w = solve(kb * jnp.exp(gc)[..., None])
    u = solve(v * beta[..., None])
    aqk = jnp.where(incl, jnp.einsum('bhnid,bhnjd->bhnij', q, k) * decay, 0.0)
    xs = tuple(jnp.moveaxis(t, 2, 0) for t in (q, k, u, w, gc, aqk))

    def step(S, inp):
        qi, ki, ui, wi, gi, ai = inp
        v_new = ui - jnp.einsum('bhck,bhkv->bhcv', wi, S)
        o = jnp.einsum('bhck,bhkv->bhcv', qi * jnp.exp(gi)[..., None], S) + jnp.einsum('bhcs,bhsv->bhcv', ai, v_new)
        g_last = gi[..., -1]
        k_dec = ki * jnp.exp(g_last[..., None] - gi)[..., None]
        S = S * jnp.exp(g_last)[..., None, None] + jnp.einsum('bhck,bhcv->bhkv', k_dec, v_new)
        return S, o

    S0 = jnp.zeros((B, H, dk, dv), f32)
    _, o = lax.scan(step, S0, xs)
    return jnp.moveaxis(o, 0, 2).reshape(B, H, T, dv).transpose(0, 2, 1, 3)


def gated_deltanet(q, k, v, z, a_in, b_in, conv_w, a_log, dt_bias, norm_g):
    B, T, _ = q.shape
    H, d = DN_HEADS, HEAD_DIM
    qkv = jax.nn.silu(causal_dwconv(jnp.concatenate([q, k, v], axis=-1), conv_w))
    q, k, v = jnp.split(qkv, 3, axis=-1)
    q = l2_norm(q.reshape(B, T, H, d).astype(jnp.float32))
    k = l2_norm(k.reshape(B, T, H, d).astype(jnp.float32))
    v = v.reshape(B, T, H, d)
    g = -jnp.exp(a_log.astype(jnp.float32)) * jax.nn.softplus(a_in.astype(jnp.float32) + dt_bias.astype(jnp.float32))
    beta = jax.nn.sigmoid(b_in.astype(jnp.float32))
    o = chunk_gated_delta_rule(q, k, v, g, beta)
    o = rms_norm(o, norm_g) * jax.nn.silu(z.reshape(B, T, H, d).astype(jnp.float32))
    return o.reshape(B, T, H * d).astype(z.dtype)


def hybrid_layer(x, layer, attn_norm, w_in, sc_conv, lam_q1, lam_k1, lam_q2, lam_k2, diff_norm,
                 dn_conv, dn_a_log, dn_dt_bias, dn_norm, fox_bias, w_out,
                 ffn_norm, w_gate, w_up, ffn_conv, w_down):
    h = rms_norm(x, attn_norm)
    p = h @ w_in
    (sc_h, sc_c, sc_b, df_q, df_k, df_v, dn_q, dn_k, dn_v, dn_z, dn_a, dn_b,
     fx_q, fx_k, fx_v, fx_f) = split_columns(p)
    y_sc = sc_b * causal_dwconv(sc_c * sc_h, sc_conv)
    lam_init = 0.8 - 0.6 * math.exp(-0.3 * layer)
    lam = (jnp.exp(jnp.sum(lam_q1.astype(jnp.float32) * lam_k1.astype(jnp.float32)))
           - jnp.exp(jnp.sum(lam_q2.astype(jnp.float32) * lam_k2.astype(jnp.float32))) + lam_init)
    y_df = diff_attention(df_q, df_k, df_v, lam, lam_init, diff_norm)
    y_dn = gated_deltanet(dn_q, dn_k, dn_v, dn_z, dn_a, dn_b, dn_conv, dn_a_log, dn_dt_bias, dn_norm)
    y_fx = forgetting_attention(fx_q, fx_k, fx_v, fx_f + fox_bias)
    y = jnp.concatenate([y_sc, y_df, y_dn, y_fx], axis=-1) @ w_out
    x = x + y
    h = rms_norm(x, ffn_norm)
    a = causal_dwconv(h @ w_gate, ffn_conv)
    x = x + (jax.nn.silu(a) * (h @ w_up)) @ w_down
    return x


def setup_inputs(seed: int = 0) -> dict:
    key = jax.random.key(seed)
    ks = jax.random.split(key, 24)
    f32 = jnp.float32
    L = DEPTH

    def normal(k, shape, scale):
        return jax.random.normal(k, shape, f32) * scale

    def gain(k, shape):
        return 1.0 + 0.02 * jax.random.normal(k, shape, f32)

    dt = jnp.exp(jax.random.uniform(ks[12], (L, DN_HEADS), f32, math.log(1e-3), math.log(1e-1)))
    return {
        "x": jax.random.normal(ks[0], (BATCH, SEQ, D_MODEL), f32),
        "attn_norm": gain(ks[1], (L, D_MODEL)),
        "w_in": normal(ks[2], (L, D_MODEL, D_IN), D_MODEL ** -0.5),
        "sc_conv": normal(ks[3], (L, SC_KERNEL, GROUP_WIDTH), SC_KERNEL ** -0.5),
        "lam_q1": normal(ks[4], (L, HEAD_DIM), 0.1),
        "lam_k1": normal(ks[5], (L, HEAD_DIM), 0.1),
        "lam_q2": normal(ks[6], (L, HEAD_DIM), 0.1),
        "lam_k2": normal(ks[7], (L, HEAD_DIM), 0.1),
        "diff_norm": gain(ks[8], (L, 2 * HEAD_DIM)),
        "dn_conv": normal(ks[9], (L, DN_CONV, 3 * GROUP_WIDTH), DN_CONV ** -0.5),
        "dn_a_log": jnp.log(jax.random.uniform(ks[10], (L, DN_HEADS), f32, 1.0, 16.0)),
        "dn_dt_bias": dt + jnp.log(-jnp.expm1(-dt)),
        "dn_norm": gain(ks[11], (L, HEAD_DIM)),
        "fox_bias": 2.0 + 0.1 * jax.random.normal(ks[13], (L, FOX_HEADS), f32),
        "w_out": normal(ks[14], (L, D_MIX, D_MODEL), D_MIX ** -0.5),
        "ffn_norm": gain(ks[15], (L, D_MODEL)),
        "w_gate": normal(ks[16], (L, D_MODEL, D_FF), D_MODEL ** -0.5),
        "w_up": normal(ks[17], (L, D_MODEL, D_FF), D_MODEL ** -0.5),
        "ffn_conv": normal(ks[18], (L, FFN_KERNEL, D_FF), FFN_KERNEL ** -0.5),
        "w_down": normal(ks[19], (L, D_FF, D_MODEL), D_FF ** -0.5),
        "final_norm": gain(ks[20], (D_MODEL,)),
    }


def reference(x, attn_norm, w_in, sc_conv, lam_q1, lam_k1, lam_q2, lam_k2, diff_norm,
              dn_conv, dn_a_log, dn_dt_bias, dn_norm, fox_bias, w_out,
              ffn_norm, w_gate, w_up, ffn_conv, w_down, final_norm):
    for l in range(DEPTH):
        x = hybrid_layer(x, l, attn_norm[l], w_in[l], sc_conv[l], lam_q1[l], lam_k1[l], lam_q2[l], lam_k2[l],
                         diff_norm[l], dn_conv[l], dn_a_log[l], dn_dt_bias[l], dn_norm[l], fox_bias[l], w_out[l],
                         ffn_norm[l], w_gate[l], w_up[l], ffn_conv[l], w_down[l])
    return rms_norm(x, final_norm)
```

```cpp
#include <hip/hip_runtime.h>
#include <cstdio>
#include <cstdint>
constexpr int NB = 2, T = 8192, M = NB * T, DM = 4096, DFF = 11008, NLAYER = 2;
constexpr int DIN_SRC = 13336;
constexpr int NSLAB = 104;
constexpr int DIN_PAD = 13568;
constexpr float EPS = 1e-6f;
namespace pg8 {
#define PG8_LAS __attribute__((address_space(3)))
typedef unsigned short bf16_t;
typedef short bf16x8 __attribute__((ext_vector_type(8)));
typedef float f32x4 __attribute__((ext_vector_type(4)));
typedef unsigned u32x4 __attribute__((ext_vector_type(4)));
constexpr int BM = 256, BK = 64, HALF = 128, HTB = HALF * BK * 2  , STAGE_BYTES = 8 * HTB, NXCD = 8, WGM = 8;

__host__ __device__ __forceinline__ int lds_byte(int r, int c) { const int st = (r >> 4) * 2 + (c >> 5), rr = r & 15, cc = c & 31, ob = rr * 64 + cc * 2; return st * 1024 + (ob ^ (((ob >> 9) & 1) << 5)); }
__host__ __device__ __forceinline__ void stage_rc(int b, int& R, int& C) { const int st = b / 1024, sb = b % 1024, swz = sb ^ (((sb >> 9) & 1) << 5); R = (st >> 1) * 16 + swz / 64; C = (st & 1) * 32 + (swz % 64) / 2; }
__host__ __device__ __forceinline__ int perm32(int rho) { const int n = rho >> 4, i = rho & 15; return 8 * (i >> 2) + 4 * n + (i & 3); }

struct Unit { int pm, pn; };
struct Gemm { const bf16_t* A; const bf16_t* Bt; int M, N, K; };

struct StaticOrder {
    int nM, nN, nwg, G, c;
    __host__ __device__ void init(int M, int N, int G_, int c_) { nM = M / BM; nN = N / BM; nwg = nM * nN; G = G_; c = c_; }
    __host__ __device__ bool next(int i, Unit& u) const {
        const long L = (long)i * G + c; if (L >= nwg) return false;
        int wgid = (int)L; { const int q = nwg / NXCD, r = nwg % NXCD, xcd = wgid % NXCD, off = wgid / NXCD; wgid = (xcd < r ? xcd * (q + 1) : r * (q + 1) + (xcd - r) * q) + off; }
        const int nig = WGM * nN, gid = wgid / nig, fm = gid * WGM, gsz = (nM - fm) < WGM ? (nM - fm) : WGM;
        u.pm = fm + ((wgid % nig) % gsz); u.pn = (wgid % nig) / gsz; return true;
    }
    __device__ __forceinline__ void a_ready(const Unit&) const {}
    __device__ __forceinline__ void done(const Unit&) const {}
};

__device__ __forceinline__ unsigned cvt_pk_bf16(float lo, float hi) { unsigned r; asm volatile("v_cvt_pk_bf16_f32 %0, %1, %2" : "=v"(r) : "v"(lo), "v"(hi)); return r; }
__device__ __forceinline__ float bf_lo(unsigned w) { return __uint_as_float(w << 16); }
__device__ __forceinline__ float bf_hi(unsigned w) { return __uint_as_float(w & 0xffff0000u); }

struct EpiSlab {
    static constexpr bool PERM = true, AFTER_DRAIN = false;
    bf16_t* P; float* psmall;
    __device__ __forceinline__ void operator()(const f32x4 (&acc)[2][2][4][2], const Unit& u, int wr, int wc, int fr, int fq) const {
        const int row0 = u.pm * BM + wr * 64 + fr;
        if (u.pn < 52) {
#pragma unroll
            for (int ai = 0; ai < 2; ++ai)
#pragma unroll
                for (int m = 0; m < 4; ++m) { const int row = row0 + ai * HALF + m * 16;
#pragma unroll
                    for (int bj = 0; bj < 2; ++bj) { const f32x4 v0 = acc[ai][bj][m][0], v1 = acc[ai][bj][m][1];
                        u32x4 w; w.x = cvt_pk_bf16(v0[0], v0[1]); w.y = cvt_pk_bf16(v0[2], v0[3]); w.z = cvt_pk_bf16(v1[0], v1[1]); w.w = cvt_pk_bf16(v1[2], v1[3]);
                        *(u32x4*)(P + ((size_t)(2 * u.pn + bj) * M + row) * 128 + wc * 32 + 8 * fq) = w; } }
        } else if (wc == 0) {
#pragma unroll
            for (int ai = 0; ai < 2; ++ai)
#pragma unroll
                for (int m = 0; m < 4; ++m) { float* rp = psmall + (size_t)(row0 + ai * HALF + m * 16) * 32 + 8 * fq;
                    *(f32x4*)(rp) = acc[ai][0][m][0]; *(f32x4*)(rp + 4) = acc[ai][0][m][1]; }
        }
    }
};
struct EpiPlain {
    static constexpr bool PERM = true, AFTER_DRAIN = false;
    bf16_t* O; int ldc;
    __device__ __forceinline__ void operator()(const f32x4 (&acc)[2][2][4][2], const Unit& u, int wr, int wc, int fr, int fq) const {
        const int row0 = u.pm * BM + wr * 64 + fr, col0 = u.pn * BM + wc * 32 + 8 * fq;
#pragma unroll
        for (int ai = 0; ai < 2; ++ai)
#pragma unroll
            for (int m = 0; m < 4; ++m) { bf16_t* rowp = O + (size_t)(row0 + ai * HALF + m * 16) * ldc + col0;
#pragma unroll
                for (int bj = 0; bj < 2; ++bj) { const f32x4 v0 = acc[ai][bj][m][0], v1 = acc[ai][bj][m][1];
                    u32x4 w; w.x = cvt_pk_bf16(v0[0], v0[1]); w.y = cvt_pk_bf16(v0[2], v0[3]); w.z = cvt_pk_bf16(v1[0], v1[1]); w.w = cvt_pk_bf16(v1[2], v1[3]);
                    *(u32x4*)(rowp + bj * HALF) = w; } }
    }
};
struct EpiAct {
    static constexpr bool PERM = true, AFTER_DRAIN = false;
    const bf16_t* G; const float* cw; bf16_t* O;
    __device__ __forceinline__ void operator()(const f32x4 (&acc)[2][2][4][2], const Unit& u, int wr, int wc, int fr, int fq) const {
        const int row0 = u.pm * BM + wr * 64 + fr, col0 = u.pn * BM + wc * 32 + 8 * fq;
#pragma unroll
        for (int bj = 0; bj < 2; ++bj) {
            const int col = col0 + bj * HALF;
            const f32x4 w0a = *(const f32x4*)(cw + col), w0b = *(const f32x4*)(cw + col + 4);
            const f32x4 w1a = *(const f32x4*)(cw + DFF + col), w1b = *(const f32x4*)(cw + DFF + col + 4);
            const f32x4 w2a = *(const f32x4*)(cw + 2 * DFF + col), w2b = *(const f32x4*)(cw + 2 * DFF + col + 4);
#pragma unroll
            for (int ai = 0; ai < 2; ++ai)
#pragma unroll
                for (int m = 0; m < 4; ++m) {
                    const int row = row0 + ai * HALF + m * 16, t = row & (T - 1);
                    const bf16_t* gp = G + (size_t)row * DFF + col;
                    const u32x4 g2 = *(const u32x4*)gp;
                    u32x4 g1 = {0u, 0u, 0u, 0u}, g0 = {0u, 0u, 0u, 0u};
                    if (t >= 1) g1 = *(const u32x4*)(gp - DFF);
                    if (t >= 2) g0 = *(const u32x4*)(gp - 2 * DFF);
                    float a[8];
#pragma unroll
                    for (int q = 0; q < 4; ++q) {
                        const float wl0 = q < 2 ? w0a[2 * q] : w0b[2 * q - 4], wh0 = q < 2 ? w0a[2 * q + 1] : w0b[2 * q - 3];
                        const float wl1 = q < 2 ? w1a[2 * q] : w1b[2 * q - 4], wh1 = q < 2 ? w1a[2 * q + 1] : w1b[2 * q - 3];
                        const float wl2 = q < 2 ? w2a[2 * q] : w2b[2 * q - 4], wh2 = q < 2 ? w2a[2 * q + 1] : w2b[2 * q - 3];
                        a[2 * q]     = wl0 * bf_lo(g0[q]) + wl1 * bf_lo(g1[q]) + wl2 * bf_lo(g2[q]);
                        a[2 * q + 1] = wh0 * bf_hi(g0[q]) + wh1 * bf_hi(g1[q]) + wh2 * bf_hi(g2[q]);
                    }
                    const f32x4 v0 = acc[ai][bj][m][0], v1 = acc[ai][bj][m][1];
                    float o[8];
#pragma unroll
                    for (int i = 0; i < 8; ++i) { const float up = i < 4 ? v0[i] : v1[i - 4]; o[i] = a[i] * __builtin_amdgcn_rcpf(1.0f + __expf(-a[i])) * up; }
                    u32x4 w; w.x = cvt_pk_bf16(o[0], o[1]); w.y = cvt_pk_bf16(o[2], o[3]); w.z = cvt_pk_bf16(o[4], o[5]); w.w = cvt_pk_bf16(o[6], o[7]);
                    *(u32x4*)(O + (size_t)row * DFF + col) = w;
                }
        }
    }
};
struct EpiResid {
    static constexpr bool PERM = false, AFTER_DRAIN = false;
    const float* base; float* out;
    __device__ __forceinline__ void operator()(const f32x4 (&acc)[2][2][4][2], const Unit& u, int wr, int wc, int fr, int fq) const {
        const int row0 = u.pm * BM + wr * 64 + fr, col0 = u.pn * BM + wc * 32 + 4 * fq;
#pragma unroll
        for (int ai = 0; ai < 2; ++ai)
#pragma unroll
            for (int m = 0; m < 4; ++m) { const size_t off = (size_t)(row0 + ai * HALF + m * 16) * DM + col0;
                f32x4 b[2][2];
#pragma unroll
                for (int bj = 0; bj < 2; ++bj)
#pragma unroll
                    for (int n = 0; n < 2; ++n) b[bj][n] = *(const f32x4*)(base + off + bj * HALF + n * 16);
#pragma unroll
                for (int bj = 0; bj < 2; ++bj)
#pragma unroll
                    for (int n = 0; n < 2; ++n) *(f32x4*)(out + off + bj * HALF + n * 16) = b[bj][n] + acc[ai][bj][m][n];
                asm volatile("" ::: "memory"); }
    }
};

template <class Epi, class Sched, bool ALIGN_EPI = false, bool SP2 = false>
__device__ __forceinline__ void gemm_phase(PG8_LAS unsigned char* lds, const Gemm g, const Sched& S, const Epi& E) {
    int tid = threadIdx.x; asm volatile("" : "+v"(tid));
    const int wid = __builtin_amdgcn_readfirstlane(tid >> 6), lane = tid & 63, wr = wid >> 2, wc = wid & 3, fr = lane & 15, fq = lane >> 4;
    const int K = g.K, nt = K / BK;
    unsigned voffA[2], voffB[2];
#pragma unroll
    for (int i = 0; i < 2; ++i) { int R, C; stage_rc(tid * 16 + i * 8192, R, C); const int Rb = Epi::PERM ? ((R & ~31) + perm32(R & 31)) : R;
        voffA[i] = (unsigned)(R * K + C) * 2u; voffB[i] = (unsigned)(Rb * K + C) * 2u; }
    const size_t kstep = (size_t)(BK * 2);
    const size_t hstep = (size_t)HALF * K * 2;
    const size_t tstep = 2 * hstep;
    const unsigned ldsw = (unsigned)wid * 1024u;
    const int aoff = lds_byte(wr * 64 + fr, fq * 8), boff = lds_byte(wc * 32 + fr, fq * 8);
#define PG8_SA(b, h) (((b) * 2 + (h)) * HTB)
#define PG8_SB(b, h) ((4 + (b) * 2 + (h)) * HTB)
#define PG8_STAGE(bufoff, gbase, voff) do { _Pragma("unroll") for (int _i = 0; _i < 2; ++_i) \
        __builtin_amdgcn_global_load_lds((const unsigned*)((const char*)(gbase) + (voff)[_i]), (PG8_LAS unsigned*)(lds + (bufoff) + ldsw + _i * 8192), 16, 0, 0); } while (0)
#define PG8_LDA(dst, b, h) do { _Pragma("unroll") for (int m = 0; m < 4; ++m) _Pragma("unroll") for (int k = 0; k < 2; ++k) dst[m][k] = *(const PG8_LAS bf16x8*)(lds + PG8_SA(b, h) + aoff + m * 2048 + k * 1024); } while (0)
#define PG8_LDB(dst, b, h) do { _Pragma("unroll") for (int n = 0; n < 2; ++n) _Pragma("unroll") for (int k = 0; k < 2; ++k) dst[n][k] = *(const PG8_LAS bf16x8*)(lds + PG8_SB(b, h) + boff + n * 2048 + k * 1024); } while (0)
#define PG8_MMA(ai, bj, At, Bt) do { __builtin_amdgcn_s_setprio(1); _Pragma("unroll") for (int m = 0; m < 4; ++m) _Pragma("unroll") for (int n = 0; n < 2; ++n) _Pragma("unroll") for (int k = 0; k < 2; ++k) \
        acc[ai][bj][m][n] = __builtin_amdgcn_mfma_f32_16x16x32_bf16(Bt[n][k], At[m][k], acc[ai][bj][m][n], 0, 0, 0); __builtin_amdgcn_s_setprio(0); } while (0)
#define PG8_WAIT_V(n) asm volatile("s_waitcnt vmcnt(" #n ")" ::: "memory")
#define PG8_WAIT_L(n) asm volatile("s_waitcnt lgkmcnt(" #n ")" ::: "memory")
#define PG8_BAR __builtin_amdgcn_s_barrier()
#define PG8_SCHED __builtin_amdgcn_sched_barrier(0)
    Unit cur, nxt; int ui = 0;
    if (!S.next(0, cur)) return;
    f32x4 acc[2][2][4][2];
#pragma unroll
    for (int a = 0; a < 2; ++a)
#pragma unroll
        for (int b = 0; b < 2; ++b)
#pragma unroll
            for (int m = 0; m < 4; ++m)
#pragma unroll
                for (int n = 0; n < 2; ++n) acc[a][b][m][n] = (f32x4){0.f, 0.f, 0.f, 0.f};
    bf16x8 At[4][2], B0[2][2], B1[2][2];
    const char* cA = (const char*)g.A + (size_t)cur.pm * tstep; const char* cB = (const char*)g.Bt + (size_t)cur.pn * tstep;
    S.a_ready(cur);
    if constexpr (SP2) {
        PG8_STAGE(PG8_SB(0, 0), cB, voffB); PG8_STAGE(PG8_SB(0, 1), cB + hstep, voffB); PG8_STAGE(PG8_SA(0, 0), cA, voffA); PG8_STAGE(PG8_SA(0, 1), cA + hstep, voffA);
        if (wr == 1) PG8_BAR;
        PG8_WAIT_V(2); PG8_BAR;
        PG8_STAGE(PG8_SB(1, 0), cB + kstep, voffB); PG8_STAGE(PG8_SA(1, 0), cA + kstep, voffA); PG8_STAGE(PG8_SB(1, 1), cB + hstep + kstep, voffB);
        PG8_WAIT_V(6); PG8_BAR;
    } else {
        PG8_STAGE(PG8_SB(0, 0), cB, voffB); PG8_STAGE(PG8_SA(0, 0), cA, voffA); PG8_STAGE(PG8_SB(0, 1), cB + hstep, voffB); PG8_STAGE(PG8_SA(0, 1), cA + hstep, voffA);
        if (wr == 1) PG8_BAR;
        PG8_WAIT_V(4); PG8_BAR;
        PG8_STAGE(PG8_SB(1, 0), cB + kstep, voffB); PG8_STAGE(PG8_SA(1, 0), cA + kstep, voffA); PG8_STAGE(PG8_SB(1, 1), cB + hstep + kstep, voffB);
        PG8_WAIT_V(6); PG8_BAR;
    }
    for (;;) {
        const bool has_next = S.next(ui + 1, nxt);
        const char* nA = has_next ? (const char*)g.A + (size_t)nxt.pm * tstep : cA; const char* nB = has_next ? (const char*)g.Bt + (size_t)nxt.pn * tstep : cB;
        for (int t = 0; t < nt; t += 2) {
            const bool last = (t == nt - 2);
            const char* a1 = cA + (size_t)(t + 1) * kstep;
            const char* a2 = last ? nA : cA + (size_t)(t + 2) * kstep; const char* b2 = last ? nB : cB + (size_t)(t + 2) * kstep;
            const char* a3 = a2 + kstep; const char* b3 = b2 + kstep;
            if (last && has_next) S.a_ready(nxt);
            if constexpr (SP2) {
            PG8_LDB(B0, 0, 0); PG8_LDB(B1, 0, 1); PG8_SCHED; PG8_LDA(At, 0, 0); PG8_STAGE(PG8_SA(1, 1), a1 + hstep, voffA);
            PG8_WAIT_V(8); PG8_WAIT_L(0); PG8_BAR; PG8_MMA(0, 0, At, B0); PG8_MMA(0, 1, At, B1); PG8_BAR; PG8_SCHED;
            PG8_LDA(At, 0, 1); PG8_STAGE(PG8_SB(0, 0), b2, voffB); PG8_STAGE(PG8_SB(0, 1), b2 + hstep, voffB); PG8_STAGE(PG8_SA(0, 0), a2, voffA);
            PG8_WAIT_V(8); PG8_WAIT_L(0); PG8_BAR; PG8_MMA(1, 0, At, B0); PG8_MMA(1, 1, At, B1); PG8_BAR; PG8_SCHED;
            PG8_LDB(B0, 1, 0); PG8_LDB(B1, 1, 1); PG8_SCHED; PG8_LDA(At, 1, 0); PG8_STAGE(PG8_SA(0, 1), a2 + hstep, voffA);
            PG8_WAIT_V(8); PG8_WAIT_L(0); PG8_BAR; PG8_MMA(0, 0, At, B0); PG8_MMA(0, 1, At, B1); PG8_BAR; PG8_SCHED;
            PG8_LDA(At, 1, 1); PG8_STAGE(PG8_SB(1, 0), b3, voffB); PG8_STAGE(PG8_SB(1, 1), b3 + hstep, voffB); PG8_STAGE(PG8_SA(1, 0), a3, voffA);
            PG8_WAIT_V(8); PG8_WAIT_L(0); PG8_BAR; PG8_MMA(1, 0, At, B0); PG8_MMA(1, 1, At, B1); PG8_BAR; PG8_SCHED;
            } else {
            PG8_LDB(B0, 0, 0); PG8_SCHED; PG8_LDA(At, 0, 0); PG8_STAGE(PG8_SA(1, 1), a1 + hstep, voffA);
            PG8_WAIT_L(8); PG8_BAR; PG8_WAIT_L(0); PG8_MMA(0, 0, At, B0); PG8_BAR; PG8_SCHED;
            PG8_LDB(B1, 0, 1); PG8_STAGE(PG8_SB(0, 0), b2, voffB);
            PG8_BAR; PG8_WAIT_L(0); PG8_MMA(0, 1, At, B1); PG8_BAR;
            PG8_LDA(At, 0, 1); PG8_STAGE(PG8_SA(0, 0), a2, voffA);
            PG8_BAR; PG8_WAIT_L(0); PG8_MMA(1, 0, At, B0); PG8_BAR; PG8_SCHED;
            PG8_STAGE(PG8_SB(0, 1), b2 + hstep, voffB);
            PG8_WAIT_V(6); PG8_BAR; PG8_MMA(1, 1, At, B1); PG8_BAR;
            PG8_LDB(B0, 1, 0); PG8_SCHED; PG8_LDA(At, 1, 0); PG8_STAGE(PG8_SA(0, 1), a2 + hstep, voffA);
            PG8_WAIT_L(8); PG8_BAR; PG8_WAIT_L(0); PG8_MMA(0, 0, At, B0); PG8_BAR; PG8_SCHED;
            PG8_LDB(B1, 1, 1); PG8_STAGE(PG8_SB(1, 0), b3, voffB);
            PG8_BAR; PG8_WAIT_L(0); PG8_MMA(0, 1, At, B1); PG8_BAR;
            PG8_LDA(At, 1, 1); PG8_STAGE(PG8_SA(1, 0), a3, voffA);
            PG8_BAR; PG8_WAIT_L(0); PG8_MMA(1, 0, At, B0); PG8_BAR; PG8_SCHED;
            PG8_STAGE(PG8_SB(1, 1), b3 + hstep, voffB);
            PG8_WAIT_V(6); PG8_BAR; PG8_MMA(1, 1, At, B1); PG8_BAR;
            }
        }
        if constexpr (ALIGN_EPI) { if (wr == 0) PG8_BAR; }
        if constexpr (!Epi::AFTER_DRAIN) { E(acc, cur, wr, wc, fr, fq); S.done(cur); }
        if (!has_next) break;
#pragma unroll
        for (int a = 0; a < 2; ++a)
#pragma unroll
            for (int b = 0; b < 2; ++b)
#pragma unroll
                for (int m = 0; m < 4; ++m)
#pragma unroll
                    for (int n = 0; n < 2; ++n) acc[a][b][m][n] = (f32x4){0.f, 0.f, 0.f, 0.f};
        cur = nxt; cA = nA; cB = nB; ++ui;
        if constexpr (ALIGN_EPI) { if (wr == 1) PG8_BAR; }
    }
    PG8_WAIT_V(0);
    if constexpr (!ALIGN_EPI) { if (wr == 0) PG8_BAR; }
    PG8_BAR;
    if constexpr (Epi::AFTER_DRAIN) { E.fused(acc, cur, wr, wc, fr, fq, lds, wid, lane); S.done(cur); }
#undef PG8_SA
#undef PG8_SB
#undef PG8_STAGE
#undef PG8_LDA
#undef PG8_LDB
#undef PG8_MMA
#undef PG8_WAIT_V
#undef PG8_WAIT_L
#undef PG8_BAR
#undef PG8_SCHED
}
}
#define GAS __attribute__((address_space(1)))
#define LAS __attribute__((address_space(3)))
typedef unsigned short bf16;
typedef unsigned v4u __attribute__((ext_vector_type(4)));
typedef float f32x4 __attribute__((ext_vector_type(4)));
typedef short bf16x8 __attribute__((ext_vector_type(8)));
typedef GAS unsigned gu32;
typedef GAS unsigned long long gu64;
#define RLX_AGENT __ATOMIC_RELAXED, __HIP_MEMORY_SCOPE_AGENT
#define LDS_WAIT() asm volatile("s_waitcnt lgkmcnt(0)" ::: "memory")
#define VM_WAIT() asm volatile("s_waitcnt vmcnt(0)" ::: "memory")
__device__ __forceinline__ unsigned long long rt() { return __builtin_amdgcn_s_memrealtime(); }
__device__ __forceinline__ unsigned f2bf(float f) { unsigned u = __builtin_bit_cast(unsigned, f); return (u + 0x7fffu + ((u >> 16) & 1u)) >> 16; }
__device__ __forceinline__ unsigned pk2(float lo, float hi) { return f2bf(lo) | (f2bf(hi) << 16); }
#define XB_TMO      128
#define XB_XCNT(j)  (256  + 64 * (j))
#define XB_XSUB(j)  (1280 + 64 * (j))
#define XB_XGEN(j)  (2304 + 64 * (j))
#define XB_TOP      3328
#define XB_TOPGEN   3392
#define XCD_BAR_WORDS 3456
#define XB_SPIN_CAP (1u << 18)

__device__ __forceinline__ unsigned xb_ld(unsigned* p)              { return __hip_atomic_load(p, __ATOMIC_RELAXED, __HIP_MEMORY_SCOPE_AGENT); }
__device__ __forceinline__ unsigned xb_add(unsigned* p, unsigned v) { return __hip_atomic_fetch_add(p, v, __ATOMIC_RELAXED, __HIP_MEMORY_SCOPE_AGENT); }
__device__ __forceinline__ unsigned xb_xcc_id() { return (unsigned)__builtin_amdgcn_s_getreg((3 << 11) | 20) & 0xFu; }
#define XB_SPIN(cond, bar) do { unsigned _sp = 0; while (cond) { __builtin_amdgcn_s_sleep(1); \
    if ((++_sp & 255u) == 0u) { if (xb_ld(&(bar)[XB_TMO])) break; if (_sp > XB_SPIN_CAP) { atomicAdd(&(bar)[XB_TMO], 1u); break; } } } } while (0)

struct XcdBarrier {
    unsigned* bar; unsigned x;
    volatile LAS unsigned* st;
};

__device__ __forceinline__ XcdBarrier xcd_barrier_post(unsigned* bar, volatile LAS unsigned* st) {
    XcdBarrier b; b.bar = bar; b.x = xb_xcc_id(); b.st = st;
    if (threadIdx.x == 0) (void)xb_add(&bar[XB_XCNT(b.x)], 1u);
    return b;
}
__device__ __forceinline__ void xcd_barrier_complete(unsigned* bar, unsigned x, unsigned& nloc, unsigned& nx) {
    const unsigned G = gridDim.x * gridDim.y * gridDim.z;
    unsigned sum, cnt, mine, sp = 0u;
    for (;;) {
        sum = 0u; cnt = 0u; mine = 0u;
#pragma unroll
        for (unsigned j = 0; j < 16; ++j) { const unsigned c = xb_ld(&bar[XB_XCNT(j)]); sum += c; cnt += (c > 0u) ? 1u : 0u; mine = (j == x) ? c : mine; }
        if (sum == G) break;
        __builtin_amdgcn_s_sleep(1);
        if ((++sp & 255u) == 0u) { if (xb_ld(&bar[XB_TMO])) break; if (sp > XB_SPIN_CAP) { atomicAdd(&bar[XB_TMO], 1u); break; } }
    }
    nloc = mine > 0u ? mine : 1u; nx = cnt > 0u ? cnt : 1u;
}

__device__ __forceinline__ void xcd_barrier(const XcdBarrier& b) {
    asm volatile("s_waitcnt vmcnt(0)" ::: "memory");
    __syncthreads();
    if (threadIdx.x == 0) {
        unsigned* bar = b.bar;
        __builtin_amdgcn_s_waitcnt(0);
        unsigned nloc = b.st[0], nx = b.st[1];
        if (nloc == 0u) { xcd_barrier_complete(bar, b.x, nloc, nx); b.st[0] = nloc; b.st[1] = nx; }
        const unsigned old = xb_add(&bar[XB_XSUB(b.x)], 1u);
        const unsigned gen = old / nloc;
        if (old + 1u == (gen + 1u) * nloc) {
            __builtin_amdgcn_fence(__ATOMIC_RELEASE, "agent");
            asm volatile("s_waitcnt vmcnt(0)" ::: "memory");
            const unsigned og = xb_add(&bar[XB_TOP], 1u);
            const unsigned tg = og / nx;
            if (og + 1u == (tg + 1u) * nx) xb_add(&bar[XB_TOPGEN], 1u);
            else XB_SPIN(xb_ld(&bar[XB_TOPGEN]) == tg, bar);
            __builtin_amdgcn_fence(__ATOMIC_ACQUIRE, "agent");
            xb_add(&bar[XB_XGEN(b.x)], 1u);
            asm volatile("s_waitcnt vmcnt(0)" ::: "memory");
        } else {
            XB_SPIN(xb_ld(&bar[XB_XGEN(b.x)]) == gen, bar);
            __builtin_amdgcn_fence(__ATOMIC_ACQUIRE, "agent");
            asm volatile("s_waitcnt vmcnt(0)" ::: "memory");
        }
    }
    __syncthreads();
}
namespace att {
typedef unsigned short bf16_t;
typedef short bf16x8 __attribute__((ext_vector_type(8)));
typedef short s16x4 __attribute__((ext_vector_type(4)));
typedef float f32x16 __attribute__((ext_vector_type(16)));
typedef float f32x4 __attribute__((ext_vector_type(4)));
typedef unsigned u32x4 __attribute__((ext_vector_type(4)));
constexpr int D = 128, NW = 8, QBLK = 32, KVBLK = 64, QB = NW * QBLK;
constexpr int SHM_V = KVBLK * D * 2, SHM_K = KVBLK * D * 2;
constexpr int OFF_WS = 2 * SHM_V + 2 * SHM_K, OFF_BIAS = OFF_WS + NW * 64 * 4, OFF_Q = OFF_BIAS + 2 * 64 * 4, ATT_LDS_BYTES = OFF_Q + NW * 8192;
#ifndef NQREG
#define NQREG 2
#endif
constexpr float SCALE = 0.08838834764831845f, INV_SCALE = 11.313708498984761f, THR = 8.f;
constexpr int WIN = 1 << 30;

#define KSWZ(row, colB) ((row) * 256 + ((colB) ^ (((row) & 7) << 4)))
#define SBAR() __builtin_amdgcn_sched_barrier(0)
__device__ __forceinline__ int v_st(int k, int c) { const int kk = (k & ~0xC) | ((k & 4) << 1) | ((k & 8) >> 1); return ((kk >> 3) * 4 + (c >> 5)) * 512 + ((kk & 7) * 32 + (c & 31)) * 2; }
__device__ __forceinline__ int v_rd_base(int lane) { return ((lane & 3) << 3) | (((lane >> 2) & 3) << 6) | (((lane >> 4) & 1) << 5) | (((lane >> 5) & 1) << 8); }
constexpr int v_rd_off(int d0, int ks, int half) { return d0 * 512 + ks * 4096 + half * 2048; }
__device__ __forceinline__ int crow(int r, int hi) { return (r & 3) + 8 * (r >> 2) + 4 * hi; }
__device__ __forceinline__ unsigned cvtpk(float lo, float hi) { unsigned r; asm volatile("v_cvt_pk_bf16_f32 %0, %1, %2" : "=v"(r) : "v"(lo), "v"(hi)); return r; }
__device__ __forceinline__ bf16x8 load8(const bf16_t* p) { return *reinterpret_cast<const bf16x8*>(p); }
__device__ __forceinline__ void mask_tile(f32x16& p0, f32x16& p1, int dq) {
    const float NEG = -__builtin_inff();
#pragma unroll
    for (int r = 0; r < 16; ++r) {
        const int c = (r & 3) + 8 * (r >> 2);
        if ((unsigned)(dq - c) >= (unsigned)WIN) p0[r] = NEG;
        if ((unsigned)(dq - c - 32) >= (unsigned)WIN) p1[r] = NEG;
    }
}
__device__ __forceinline__ void add_bias(f32x16& p0, f32x16& p1, const float* bl, int hi) {
#pragma unroll
    for (int g = 0; g < 4; ++g) { const f32x4 a = *(const f32x4*)(bl + 8 * g + 4 * hi), b = *(const f32x4*)(bl + 32 + 8 * g + 4 * hi);
#pragma unroll
        for (int i = 0; i < 4; ++i) { p0[4 * g + i] += a[i]; p1[4 * g + i] += b[i]; }
        asm volatile("" ::: "memory"); }
}
__device__ __forceinline__ void partialSM(f32x16& p0, f32x16& p1, float& m_reg, float& mn, float& alpha) {
    float pmax = p0[0]; for (int r = 1; r < 16; ++r) pmax = fmaxf(pmax, p0[r]); for (int r = 0; r < 16; ++r) pmax = fmaxf(pmax, p1[r]);
    { auto rr = __builtin_amdgcn_permlane32_swap(__float_as_uint(pmax), __float_as_uint(pmax), false, false);
      pmax = fmaxf(__uint_as_float(rr[0]), __uint_as_float(rr[1])); }
    constexpr float C2 = 1.4426950408889634f * SCALE;
    if (__builtin_expect(__all((pmax - m_reg) * SCALE <= THR), 1)) { mn = m_reg; alpha = 1.f; }
    else { mn = fmaxf(m_reg, pmax); alpha = __builtin_amdgcn_exp2f((m_reg - mn) * C2); m_reg = mn; }
    const float mnL = -mn * C2;
    for (int r = 0; r < 16; ++r) p0[r] = fmaf(p0[r], C2, mnL); for (int r = 0; r < 16; ++r) p1[r] = fmaf(p1[r], C2, mnL);
    for (int r = 0; r < 16; ++r) p0[r] = __builtin_amdgcn_exp2f(p0[r]);
}
__device__ __forceinline__ void finishSM(f32x16& p0, f32x16& p1, float alpha, float& l_reg, bf16x8& pa0, bf16x8& pa1, bf16x8& pa2, bf16x8& pa3) {
    for (int r = 0; r < 16; ++r) p1[r] = __builtin_amdgcn_exp2f(p1[r]);
    float ps = 0; for (int r = 0; r < 16; ++r) ps += p0[r]; for (int r = 0; r < 16; ++r) ps += p1[r];
    { auto rr = __builtin_amdgcn_permlane32_swap(__float_as_uint(ps), __float_as_uint(ps), false, false);
      ps = __uint_as_float(rr[0]) + __uint_as_float(rr[1]); }
    l_reg = l_reg * alpha + ps;
#define PK4(P, B_, OUT) do { unsigned a0 = cvtpk(P[B_+0], P[B_+1]), a1 = cvtpk(P[B_+2], P[B_+3]);                          \
        unsigned b0 = cvtpk(P[B_+4], P[B_+5]), b1 = cvtpk(P[B_+6], P[B_+7]);                                             \
        auto r0 = __builtin_amdgcn_permlane32_swap(a0, b0, false, false); auto r1 = __builtin_amdgcn_permlane32_swap(a1, b1, false, false); \
        u32x4 w = {r0[0], r1[0], r0[1], r1[1]}; OUT = *reinterpret_cast<bf16x8*>(&w); } while (0)
    PK4(p0, 0, pa0); PK4(p0, 8, pa1); PK4(p1, 0, pa2); PK4(p1, 8, pa3);
#undef PK4
}
template <int KB>
__device__ __forceinline__ void qkt(f32x16& p0, f32x16& p1, const char* K_lds, int r32, int hi, const bf16x8* qr, const char* qw) {
    p0 = f32x16{}; p1 = f32x16{};
    const char* kb[4];
#pragma unroll
    for (int dd = 0; dd < 4; ++dd) kb[dd] = K_lds + KB * SHM_K + KSWZ(r32, (dd * 16 + hi * 8) * 2);
#pragma unroll
    for (int d0 = 0; d0 < 8; ++d0) { const char* a = kb[d0 & 3] + (d0 >> 2) * 128;
        bf16x8 b0 = *reinterpret_cast<const bf16x8*>(a);
        bf16x8 b1 = *reinterpret_cast<const bf16x8*>(a + 32 * 256);
        bf16x8 qf; if (d0 < NQREG) qf = qr[d0]; else qf = *reinterpret_cast<const bf16x8*>(qw + d0 * 1024);
        p0 = __builtin_amdgcn_mfma_f32_32x32x16_bf16(b0, qf, p0, 0, 0, 0);
        p1 = __builtin_amdgcn_mfma_f32_32x32x16_bf16(b1, qf, p1, 0, 0, 0); }
}
template <int VB>
__device__ __forceinline__ void pv_tile(f32x16* o, int vb0, bf16x8 pa0, bf16x8 pa1, bf16x8 pa2, bf16x8 pa3) {
#define TRRD(dst, off) asm volatile("ds_read_b64_tr_b16 %0, %1 offset:%2" : "=&v"(dst) : "v"(vb0), "i"(off) : "memory")
#define PV_D0(d0) do { s16x4 l0, l1, l2, l3, h0, h1, h2, h3; constexpr int b_ = VB * SHM_V + v_rd_off(d0, 0, 0); \
        TRRD(l0, b_); TRRD(h0, b_ + 2048); TRRD(l1, b_ + 4096); TRRD(h1, b_ + 6144); TRRD(l2, b_ + 8192); TRRD(h2, b_ + 10240); TRRD(l3, b_ + 12288); TRRD(h3, b_ + 14336); \
        asm volatile("s_waitcnt lgkmcnt(0)" ::: "memory"); SBAR();   \
        o[d0] = __builtin_amdgcn_mfma_f32_32x32x16_bf16(pa0, (bf16x8){l0[0], l0[1], l0[2], l0[3], h0[0], h0[1], h0[2], h0[3]}, o[d0], 0, 0, 0);   \
        o[d0] = __builtin_amdgcn_mfma_f32_32x32x16_bf16(pa1, (bf16x8){l1[0], l1[1], l1[2], l1[3], h1[0], h1[1], h1[2], h1[3]}, o[d0], 0, 0, 0);   \
        o[d0] = __builtin_amdgcn_mfma_f32_32x32x16_bf16(pa2, (bf16x8){l2[0], l2[1], l2[2], l2[3], h2[0], h2[1], h2[2], h2[3]}, o[d0], 0, 0, 0);   \
        o[d0] = __builtin_amdgcn_mfma_f32_32x32x16_bf16(pa3, (bf16x8){l3[0], l3[1], l3[2], l3[3], h3[0], h3[1], h3[2], h3[3]}, o[d0], 0, 0, 0); } while (0)
    PV_D0(0); PV_D0(1); PV_D0(2); PV_D0(3);
#undef PV_D0
#undef TRRD
}
struct BlockRef { const bf16_t* Q; const bf16_t* K; const bf16_t* V; float* O; const float* cum; int P0; };
struct Seam { bf16x8 qr[8]; bf16x8 st_v0, st_v1, st_k0, st_k1; float st_b; };
#define ROW(p, k0, rr) ((p) + (size_t)((k0) + (rr)) * D + sc)
#define VMW() asm volatile("s_waitcnt vmcnt(0)" ::: "memory")
#define VMWN(n) asm volatile("s_waitcnt vmcnt(%0)" :: "i"(n) : "memory")
#define SLOAD_H(Kp, Vp, Cp, k0) do { S.st_v0 = load8(ROW(Vp, k0, sr)); S.st_v1 = load8(ROW(Vp, k0, 32 + sr));              \
                         S.st_k0 = load8(ROW(Kp, k0, sr)); S.st_k1 = load8(ROW(Kp, k0, 32 + sr)); if ((Cp) != nullptr && tid < 64) S.st_b = (Cp)[(k0) + tid]; } while (0)
#define SWRITE_HK(bf, Cp) do { *(bf16x8*)(K_lds + (bf) * SHM_K + kws) = S.st_k0; *(bf16x8*)(K_lds + (bf) * SHM_K + kws + 32 * 256) = S.st_k1; \
                         if ((Cp) != nullptr && tid < 64) bias_l[(bf) * 64 + tid] = -S.st_b * INV_SCALE; } while (0)
#define SWRITE_HV(bf) do { *(bf16x8*)(V_lds + (bf) * SHM_V + vst0) = S.st_v0; *(bf16x8*)(V_lds + (bf) * SHM_V + vst1) = S.st_v1; } while (0)
#define SWRITE_H(bf, Cp) do { SWRITE_HV(bf); SWRITE_HK(bf, Cp); } while (0)
__device__ __forceinline__ void attn_prime(const BlockRef& cur, char* lds, Seam& S, const int tid) {
    const int wid = __builtin_amdgcn_readfirstlane(tid >> 6), lane = tid & 63, r32 = lane & 31, hi = lane >> 5;
    const int sr = tid >> 4, sc = (tid & 15) * 8, kws = KSWZ(sr, sc * 2); char* K_lds = lds + 2 * SHM_V; float* bias_l = (float*)(lds + OFF_BIAS);
    for (int d0 = 0; d0 < 8; ++d0) S.qr[d0] = load8(cur.Q + (size_t)(wid * QBLK + r32) * D + d0 * 16 + hi * 8);
    SLOAD_H(cur.K, cur.V, cur.cum, 0); VMW(); SWRITE_HK(0, cur.cum);
    __syncthreads();
}
__device__ __forceinline__ void attn_block(const BlockRef& cur, const BlockRef& nxt, char* lds, Seam& S, const int tid) {
    const int wid = __builtin_amdgcn_readfirstlane(tid >> 6), lane = tid & 63, r32 = lane & 31, hi = lane >> 5;
    const int NT = (cur.P0 + QB) / KVBLK;
    const int qlo = cur.P0 + wid * QBLK, qm = qlo + r32 - 4 * hi;
    char* V_lds = lds; char* K_lds = lds + 2 * SHM_V; float* bias_l = (float*)(lds + OFF_BIAS);
    float* ws = (float*)(lds + OFF_WS) + wid * 64; float* li_l = ws, * al_l = ws + 32;
    float m_reg = -1e30f, l_reg = 0; f32x16 o[4] = {};
    const int sr = tid >> 4, sc = (tid & 15) * 8, vst0 = v_st(sr, sc), vst1 = v_st(32 + sr, sc), kws = KSWZ(sr, sc * 2);
    const int vb0 = (int)(uintptr_t)V_lds + v_rd_base(lane);
    const bf16_t* Kh = cur.K; const bf16_t* Vh = cur.V; const float* Ch = cur.cum;
#define RESC(a) do { if (__any((a) < 1.f)) { if (hi == 0) al_l[r32] = (a); asm volatile("s_waitcnt lgkmcnt(0)" ::: "memory");              \
                     for (int d_ = 0; d_ < 4; ++d_) for (int r = 0; r < 16; ++r) o[d_][r] *= al_l[crow(r, hi)]; } } while (0)
#define KBASE(t) ((t) * KVBLK)
#define MASKT(P0_, P1_, t) do { const int kb_ = KBASE(t); if (kb_ + KVBLK - 1 > qlo) mask_tile(P0_, P1_, qm - kb_); } while (0)
#define BIAST(P0_, P1_, bf) do { if (Ch != nullptr) add_bias(P0_, P1_, bias_l + (bf) * 64, hi); } while (0)
    constexpr int NQL = 8;
#define SEAM_K0() do { VMWN(NQL); SWRITE_HK(0, nxt.cum); SBAR(); } while (0)
    f32x16 pA0, pA1, pB0, pB1; float mnA, mnB, alA, alB; bf16x8 pa0, pa1, pa2, pa3;
    char* qw = lds + OFF_Q + wid * 8192 + lane * 16;
#pragma unroll
    for (int d0 = NQREG; d0 < 8; ++d0) *reinterpret_cast<bf16x8*>(qw + d0 * 1024) = S.qr[d0];
    SWRITE_HV(0); SBAR();
    if (NT > 1) SLOAD_H(Kh, Vh, Ch, KBASE(1));
    SBAR(); qkt<0>(pA0, pA1, K_lds, r32, hi, S.qr, qw);
    BIAST(pA0, pA1, 0); MASKT(pA0, pA1, 0); partialSM(pA0, pA1, m_reg, mnA, alA);
    if (NT > 1) { VMW(); SWRITE_H(1, Ch); }
    __syncthreads();
#define HALF_STEP(PX0, PX1, mnX, alX, PY0, PY1, alY, t, KB, VB, SB) do {                                                      \
        SBAR(); qkt<KB>(PX0, PX1, K_lds, r32, hi, S.qr, qw);                                                         \
        finishSM(PY0, PY1, alY, l_reg, pa0, pa1, pa2, pa3); SBAR();                                                           \
        if ((t) + 1 < NT) { SLOAD_H(Kh, Vh, Ch, KBASE((t) + 1)); SBAR(); }                                                    \
        pv_tile<VB>(o, vb0, pa0, pa1, pa2, pa3); BIAST(PX0, PX1, KB); MASKT(PX0, PX1, (t)); partialSM(PX0, PX1, m_reg, mnX, alX); \
        __syncthreads();                                                                                                      \
        if ((t) + 1 < NT) { VMW(); SWRITE_H(SB, Ch); }                                                                        \
        RESC(alX); __syncthreads(); } while (0)
    for (int t = 1; t + 1 < NT; t += 2) {
        HALF_STEP(pB0, pB1, mnB, alB, pA0, pA1, alA, t, 1, 0, 0);
        HALF_STEP(pA0, pA1, mnA, alA, pB0, pB1, alB, t + 1, 0, 1, 1);
    }
    const bool even = (NT & 1) == 0;
    if (even) { SBAR(); qkt<1>(pB0, pB1, K_lds, r32, hi, S.qr, qw); SBAR(); }
    SLOAD_H(nxt.K, nxt.V, nxt.cum, 0); SBAR();
#pragma unroll
    for (int d0 = 0; d0 < 8; ++d0) S.qr[d0] = load8(nxt.Q + (size_t)(wid * QBLK + r32) * D + d0 * 16 + hi * 8);
    SBAR();
    finishSM(pA0, pA1, alA, l_reg, pa0, pa1, pa2, pa3); SBAR();
    pv_tile<0>(o, vb0, pa0, pa1, pa2, pa3);
    if (even) { BIAST(pB0, pB1, 1); MASKT(pB0, pB1, NT - 1); partialSM(pB0, pB1, m_reg, mnB, alB); __syncthreads(); RESC(alB);
        finishSM(pB0, pB1, alB, l_reg, pa0, pa1, pa2, pa3); SBAR(); pv_tile<1>(o, vb0, pa0, pa1, pa2, pa3); }
    SBAR(); SEAM_K0();
    if (hi == 0) li_l[r32] = l_reg; asm volatile("s_waitcnt lgkmcnt(0)" ::: "memory");
    float rli[16];
#pragma unroll
    for (int r = 0; r < 16; ++r) rli[r] = __builtin_amdgcn_rcpf(li_l[crow(r, hi)]);
    float* Ow = cur.O + (size_t)(wid * QBLK) * D;
#pragma unroll
    for (int r = 0; r < 16; ++r) { const int orow = crow(r, hi);
#pragma unroll
        for (int d0 = 0; d0 < 4; ++d0) Ow[(size_t)orow * D + d0 * 32 + r32] = o[d0][r] * rli[r]; }
    __syncthreads();
#undef RESC
#undef KBASE
#undef MASKT
#undef BIAST
#undef SEAM_K0
#undef HALF_STEP
}
#undef ROW
#undef VMW
#undef VMWN
#undef SLOAD_H
#undef SWRITE_HK
#undef SWRITE_HV
#undef SWRITE_H
}

constexpr size_t MiB = 1u << 20;
constexpr size_t WS_CTL = 0, CTL_ZERO_BYTES = 1 * MiB;
constexpr size_t SZ_WIN = (size_t)DIN_PAD * DM * 2, SZ_WOUT = (size_t)DM * DM * 2, SZ_WFF = (size_t)DFF * DM * 2;
constexpr size_t WS_WIN = 1 * MiB, WS_WOUT = WS_WIN + SZ_WIN, WS_WG = WS_WOUT + SZ_WOUT, WS_WU = WS_WG + SZ_WFF, WS_WD = WS_WU + SZ_WFF;
constexpr size_t WS_H = WS_WD + SZ_WFF;
constexpr size_t WS_P = WS_H + (size_t)M * DM * 2;
constexpr size_t SZ_P = (size_t)NSLAB * M * 128 * 2;
constexpr size_t WS_PS = WS_P + SZ_P;
constexpr size_t WS_Y = WS_PS + (size_t)M * 32 * 4;
constexpr size_t WS_X = WS_Y + (size_t)M * DM * 2;
constexpr size_t WS_OB = WS_X;
constexpr size_t WS_DQ = WS_OB + (size_t)24 * M * 128 * 4;
constexpr size_t WS_DK = WS_DQ + (size_t)16 * T * 128 * 4;
constexpr size_t WS_DV = WS_DK + (size_t)16 * T * 128 * 4;
constexpr size_t WS_DO = WS_DV + (size_t)16 * T * 128 * 4;
constexpr size_t WS_DG = WS_DO + (size_t)M * 8 * 128 * 4;
constexpr size_t WS_DB = WS_DG + (size_t)16 * T * 4;
constexpr size_t WS_CUM = WS_DB + (size_t)16 * T * 4;
constexpr size_t WS_XEND = WS_CUM + (size_t)16 * T * 4;
constexpr size_t WS_END = WS_XEND;
static_assert(SZ_P >= (size_t)M * DFF * 2, "gate overlays P");
static_assert(WS_XEND - WS_X >= (size_t)M * DFF * 2, "act overlays region X");
static_assert(WS_WIN % 256 == 0 && WS_H % 256 == 0 && WS_P % 256 == 0 && WS_Y % 256 == 0 && WS_X % 256 == 0, "alignment");
constexpr int CW_BAR = 4096;
constexpr int LDS_BYTES = 147456, MISC_OFF = LDS_BYTES - 512;
constexpr int NWAVES = 8;
typedef unsigned short bf16_t;
typedef unsigned u32x4 __attribute__((ext_vector_type(4)));
typedef unsigned u32x2 __attribute__((ext_vector_type(2)));
typedef float f32x2 __attribute__((ext_vector_type(2)));

struct Args { const float* in[21]; float* out; unsigned char* ws; int ph_lo, ph_hi; };
#define CAS __attribute__((address_space(4)))
typedef const CAS Args* ArgP;
enum { I_X = 0, I_ATTN_NORM, I_W_IN, I_SC_CONV, I_LQ1, I_LK1, I_LQ2, I_LK2, I_DIFF_NORM, I_DN_CONV, I_DN_ALOG, I_DN_DTB, I_DN_NORM, I_FOX_BIAS, I_W_OUT, I_FFN_NORM, I_W_GATE, I_W_UP, I_FFN_CONV, I_W_DOWN, I_FINAL_NORM };

__device__ __forceinline__ float wave_sum(float v) {
#pragma unroll
    for (int o = 1; o < 64; o <<= 1) v += __shfl_xor(v, o);
    return v;
}
__device__ __forceinline__ float silu_f(float x) { return x / (1.0f + __expf(-x)); }
__device__ __forceinline__ unsigned pkbf(float lo, float hi) { return pg8::cvt_pk_bf16(lo, hi); }

__host__ __device__ __forceinline__ int win_src(int n) {
    if (n < 10240) return n;
    if (n < 13312) return n + 16;
    const int j = n - 13312;
    if (j < 16) return 10240 + j;
    if (j < 24) return 13328 + (j - 16);
    return -1;
}
template <bool REMAP>
__device__ __forceinline__ void transpose_item(const float* W, int Nsrc, int K, bf16_t* WT, LAS float* scr, int kb, int nb, int lane) {
    const int k0 = 64 * kb, n0 = 64 * nb;
    const int nl = 4 * (lane & 15), kr = lane >> 4;
    int sc = n0 + nl; if (REMAP) sc = win_src(n0 + nl);
#pragma unroll 4
    for (int i = 0; i < 16; ++i) { const int kk = 4 * i + kr;
        f32x4 v = {0.f, 0.f, 0.f, 0.f};
        if (sc >= 0) v = *(const f32x4*)(W + (size_t)(k0 + kk) * Nsrc + sc);
        scr[kk * 65 + nl + 0] = v[0]; scr[kk * 65 + nl + 1] = v[1]; scr[kk * 65 + nl + 2] = v[2]; scr[kk * 65 + nl + 3] = v[3]; }
    LDS_WAIT(); asm volatile("" ::: "memory");
    const int kc = lane & 7, nn = lane >> 3;
#pragma unroll
    for (int j = 0; j < 8; ++j) { const int n = nn + 8 * j; const LAS float* s = scr + (8 * kc) * 65 + n;
        u32x4 o; o.x = pkbf(s[0 * 65], s[1 * 65]); o.y = pkbf(s[2 * 65], s[3 * 65]); o.z = pkbf(s[4 * 65], s[5 * 65]); o.w = pkbf(s[6 * 65], s[7 * 65]);
        *(u32x4*)(WT + (size_t)(n0 + n) * K + k0 + 8 * kc) = o; }
    LDS_WAIT(); asm volatile("" ::: "memory");
}
__device__ __forceinline__ void phase_convert(ArgP A, int l, LAS unsigned char* lds, int gw, int NGW, int wave, int lane) {
    LAS float* scr = (LAS float*)(lds + wave * 16640);
    unsigned char* ws = A->ws;
    const float* w_in = A->in[I_W_IN] + (size_t)l * DM * DIN_SRC; const float* w_out = A->in[I_W_OUT] + (size_t)l * DM * DM;
    const float* w_g = A->in[I_W_GATE] + (size_t)l * DM * DFF; const float* w_u = A->in[I_W_UP] + (size_t)l * DM * DFF; const float* w_d = A->in[I_W_DOWN] + (size_t)l * DFF * DM;
    constexpr int NI_IN = (DM / 64) * (DIN_PAD / 64), NI_OUT = (DM / 64) * (DM / 64), NI_FF = (DM / 64) * (DFF / 64);
    constexpr int NITEMS = NI_IN + NI_OUT + 3 * NI_FF;
    for (int it = gw; it < NITEMS; it += NGW) {
        int r = it;
        if (r < NI_IN) { transpose_item<true>(w_in, DIN_SRC, DM, (bf16_t*)(ws + WS_WIN), scr, r / (DIN_PAD / 64), r % (DIN_PAD / 64), lane); continue; } r -= NI_IN;
        if (r < NI_OUT) { transpose_item<false>(w_out, DM, DM, (bf16_t*)(ws + WS_WOUT), scr, r / (DM / 64), r % (DM / 64), lane); continue; } r -= NI_OUT;
        if (r < NI_FF) { transpose_item<false>(w_g, DFF, DM, (bf16_t*)(ws + WS_WG), scr, r / (DFF / 64), r % (DFF / 64), lane); continue; } r -= NI_FF;
        if (r < NI_FF) { transpose_item<false>(w_u, DFF, DM, (bf16_t*)(ws + WS_WU), scr, r / (DFF / 64), r % (DFF / 64), lane); continue; } r -= NI_FF;
        transpose_item<false>(w_d, DM, DFF, (bf16_t*)(ws + WS_WD), scr, r / (DM / 64), r % (DM / 64), lane);
    }
}
__device__ __forceinline__ void phase_norm(const float* x, const float* g, bf16_t* h, int gw, int NGW, int lane) {
    f32x4 gv[16];
#pragma unroll
    for (int j = 0; j < 16; ++j) gv[j] = *((const f32x4*)g + lane + 64 * j);
    for (int m = gw; m < M; m += NGW) {
        const f32x4* xr = (const f32x4*)(x + (size_t)m * DM) + lane;
        f32x4 v[16]; float s = 0.f;
#pragma unroll
        for (int j = 0; j < 16; ++j) { v[j] = xr[64 * j]; s += (v[j][0] * v[j][0] + v[j][1] * v[j][1]) + (v[j][2] * v[j][2] + v[j][3] * v[j][3]); }
        const float rs = rsqrtf(wave_sum(s) * (1.0f / DM) + EPS);
        u32x2* o = (u32x2*)(h + (size_t)m * DM) + lane;
#pragma unroll
        for (int j = 0; j < 16; ++j) { u32x2 w; w.x = pkbf(v[j][0] * rs * gv[j][0], v[j][1] * rs * gv[j][1]); w.y = pkbf(v[j][2] * rs * gv[j][2], v[j][3] * rs * gv[j][3]); o[64 * j] = w; }
    }
}
__device__ __forceinline__ void phase_final_norm(float* x, const float* g, int gw, int NGW, int lane) {
    f32x4 gv[16];
#pragma unroll
    for (int j = 0; j < 16; ++j) gv[j] = *((const f32x4*)g + lane + 64 * j);
    for (int m = gw; m < M; m += NGW) {
        f32x4* xr = (f32x4*)(x + (size_t)m * DM) + lane;
        f32x4 v[16]; float s = 0.f;
#pragma unroll
        for (int j = 0; j < 16; ++j) { v[j] = xr[64 * j]; s += (v[j][0] * v[j][0] + v[j][1] * v[j][1]) + (v[j][2] * v[j][2] + v[j][3] * v[j][3]); }
        const float rs = rsqrtf(wave_sum(s) * (1.0f / DM) + EPS);
#pragma unroll
        for (int j = 0; j < 16; ++j) xr[64 * j] = v[j] * rs * gv[j];
    }
}
__device__ __forceinline__ void unpack8(const u32x4 w, float* f) {
#pragma unroll
    for (int q = 0; q < 4; ++q) { f[2 * q] = pg8::bf_lo(w[q]); f[2 * q + 1] = pg8::bf_hi(w[q]); }
}
__device__ __forceinline__ void phase_prep(ArgP A, int l, int gtid, int NGT, int gw, int NGW, int lane) {
    unsigned char* ws = A->ws;
    const bf16_t* P = (const bf16_t*)(ws + WS_P); const float* PS = (const float*)(ws + WS_PS); bf16_t* Y = (bf16_t*)(ws + WS_Y);
    { const float* cw = A->in[I_SC_CONV] + (size_t)l * 3 * 1024;
      for (int it = gtid; it < M * 128; it += NGT) {
          const int m = it >> 7, c8 = (it & 127) * 8, slab = c8 >> 7, cc = c8 & 127, t = m & (T - 1);
          float acc[8] = {0.f, 0.f, 0.f, 0.f, 0.f, 0.f, 0.f, 0.f};
#pragma unroll
          for (int j = 0; j < 3; ++j) { const int dt = 2 - j;
              if (t >= dt) { float hh[8], cx[8];
                  unpack8(*(const u32x4*)(P + ((size_t)(0 + slab) * M + (m - dt)) * 128 + cc), hh);
                  unpack8(*(const u32x4*)(P + ((size_t)(8 + slab) * M + (m - dt)) * 128 + cc), cx);
                  const f32x4 wa = *(const f32x4*)(cw + j * 1024 + c8), wb = *(const f32x4*)(cw + j * 1024 + c8 + 4);
#pragma unroll
                  for (int i = 0; i < 8; ++i) acc[i] += (i < 4 ? wa[i] : wb[i - 4]) * (hh[i] * cx[i]); } }
          float bb[8]; unpack8(*(const u32x4*)(P + ((size_t)(16 + slab) * M + m) * 128 + cc), bb);
          u32x4 w; w.x = pkbf(bb[0] * acc[0], bb[1] * acc[1]); w.y = pkbf(bb[2] * acc[2], bb[3] * acc[3]); w.z = pkbf(bb[4] * acc[4], bb[5] * acc[5]); w.w = pkbf(bb[6] * acc[6], bb[7] * acc[7]);
          *(u32x4*)(Y + (size_t)m * DM + c8) = w; } }
    { const float* cw = A->in[I_DN_CONV] + (size_t)l * 4 * 3072; const float* alog = A->in[I_DN_ALOG] + l * 8; const float* dtb = A->in[I_DN_DTB] + l * 8;
      float* DQ = (float*)(ws + WS_DQ); float* DK = (float*)(ws + WS_DK); float* DV = (float*)(ws + WS_DV); float* DG = (float*)(ws + WS_DG); float* DB = (float*)(ws + WS_DB);
      for (int it = gtid; it < M * 128; it += NGT) {
          const int m = it >> 7, h = (it >> 4) & 7, cc = (it & 15) * 8, t = m & (T - 1), b = m >> 13;
          float r[3][8];
#pragma unroll
          for (int s = 0; s < 3; ++s) {
#pragma unroll
              for (int i = 0; i < 8; ++i) r[s][i] = 0.f;
#pragma unroll
              for (int j = 0; j < 4; ++j) { const int dt = 3 - j;
                  if (t >= dt) { float xx[8]; unpack8(*(const u32x4*)(P + ((size_t)(48 + 8 * s + h) * M + (m - dt)) * 128 + cc), xx);
                      const float* wp = cw + j * 3072 + s * 1024 + h * 128 + cc; const f32x4 wa = *(const f32x4*)wp, wb = *(const f32x4*)(wp + 4);
#pragma unroll
                      for (int i = 0; i < 8; ++i) r[s][i] += (i < 4 ? wa[i] : wb[i - 4]) * xx[i]; } }
#pragma unroll
              for (int i = 0; i < 8; ++i) r[s][i] = silu_f(r[s][i]);
          }
          float sq = 0.f, sk = 0.f;
#pragma unroll
          for (int i = 0; i < 8; ++i) { sq += r[0][i] * r[0][i]; sk += r[1][i] * r[1][i]; }
#pragma unroll
          for (int o = 1; o < 16; o <<= 1) { sq += __shfl_xor(sq, o); sk += __shfl_xor(sk, o); }
          const float rq = rsqrtf(sq + EPS) * 0.08838834764831845f, rk = rsqrtf(sk + EPS);
          const size_t off = ((size_t)(b * 8 + h) * T + t) * 128 + cc;
          *(f32x4*)(DQ + off) = (f32x4){r[0][0] * rq, r[0][1] * rq, r[0][2] * rq, r[0][3] * rq}; *(f32x4*)(DQ + off + 4) = (f32x4){r[0][4] * rq, r[0][5] * rq, r[0][6] * rq, r[0][7] * rq};
          *(f32x4*)(DK + off) = (f32x4){r[1][0] * rk, r[1][1] * rk, r[1][2] * rk, r[1][3] * rk}; *(f32x4*)(DK + off + 4) = (f32x4){r[1][4] * rk, r[1][5] * rk, r[1][6] * rk, r[1][7] * rk};
          *(f32x4*)(DV + off) = (f32x4){r[2][0], r[2][1], r[2][2], r[2][3]}; *(f32x4*)(DV + off + 4) = (f32x4){r[2][4], r[2][5], r[2][6], r[2][7]};
          if ((it & 15) == 0) {
              const float a = PS[(size_t)m * 32 + h] + dtb[h], bi = PS[(size_t)m * 32 + 8 + h];
              const float sp = fmaxf(a, 0.f) + log1pf(expf(-fabsf(a)));
              DG[(size_t)(b * 8 + h) * T + t] = -expf(alog[h]) * sp;
              DB[(size_t)(b * 8 + h) * T + t] = 1.0f / (1.0f + expf(-bi));
          } } }
    { const float* fb = A->in[I_FOX_BIAS] + l * 8; float* CUM = (float*)(ws + WS_CUM);
      if (gw < 16) { const int b = gw >> 3, h = gw & 7; const float bias = fb[h];
          const float* src = PS + (size_t)(b * T + lane * 128) * 32 + 16 + h;
          float tot = 0.f;
          for (int i = 0; i < 128; ++i) { const float x = src[(size_t)i * 32] + bias; tot += fminf(x, 0.f) - log1pf(expf(-fabsf(x))); }
          float incl = tot;
#pragma unroll
          for (int o = 1; o < 64; o <<= 1) { const float u = __shfl_up(incl, o); if (lane >= o) incl += u; }
          float run = incl - tot;
          float* dst = CUM + (size_t)gw * T + lane * 128;
          for (int i = 0; i < 128; ++i) { const float x = src[(size_t)i * 32] + bias; run += fminf(x, 0.f) - log1pf(expf(-fabsf(x))); dst[i] = run; } } }
}
__device__ __forceinline__ att::BlockRef attn_ref(unsigned char* ws, int L, int pass) {
    const int b = L / 384, r = L - b * 384, vh = r >> 4, x = r & 15, qb = pass ? 31 - x : x;
    int sq, sk, sv; const float* cum = nullptr;
    if (vh < 16) { const int h = vh >> 2, mm = (vh >> 1) & 1, e = vh & 1; sq = 24 + 2 * h + mm; sk = 32 + 2 * h + mm; sv = 40 + 2 * h + e; }
    else { const int h = vh - 16; sq = 80 + h; sk = 88 + h; sv = 96 + h; cum = (const float*)(ws + WS_CUM) + (size_t)(b * 8 + h) * T; }
    const bf16_t* P = (const bf16_t*)(ws + WS_P);
    att::BlockRef R;
    R.Q = P + ((size_t)sq * M + (size_t)b * T + (size_t)qb * 256) * 128;
    R.K = P + ((size_t)sk * M + (size_t)b * T) * 128;
    R.V = P + ((size_t)sv * M + (size_t)b * T) * 128;
    R.O = (float*)(ws + WS_OB) + ((size_t)vh * M + (size_t)b * T + (size_t)qb * 256) * 128;
    R.cum = cum; R.P0 = qb * 256;
    return R;
}
__device__ __forceinline__ void phase_attn(unsigned char* ws, char* lds, int G, int bid, const int tid) {
    constexpr int TOTAL = 768;
    int L = bid; if (L >= TOTAL) return;
    int pass = 0;
    att::BlockRef cur = attn_ref(ws, L, 0);
    att::Seam S;
    att::attn_prime(cur, lds, S, tid);
    for (;;) {
        const bool more_pass = pass == 0, more_item = L + G < TOTAL, last = !more_pass && !more_item;
        int passn = pass + 1, Ln = L;
        if (!more_pass) { passn = 0; Ln = more_item ? L + G : L; }
        const att::BlockRef nxt = last ? cur : attn_ref(ws, Ln, passn);
        att::attn_block(cur, nxt, lds, S, tid);
        if (last) break;
        cur = nxt; pass = passn; L = Ln;
    }
}
__device__ __forceinline__ void phase_scan_naive(unsigned char* ws, LAS unsigned char* lds, int bid, int tid) {
    if (bid >= 8) return;
    const int pr = tid >> 8, tt = tid & 255, j = tt >> 1, half = tt & 1, bh = bid * 2 + pr, b = bh >> 3, h = bh & 7;
    LAS float* kq = (LAS float*)(lds + pr * 16896);
    LAS float* lk = kq; LAS float* lq = kq + 2048; LAS float* lg = kq + 4096; LAS float* lb = kq + 4112;
    const float* DQ = (const float*)(ws + WS_DQ) + (size_t)bh * T * 128; const float* DK = (const float*)(ws + WS_DK) + (size_t)bh * T * 128;
    const float* DV = (const float*)(ws + WS_DV) + (size_t)bh * T * 128; const float* DG = (const float*)(ws + WS_DG) + (size_t)bh * T; const float* DB = (const float*)(ws + WS_DB) + (size_t)bh * T;
    float* DO = (float*)(ws + WS_DO);
    float S[64];
#pragma unroll
    for (int i = 0; i < 64; ++i) S[i] = 0.f;
    for (int t0 = 0; t0 < T; t0 += 16) {
        __syncthreads();
#pragma unroll
        for (int i = 0; i < 8; ++i) { const int e = i * 256 + tt; lk[e] = DK[(size_t)t0 * 128 + e]; lq[e] = DQ[(size_t)t0 * 128 + e]; }
        if (tt < 16) { lg[tt] = DG[t0 + tt]; lb[tt] = DB[t0 + tt]; }
        __syncthreads();
        for (int i = 0; i < 16; ++i) {
            const float a = __expf(lg[i]), be = lb[i], v = DV[(size_t)(t0 + i) * 128 + j];
            const LAS f32x4* kp = (const LAS f32x4*)(lk + i * 128 + half * 64); const LAS f32x4* qp = (const LAS f32x4*)(lq + i * 128 + half * 64);
            float u0 = 0.f, u1 = 0.f, u2 = 0.f, u3 = 0.f;
#pragma unroll
            for (int c = 0; c < 16; ++c) { const f32x4 kv = kp[c]; u0 += S[4 * c] * kv[0]; u1 += S[4 * c + 1] * kv[1]; u2 += S[4 * c + 2] * kv[2]; u3 += S[4 * c + 3] * kv[3]; }
            float u = (u0 + u1) + (u2 + u3); u += __shfl_xor(u, 1);
            const float vn = be * (v - a * u);
            float o0 = 0.f, o1 = 0.f, o2 = 0.f, o3 = 0.f;
#pragma unroll
            for (int c = 0; c < 16; ++c) { const f32x4 kv = kp[c]; const f32x4 qv = qp[c];
                S[4 * c] = a * S[4 * c] + kv[0] * vn; S[4 * c + 1] = a * S[4 * c + 1] + kv[1] * vn; S[4 * c + 2] = a * S[4 * c + 2] + kv[2] * vn; S[4 * c + 3] = a * S[4 * c + 3] + kv[3] * vn;
                o0 += S[4 * c] * qv[0]; o1 += S[4 * c + 1] * qv[1]; o2 += S[4 * c + 2] * qv[2]; o3 += S[4 * c + 3] * qv[3]; }
            float o = (o0 + o1) + (o2 + o3); o += __shfl_xor(o, 1);
            if (half == 0) DO[((size_t)(b * T + t0 + i) * 8 + h) * 128 + j] = o;
        }
    }
}
__device__ __forceinline__ void phase_post(ArgP A, int l, int gw, int NGW, int lane) {
    unsigned char* ws = A->ws;
    const float* OB = (const float*)(ws + WS_OB); const float* DO = (const float*)(ws + WS_DO); const bf16_t* P = (const bf16_t*)(ws + WS_P); bf16_t* Y = (bf16_t*)(ws + WS_Y);
    const float lam_init = 0.8f - 0.6f * expf(-0.3f * (float)l);
    float lam;
    { const float* q1 = A->in[I_LQ1] + l * 128; const float* k1 = A->in[I_LK1] + l * 128; const float* q2 = A->in[I_LQ2] + l * 128; const float* k2 = A->in[I_LK2] + l * 128;
      const float d1 = wave_sum(q1[lane] * k1[lane] + q1[lane + 64] * k1[lane + 64]), d2 = wave_sum(q2[lane] * k2[lane] + q2[lane + 64] * k2[lane + 64]);
      lam = expf(d1) - expf(d2) + lam_init; }
    const float* dng = A->in[I_DIFF_NORM] + l * 256; const f32x4 gd = *(const f32x4*)(dng + 4 * lane);
    const float* nng = A->in[I_DN_NORM] + l * 128; const f32x2 gn = *(const f32x2*)(nng + 2 * lane);
    const float post = 1.0f - lam_init;
    for (int m = gw; m < M; m += NGW) {
#pragma unroll
        for (int h = 0; h < 4; ++h) { const int eh = lane >> 5, ec = (4 * lane) & 127;
            const f32x4 o1 = *(const f32x4*)(OB + ((size_t)(4 * h + 0 + eh) * M + m) * 128 + ec), o2 = *(const f32x4*)(OB + ((size_t)(4 * h + 2 + eh) * M + m) * 128 + ec);
            const f32x4 d = o1 - lam * o2;
            const float rs = rsqrtf(wave_sum((d[0] * d[0] + d[1] * d[1]) + (d[2] * d[2] + d[3] * d[3])) * (1.0f / 256.0f) + EPS) * post;
            u32x2 w; w.x = pkbf(d[0] * rs * gd[0], d[1] * rs * gd[1]); w.y = pkbf(d[2] * rs * gd[2], d[3] * rs * gd[3]);
            *(u32x2*)(Y + (size_t)m * DM + 1024 + h * 256 + 4 * lane) = w; }
#pragma unroll
        for (int h = 0; h < 8; ++h) {
            const f32x2 o = *(const f32x2*)(DO + ((size_t)m * 8 + h) * 128 + 2 * lane);
            const float rs = rsqrtf(wave_sum(o[0] * o[0] + o[1] * o[1]) * (1.0f / 128.0f) + EPS);
            const unsigned zz = *(const unsigned*)(P + ((size_t)(72 + h) * M + m) * 128 + 2 * lane);
            const float z0 = pg8::bf_lo(zz), z1 = pg8::bf_hi(zz);
            *(unsigned*)(Y + (size_t)m * DM + 2048 + h * 128 + 2 * lane) = pkbf(o[0] * rs * gn[0] * silu_f(z0), o[1] * rs * gn[1] * silu_f(z1)); }
#pragma unroll
        for (int h = 0; h < 8; ++h) {
            const f32x2 o = *(const f32x2*)(OB + ((size_t)(16 + h) * M + m) * 128 + 2 * lane);
            *(unsigned*)(Y + (size_t)m * DM + 3072 + h * 128 + 2 * lane) = pkbf(o[0], o[1]); }
    }
}

constexpr int PH_PER_LAYER = 11, PH_FINAL = NLAYER * PH_PER_LAYER, PH_TOTAL = PH_FINAL + 1;
__global__ void __launch_bounds__(NWAVES * 64, 2) mega(Args args) {
    extern __shared__ __attribute__((aligned(16))) unsigned char lds[];
    LAS unsigned char* ldsl = (LAS unsigned char*)lds;
    const int G = gridDim.x, bid = blockIdx.x;
    const int NGW = G * NWAVES, NGT = G * NWAVES * 64;
    volatile LAS unsigned* MISC = (volatile LAS unsigned*)(ldsl + MISC_OFF);
    if (threadIdx.x < 32) MISC[threadIdx.x] = 0u;
    __syncthreads();
    const int lo = args.ph_lo, hi = args.ph_hi;
    XcdBarrier bar; bar.bar = (unsigned*)(args.ws + WS_CTL) + CW_BAR; bar.x = 0; bar.st = nullptr;
    if (hi - lo > 1) bar = xcd_barrier_post((unsigned*)(args.ws + WS_CTL) + CW_BAR, MISC + 8);
#ifndef ONLY_J
#define ONLY_J -1
#endif
#define IN(k) (lo <= (k) && (k) < hi)
#define INJ(j) ((ONLY_J < 0 || ONLY_J == (j)) && IN(pb + (j)))
#define SEAM(k) do { if (IN(k) && IN((k) + 1)) xcd_barrier(bar); } while (0)
#define SITE() ArgP A = (ArgP)__builtin_amdgcn_kernarg_segment_ptr(); asm volatile("" : "+s"(A)); unsigned char* ws = A->ws; int tid = threadIdx.x; asm volatile("" : "+v"(tid)); \
    const int lane = tid & 63, wave = __builtin_amdgcn_readfirstlane(tid >> 6), gw = bid * NWAVES + wave, gtid = bid * (NWAVES * 64) + tid; (void)lane; (void)wave; (void)gw; (void)gtid; (void)ws
    for (int l = 0; l < NLAYER; ++l) {
        const int pb = l * PH_PER_LAYER;
        if (INJ(0)) { SITE(); phase_convert(A, l, ldsl, gw, NGW, wave, lane); phase_norm(l == 0 ? A->in[I_X] : A->out, A->in[I_ATTN_NORM] + (size_t)l * DM, (bf16_t*)(ws + WS_H), gw, NGW, lane); }
        SEAM(pb + 0);
        if (INJ(1)) { SITE(); pg8::Gemm g{(const bf16_t*)(ws + WS_H), (const bf16_t*)(ws + WS_WIN), M, DIN_PAD, DM}; pg8::StaticOrder S; S.init(M, DIN_PAD, G, bid);
            pg8::EpiSlab E{(bf16_t*)(ws + WS_P), (float*)(ws + WS_PS)};
            pg8::gemm_phase<pg8::EpiSlab, pg8::StaticOrder, true, true>(ldsl, g, S, E); }
        SEAM(pb + 1);
        if (INJ(2)) { SITE(); phase_prep(A, l, gtid, NGT, gw, NGW, lane); }
        SEAM(pb + 2);
        if (INJ(3)) { SITE(); phase_attn(ws, (char*)lds, G, bid, tid); }
        SEAM(pb + 3);
        if (INJ(4)) { SITE(); phase_scan_naive(ws, ldsl, bid, tid); }
        SEAM(pb + 4);
        if (INJ(5)) { SITE(); phase_post(A, l, gw, NGW, lane); }
        SEAM(pb + 5);
        if (INJ(6)) { SITE(); pg8::Gemm g{(const bf16_t*)(ws + WS_Y), (const bf16_t*)(ws + WS_WOUT), M, DM, DM}; pg8::StaticOrder S; S.init(M, DM, G, bid);
            pg8::EpiResid E{l == 0 ? A->in[I_X] : A->out, A->out};
            pg8::gemm_phase<pg8::EpiResid, pg8::StaticOrder, true, true>(ldsl, g, S, E); }
        SEAM(pb + 6);
        if (INJ(7)) { SITE(); phase_norm(A->out, A->in[I_FFN_NORM] + (size_t)l * DM, (bf16_t*)(ws + WS_H), gw, NGW, lane); }
        SEAM(pb + 7);
        if (INJ(8)) { SITE(); pg8::Gemm g{(const bf16_t*)(ws + WS_H), (const bf16_t*)(ws + WS_WG), M, DFF, DM}; pg8::StaticOrder S; S.init(M, DFF, G, bid);
            pg8::EpiPlain E{(bf16_t*)(ws + WS_P), DFF};
            pg8::gemm_phase<pg8::EpiPlain, pg8::StaticOrder, true, true>(ldsl, g, S, E); }
        SEAM(pb + 8);
        if (INJ(9)) { SITE(); pg8::Gemm g{(const bf16_t*)(ws + WS_H), (const bf16_t*)(ws + WS_WU), M, DFF, DM}; pg8::StaticOrder S; S.init(M, DFF, G, bid);
            pg8::EpiAct E{(const bf16_t*)(ws + WS_P), A->in[I_FFN_CONV] + (size_t)l * 3 * DFF, (bf16_t*)(ws + WS_X)};
            pg8::gemm_phase<pg8::EpiAct, pg8::StaticOrder, true, true>(ldsl, g, S, E); }
        SEAM(pb + 9);
        if (INJ(10)) { SITE(); pg8::Gemm g{(const bf16_t*)(ws + WS_X), (const bf16_t*)(ws + WS_WD), M, DM, DFF}; pg8::StaticOrder S; S.init(M, DM, G, bid);
            pg8::EpiResid E{A->out, A->out};
            pg8::gemm_phase<pg8::EpiResid, pg8::StaticOrder, true, true>(ldsl, g, S, E); }
        SEAM(pb + 10);
    }
    if ((ONLY_J < 0 || ONLY_J == 11) && IN(PH_FINAL)) { SITE(); phase_final_norm(A->out, A->in[I_FINAL_NORM], gw, NGW, lane); }
#undef IN
#undef INJ
#undef SEAM
#undef SITE
}

extern "C" void kernel_launch(void* const* d_in, const int* in_sizes, int n_in, void* d_out, int out_size, void* d_ws, size_t ws_size, hipStream_t stream) {
    static int grid = 0;
    if (grid == 0) {
        if (n_in != 21 || out_size != M * DM || ws_size < WS_END) { fprintf(stderr, "kernel_launch: unexpected arguments (n_in %d, out %d, ws %zu, need %zu)\n", n_in, out_size, ws_size, (size_t)WS_END); grid = -1; return; }
        int dev = 0, cus = 0, per_cu = 0;
        if (hipGetDevice(&dev) != hipSuccess || hipDeviceGetAttribute(&cus, hipDeviceAttributeMultiprocessorCount, dev) != hipSuccess) { grid = -1; return; }
        if (hipFuncSetAttribute((const void*)mega, hipFuncAttributeMaxDynamicSharedMemorySize, LDS_BYTES) != hipSuccess) { fprintf(stderr, "kernel_launch: hipFuncSetAttribute failed\n"); grid = -1; return; }
        if (hipOccupancyMaxActiveBlocksPerMultiprocessor(&per_cu, (const void*)mega, NWAVES * 64, LDS_BYTES) != hipSuccess || per_cu < 1) fprintf(stderr, "kernel_launch: occupancy query reports %d\n", per_cu);
        (void)hipGetLastError();
        grid = cus;
    }
    if (grid < 0) return;
    (void)hipMemsetAsync((char*)d_ws + WS_CTL, 0, CTL_ZERO_BYTES, stream);
    Args a{};
    for (int i = 0; i < 21; ++i) a.in[i] = (const float*)d_in[i];
    a.out = (float*)d_out; a.ws = (unsigned char*)d_ws;
#ifndef N_CUT
#define N_CUT 0
#endif
#if N_CUT == 0
    for (int p = 0; p < PH_TOTAL; ++p) { a.ph_lo = p; a.ph_hi = p + 1; hipLaunchKernelGGL(mega, dim3(grid), dim3(NWAVES * 64), LDS_BYTES, stream, a); }
#else
    a.ph_lo = 0; a.ph_hi = PH_TOTAL; hipLaunchKernelGGL(mega, dim3(grid), dim3(NWAVES * 64), LDS_BYTES, stream, a);
#endif
}
```

```cpp
#include <hip/hip_runtime.h>
#include <cstdio>
#include <cstdint>
constexpr int NB = 2, T = 8192, M = NB * T, DM = 4096, DFF = 11008, NLAYER = 2;
constexpr int DIN_SRC = 13336;
constexpr int NSLAB = 104;
constexpr int DIN_PAD = 13568;
constexpr float EPS = 1e-6f;
namespace pg8 {
#define PG8_LAS __attribute__((address_space(3)))
typedef unsigned short bf16_t;
typedef short bf16x8 __attribute__((ext_vector_type(8)));
typedef float f32x4 __attribute__((ext_vector_type(4)));
typedef unsigned u32x4 __attribute__((ext_vector_type(4)));
constexpr int BM = 256, BK = 64, HALF = 128, HTB = HALF * BK * 2  , STAGE_BYTES = 8 * HTB, NXCD = 8, WGM = 8;

__host__ __device__ __forceinline__ int lds_byte(int r, int c) { const int st = (r >> 4) * 2 + (c >> 5), rr = r & 15, cc = c & 31, ob = rr * 64 + cc * 2; return st * 1024 + (ob ^ (((ob >> 9) & 1) << 5)); }
__host__ __device__ __forceinline__ void stage_rc(int b, int& R, int& C) { const int st = b / 1024, sb = b % 1024, swz = sb ^ (((sb >> 9) & 1) << 5); R = (st >> 1) * 16 + swz / 64; C = (st & 1) * 32 + (swz % 64) / 2; }
__host__ __device__ __forceinline__ int perm32(int rho) { const int n = rho >> 4, i = rho & 15; return 8 * (i >> 2) + 4 * n + (i & 3); }

struct Unit { int pm, pn; };
struct Gemm { const bf16_t* A; const bf16_t* Bt; int M, N, K; };

struct StaticOrder {
    int nM, nN, nwg, G, c, wgm;
    __host__ __device__ void init(int M, int N, int G_, int c_, int wgm_ = WGM) { nM = M / BM; nN = N / BM; nwg = nM * nN; G = G_; c = c_; wgm = wgm_; }
    __host__ __device__ bool next(int i, Unit& u) const {
        const long L = (long)i * G + c; if (L >= nwg) return false;
        int wgid = (int)L; { const int q = nwg / NXCD, r = nwg % NXCD, xcd = wgid % NXCD, off = wgid / NXCD; wgid = (xcd < r ? xcd * (q + 1) : r * (q + 1) + (xcd - r) * q) + off; }
        const int nig = wgm * nN, gid = wgid / nig, fm = gid * wgm, gsz = (nM - fm) < wgm ? (nM - fm) : wgm;
        u.pm = fm + ((wgid % nig) % gsz); u.pn = (wgid % nig) / gsz; return true;
    }
    __device__ __forceinline__ void a_ready(const Unit&) const {}
    __device__ __forceinline__ void done(const Unit&) const {}
};
struct RevOrder : StaticOrder {
    __host__ __device__ bool next(int i, Unit& u) const {
        const long L = (long)i * G + c; if (L >= nwg) return false;
        int wgid = nwg - 1 - (int)L; { const int q = nwg / NXCD, r = nwg % NXCD, xcd = wgid % NXCD, off = wgid / NXCD; wgid = (xcd < r ? xcd * (q + 1) : r * (q + 1) + (xcd - r) * q) + off; }
        const int nig = wgm * nN, gid = wgid / nig, fm = gid * wgm, gsz = (nM - fm) < wgm ? (nM - fm) : wgm;
        u.pm = fm + ((wgid % nig) % gsz); u.pn = (wgid % nig) / gsz; return true;
    }
};

__device__ __forceinline__ unsigned cvt_pk_bf16(float lo, float hi) { unsigned r; asm volatile("v_cvt_pk_bf16_f32 %0, %1, %2" : "=v"(r) : "v"(lo), "v"(hi)); return r; }
__device__ __forceinline__ float bf_lo(unsigned w) { return __uint_as_float(w << 16); }
__device__ __forceinline__ float bf_hi(unsigned w) { return __uint_as_float(w & 0xffff0000u); }

struct EpiSlab {
    static constexpr bool PERM = true, AFTER_DRAIN = false;
    bf16_t* P; float* psmall;
    __device__ __forceinline__ void operator()(const f32x4 (&acc)[2][2][4][2], const Unit& u, int wr, int wc, int fr, int fq) const {
        const int row0 = u.pm * BM + wr * 64 + fr;
        if (u.pn < 52) {
#pragma unroll
            for (int ai = 0; ai < 2; ++ai)
#pragma unroll
                for (int m = 0; m < 4; ++m) { const int row = row0 + ai * HALF + m * 16;
#pragma unroll
                    for (int bj = 0; bj < 2; ++bj) { const f32x4 v0 = acc[ai][bj][m][0], v1 = acc[ai][bj][m][1];
                        u32x4 w; w.x = cvt_pk_bf16(v0[0], v0[1]); w.y = cvt_pk_bf16(v0[2], v0[3]); w.z = cvt_pk_bf16(v1[0], v1[1]); w.w = cvt_pk_bf16(v1[2], v1[3]);
                        *(u32x4*)(P + ((size_t)(2 * u.pn + bj) * M + row) * 128 + wc * 32 + 8 * fq) = w; } }
        } else if (wc == 0) {
#pragma unroll
            for (int ai = 0; ai < 2; ++ai)
#pragma unroll
                for (int m = 0; m < 4; ++m) { float* rp = psmall + (size_t)(row0 + ai * HALF + m * 16) * 32 + 8 * fq;
                    *(f32x4*)(rp) = acc[ai][0][m][0]; *(f32x4*)(rp + 4) = acc[ai][0][m][1]; }
        }
    }
};
struct EpiPlain {
    static constexpr bool PERM = true, AFTER_DRAIN = false;
    bf16_t* O; int ldc;
    __device__ __forceinline__ void operator()(const f32x4 (&acc)[2][2][4][2], const Unit& u, int wr, int wc, int fr, int fq) const {
        const int row0 = u.pm * BM + wr * 64 + fr, col0 = u.pn * BM + wc * 32 + 8 * fq;
#pragma unroll
        for (int ai = 0; ai < 2; ++ai)
#pragma unroll
            for (int m = 0; m < 4; ++m) { bf16_t* rowp = O + (size_t)(row0 + ai * HALF + m * 16) * ldc + col0;
#pragma unroll
                for (int bj = 0; bj < 2; ++bj) { const f32x4 v0 = acc[ai][bj][m][0], v1 = acc[ai][bj][m][1];
                    u32x4 w; w.x = cvt_pk_bf16(v0[0], v0[1]); w.y = cvt_pk_bf16(v0[2], v0[3]); w.z = cvt_pk_bf16(v1[0], v1[1]); w.w = cvt_pk_bf16(v1[2], v1[3]);
                    *(u32x4*)(rowp + bj * HALF) = w; } }
    }
};
struct EpiAct {
    static constexpr bool PERM = true, AFTER_DRAIN = false;
    const bf16_t* G; const float* cw; bf16_t* O;
    __device__ __forceinline__ void operator()(const f32x4 (&acc)[2][2][4][2], const Unit& u, int wr, int wc, int fr, int fq) const {
        const int row0 = u.pm * BM + wr * 64 + fr, col0 = u.pn * BM + wc * 32 + 8 * fq;
#pragma unroll
        for (int bj = 0; bj < 2; ++bj) {
            const int col = col0 + bj * HALF;
            const f32x4 w0a = *(const f32x4*)(cw + col), w0b = *(const f32x4*)(cw + col + 4);
            const f32x4 w1a = *(const f32x4*)(cw + DFF + col), w1b = *(const f32x4*)(cw + DFF + col + 4);
            const f32x4 w2a = *(const f32x4*)(cw + 2 * DFF + col), w2b = *(const f32x4*)(cw + 2 * DFF + col + 4);
#pragma unroll
            for (int ai = 0; ai < 2; ++ai) {
                u32x4 g2[4], g1[4], g0[4];
#pragma unroll
                for (int m = 0; m < 4; ++m) {
                    const int row = row0 + ai * HALF + m * 16, t = row & (T - 1);
                    const bf16_t* gp = G + (size_t)row * DFF + col;
                    g2[m] = *(const u32x4*)gp; g1[m] = (u32x4){0u, 0u, 0u, 0u}; g0[m] = (u32x4){0u, 0u, 0u, 0u};
                    if (t >= 1) g1[m] = *(const u32x4*)(gp - DFF);
                    if (t >= 2) g0[m] = *(const u32x4*)(gp - 2 * DFF); }
#pragma unroll
                for (int m = 0; m < 4; ++m) {
                    const int row = row0 + ai * HALF + m * 16;
                    float a[8];
#pragma unroll
                    for (int q = 0; q < 4; ++q) {
                        const float wl0 = q < 2 ? w0a[2 * q] : w0b[2 * q - 4], wh0 = q < 2 ? w0a[2 * q + 1] : w0b[2 * q - 3];
                        const float wl1 = q < 2 ? w1a[2 * q] : w1b[2 * q - 4], wh1 = q < 2 ? w1a[2 * q + 1] : w1b[2 * q - 3];
                        const float wl2 = q < 2 ? w2a[2 * q] : w2b[2 * q - 4], wh2 = q < 2 ? w2a[2 * q + 1] : w2b[2 * q - 3];
                        a[2 * q]     = wl0 * bf_lo(g0[m][q]) + wl1 * bf_lo(g1[m][q]) + wl2 * bf_lo(g2[m][q]);
                        a[2 * q + 1] = wh0 * bf_hi(g0[m][q]) + wh1 * bf_hi(g1[m][q]) + wh2 * bf_hi(g2[m][q]);
                    }
                    const f32x4 v0 = acc[ai][bj][m][0], v1 = acc[ai][bj][m][1];
                    float o[8];
#pragma unroll
                    for (int i = 0; i < 8; ++i) { const float up = i < 4 ? v0[i] : v1[i - 4]; o[i] = a[i] * __builtin_amdgcn_rcpf(1.0f + __expf(-a[i])) * up; }
                    u32x4 w; w.x = cvt_pk_bf16(o[0], o[1]); w.y = cvt_pk_bf16(o[2], o[3]); w.z = cvt_pk_bf16(o[4], o[5]); w.w = cvt_pk_bf16(o[6], o[7]);
                    *(u32x4*)(O + (size_t)row * DFF + col) = w;
                }
                asm volatile("" ::: "memory");
            }
        }
    }
};
struct EpiResid {
    static constexpr bool PERM = false, AFTER_DRAIN = false;
    const float* base; float* out;
    __device__ __forceinline__ void operator()(const f32x4 (&acc)[2][2][4][2], const Unit& u, int wr, int wc, int fr, int fq) const {
        const int row0 = u.pm * BM + wr * 64 + fr, col0 = u.pn * BM + wc * 32 + 4 * fq;
#pragma unroll
        for (int ai = 0; ai < 2; ++ai)
#pragma unroll
            for (int mp = 0; mp < 2; ++mp) {
                f32x4 b[2][2][2];
#pragma unroll
                for (int mm = 0; mm < 2; ++mm) { const size_t off = (size_t)(row0 + ai * HALF + (2 * mp + mm) * 16) * DM + col0;
#pragma unroll
                    for (int bj = 0; bj < 2; ++bj)
#pragma unroll
                        for (int n = 0; n < 2; ++n) b[mm][bj][n] = *(const f32x4*)(base + off + bj * HALF + n * 16); }
#pragma unroll
                for (int mm = 0; mm < 2; ++mm) { const size_t off = (size_t)(row0 + ai * HALF + (2 * mp + mm) * 16) * DM + col0;
#pragma unroll
                    for (int bj = 0; bj < 2; ++bj)
#pragma unroll
                        for (int n = 0; n < 2; ++n) *(f32x4*)(out + off + bj * HALF + n * 16) = b[mm][bj][n] + acc[ai][bj][2 * mp + mm][n]; }
                asm volatile("" ::: "memory"); }
    }
};

template <bool F32BASE> struct EpiResidB {
    static constexpr bool PERM = true, AFTER_DRAIN = false;
    const void* base; bf16_t* out;
    __device__ __forceinline__ void operator()(const f32x4 (&acc)[2][2][4][2], const Unit& u, int wr, int wc, int fr, int fq) const {
        const int row0 = u.pm * BM + wr * 64 + fr, col0 = u.pn * BM + wc * 32 + 8 * fq;
#pragma unroll
        for (int ai = 0; ai < 2; ++ai)
#pragma unroll
            for (int mp = 0; mp < 2; ++mp) {
                f32x4 b[2][2][2];
#pragma unroll
                for (int mm = 0; mm < 2; ++mm) { const size_t off = (size_t)(row0 + ai * HALF + (2 * mp + mm) * 16) * DM + col0;
#pragma unroll
                    for (int bj = 0; bj < 2; ++bj) {
                        if constexpr (F32BASE) { const float* bp = (const float*)base + off + bj * HALF; b[mm][bj][0] = *(const f32x4*)bp; b[mm][bj][1] = *(const f32x4*)(bp + 4); }
                        else { const u32x4 w = *(const u32x4*)((const bf16_t*)base + off + bj * HALF);
                            b[mm][bj][0] = (f32x4){bf_lo(w.x), bf_hi(w.x), bf_lo(w.y), bf_hi(w.y)}; b[mm][bj][1] = (f32x4){bf_lo(w.z), bf_hi(w.z), bf_lo(w.w), bf_hi(w.w)}; } } }
#pragma unroll
                for (int mm = 0; mm < 2; ++mm) { const size_t off = (size_t)(row0 + ai * HALF + (2 * mp + mm) * 16) * DM + col0;
#pragma unroll
                    for (int bj = 0; bj < 2; ++bj) { const f32x4 v0 = b[mm][bj][0] + acc[ai][bj][2 * mp + mm][0], v1 = b[mm][bj][1] + acc[ai][bj][2 * mp + mm][1];
                        u32x4 w; w.x = cvt_pk_bf16(v0[0], v0[1]); w.y = cvt_pk_bf16(v0[2], v0[3]); w.z = cvt_pk_bf16(v1[0], v1[1]); w.w = cvt_pk_bf16(v1[2], v1[3]);
                        *(u32x4*)(out + off + bj * HALF) = w; } }
                asm volatile("" ::: "memory"); }
    }
};

template <class Epi, class Sched, bool ALIGN_EPI = false, bool SP2 = false>
__device__ __forceinline__ void gemm_phase(PG8_LAS unsigned char* lds, const Gemm g, const Sched& S, const Epi& E, const int tid_in) {
    int tid = tid_in; asm volatile("" : "+v"(tid));
    const int wid = __builtin_amdgcn_readfirstlane(tid >> 6), lane = tid & 63, wr = wid >> 2, wc = wid & 3, fr = lane & 15, fq = lane >> 4;
    const int K = g.K, nt = K / BK;
    unsigned voffA[2], voffB[2];
#pragma unroll
    for (int i = 0; i < 2; ++i) { int R, C; stage_rc(tid * 16 + i * 8192, R, C); const int Rb = Epi::PERM ? ((R & ~31) + perm32(R & 31)) : R;
        voffA[i] = (unsigned)(R * K + C) * 2u; voffB[i] = (unsigned)(Rb * K + C) * 2u; }
    const size_t kstep = (size_t)(BK * 2);
    const size_t hstep = (size_t)HALF * K * 2;
    const size_t tstep = 2 * hstep;
    const unsigned ldsw = (unsigned)wid * 1024u;
    const int aoff = lds_byte(wr * 64 + fr, fq * 8), boff = lds_byte(wc * 32 + fr, fq * 8);
#define PG8_SA(b, h) (((b) * 2 + (h)) * HTB)
#define PG8_SB(b, h) ((4 + (b) * 2 + (h)) * HTB)
#define PG8_STAGE(bufoff, gbase, voff) do { _Pragma("unroll") for (int _i = 0; _i < 2; ++_i) \
        __builtin_amdgcn_global_load_lds((const unsigned*)((const char*)(gbase) + (voff)[_i]), (PG8_LAS unsigned*)(lds + (bufoff) + ldsw + _i * 8192), 16, 0, 0); } while (0)
#define PG8_LDA(dst, b, h) do { _Pragma("unroll") for (int m = 0; m < 4; ++m) _Pragma("unroll") for (int k = 0; k < 2; ++k) dst[m][k] = *(const PG8_LAS bf16x8*)(lds + PG8_SA(b, h) + aoff + m * 2048 + k * 1024); } while (0)
#define PG8_LDB(dst, b, h) do { _Pragma("unroll") for (int n = 0; n < 2; ++n) _Pragma("unroll") for (int k = 0; k < 2; ++k) dst[n][k] = *(const PG8_LAS bf16x8*)(lds + PG8_SB(b, h) + boff + n * 2048 + k * 1024); } while (0)
#define PG8_MMA(ai, bj, At, Bt) do { __builtin_amdgcn_s_setprio(1); _Pragma("unroll") for (int m = 0; m < 4; ++m) _Pragma("unroll") for (int n = 0; n < 2; ++n) _Pragma("unroll") for (int k = 0; k < 2; ++k) \
        acc[ai][bj][m][n] = __builtin_amdgcn_mfma_f32_16x16x32_bf16(Bt[n][k], At[m][k], acc[ai][bj][m][n], 0, 0, 0); __builtin_amdgcn_s_setprio(0); } while (0)
#define PG8_WAIT_V(n) asm volatile("s_waitcnt vmcnt(" #n ")" ::: "memory")
#define PG8_WAIT_L(n) asm volatile("s_waitcnt lgkmcnt(" #n ")" ::: "memory")
#define PG8_BAR __builtin_amdgcn_s_barrier()
#define PG8_SCHED __builtin_amdgcn_sched_barrier(0)
    Unit cur, nxt; int ui = 0;
    if (!S.next(0, cur)) return;
    f32x4 acc[2][2][4][2];
#pragma unroll
    for (int a = 0; a < 2; ++a)
#pragma unroll
        for (int b = 0; b < 2; ++b)
#pragma unroll
            for (int m = 0; m < 4; ++m)
#pragma unroll
                for (int n = 0; n < 2; ++n) acc[a][b][m][n] = (f32x4){0.f, 0.f, 0.f, 0.f};
    bf16x8 At[4][2], B0[2][2], B1[2][2];
    const char* cA = (const char*)g.A + (size_t)cur.pm * tstep; const char* cB = (const char*)g.Bt + (size_t)cur.pn * tstep;
    S.a_ready(cur);
    if constexpr (SP2) {
        PG8_STAGE(PG8_SB(0, 0), cB, voffB); PG8_STAGE(PG8_SB(0, 1), cB + hstep, voffB); PG8_STAGE(PG8_SA(0, 0), cA, voffA); PG8_STAGE(PG8_SA(0, 1), cA + hstep, voffA);
        if (wr == 1) PG8_BAR;
        PG8_WAIT_V(2); PG8_BAR;
        PG8_STAGE(PG8_SB(1, 0), cB + kstep, voffB); PG8_STAGE(PG8_SA(1, 0), cA + kstep, voffA); PG8_STAGE(PG8_SB(1, 1), cB + hstep + kstep, voffB);
        PG8_WAIT_V(6); PG8_BAR;
    } else {
        PG8_STAGE(PG8_SB(0, 0), cB, voffB); PG8_STAGE(PG8_SA(0, 0), cA, voffA); PG8_STAGE(PG8_SB(0, 1), cB + hstep, voffB); PG8_STAGE(PG8_SA(0, 1), cA + hstep, voffA);
        if (wr == 1) PG8_BAR;
        PG8_WAIT_V(4); PG8_BAR;
        PG8_STAGE(PG8_SB(1, 0), cB + kstep, voffB); PG8_STAGE(PG8_SA(1, 0), cA + kstep, voffA); PG8_STAGE(PG8_SB(1, 1), cB + hstep + kstep, voffB);
        PG8_WAIT_V(6); PG8_BAR;
    }
    for (;;) {
        const bool has_next = S.next(ui + 1, nxt);
        const char* nA = has_next ? (const char*)g.A + (size_t)nxt.pm * tstep : cA; const char* nB = has_next ? (const char*)g.Bt + (size_t)nxt.pn * tstep : cB;
        for (int t = 0; t < nt; t += 2) {
            const bool last = (t == nt - 2);
            const char* a1 = cA + (size_t)(t + 1) * kstep;
            const char* a2 = last ? nA : cA + (size_t)(t + 2) * kstep; const char* b2 = last ? nB : cB + (size_t)(t + 2) * kstep;
            const char* a3 = a2 + kstep; const char* b3 = b2 + kstep;
            if (last && has_next) S.a_ready(nxt);
            if constexpr (SP2) {
            PG8_LDB(B0, 0, 0); PG8_LDB(B1, 0, 1); PG8_SCHED; PG8_LDA(At, 0, 0); PG8_STAGE(PG8_SA(1, 1), a1 + hstep, voffA);
            PG8_WAIT_V(8); PG8_WAIT_L(0); PG8_BAR; PG8_MMA(0, 0, At, B0); PG8_MMA(0, 1, At, B1); PG8_BAR; PG8_SCHED;
            PG8_LDA(At, 0, 1); PG8_STAGE(PG8_SB(0, 0), b2, voffB); PG8_STAGE(PG8_SB(0, 1), b2 + hstep, voffB); PG8_STAGE(PG8_SA(0, 0), a2, voffA);
            PG8_WAIT_V(8); PG8_WAIT_L(0); PG8_BAR; PG8_MMA(1, 0, At, B0); PG8_MMA(1, 1, At, B1); PG8_BAR; PG8_SCHED;
            PG8_LDB(B0, 1, 0); PG8_LDB(B1, 1, 1); PG8_SCHED; PG8_LDA(At, 1, 0); PG8_STAGE(PG8_SA(0, 1), a2 + hstep, voffA);
            PG8_WAIT_V(8); PG8_WAIT_L(0); PG8_BAR; PG8_MMA(0, 0, At, B0); PG8_MMA(0, 1, At, B1); PG8_BAR; PG8_SCHED;
            PG8_LDA(At, 1, 1); PG8_STAGE(PG8_SB(1, 0), b3, voffB); PG8_STAGE(PG8_SB(1, 1), b3 + hstep, voffB); PG8_STAGE(PG8_SA(1, 0), a3, voffA);
            PG8_WAIT_V(8); PG8_WAIT_L(0); PG8_BAR; PG8_MMA(1, 0, At, B0); PG8_MMA(1, 1, At, B1); PG8_BAR; PG8_SCHED;
            } else {
            PG8_LDB(B0, 0, 0); PG8_SCHED; PG8_LDA(At, 0, 0); PG8_STAGE(PG8_SA(1, 1), a1 + hstep, voffA);
            PG8_WAIT_L(8); PG8_BAR; PG8_WAIT_L(0); PG8_MMA(0, 0, At, B0); PG8_BAR; PG8_SCHED;
            PG8_LDB(B1, 0, 1); PG8_STAGE(PG8_SB(0, 0), b2, voffB);
            PG8_BAR; PG8_WAIT_L(0); PG8_MMA(0, 1, At, B1); PG8_BAR;
            PG8_LDA(At, 0, 1); PG8_STAGE(PG8_SA(0, 0), a2, voffA);
            PG8_BAR; PG8_WAIT_L(0); PG8_MMA(1, 0, At, B0); PG8_BAR; PG8_SCHED;
            PG8_STAGE(PG8_SB(0, 1), b2 + hstep, voffB);
            PG8_WAIT_V(6); PG8_BAR; PG8_MMA(1, 1, At, B1); PG8_BAR;
            PG8_LDB(B0, 1, 0); PG8_SCHED; PG8_LDA(At, 1, 0); PG8_STAGE(PG8_SA(0, 1), a2 + hstep, voffA);
            PG8_WAIT_L(8); PG8_BAR; PG8_WAIT_L(0); PG8_MMA(0, 0, At, B0); PG8_BAR; PG8_SCHED;
            PG8_LDB(B1, 1, 1); PG8_STAGE(PG8_SB(1, 0), b3, voffB);
            PG8_BAR; PG8_WAIT_L(0); PG8_MMA(0, 1, At, B1); PG8_BAR;
            PG8_LDA(At, 1, 1); PG8_STAGE(PG8_SA(1, 0), a3, voffA);
            PG8_BAR; PG8_WAIT_L(0); PG8_MMA(1, 0, At, B0); PG8_BAR; PG8_SCHED;
            PG8_STAGE(PG8_SB(1, 1), b3 + hstep, voffB);
            PG8_WAIT_V(6); PG8_BAR; PG8_MMA(1, 1, At, B1); PG8_BAR;
            }
        }
        if constexpr (ALIGN_EPI) { if (wr == 0) PG8_BAR; }
        if constexpr (!Epi::AFTER_DRAIN) { E(acc, cur, wr, wc, fr, fq); S.done(cur); }
        if (!has_next) break;
#pragma unroll
        for (int a = 0; a < 2; ++a)
#pragma unroll
            for (int b = 0; b < 2; ++b)
#pragma unroll
                for (int m = 0; m < 4; ++m)
#pragma unroll
                    for (int n = 0; n < 2; ++n) acc[a][b][m][n] = (f32x4){0.f, 0.f, 0.f, 0.f};
        cur = nxt; cA = nA; cB = nB; ++ui;
        if constexpr (ALIGN_EPI) { if (wr == 1) PG8_BAR; }
    }
    PG8_WAIT_V(0);
    if constexpr (!ALIGN_EPI) { if (wr == 0) PG8_BAR; }
    PG8_BAR;
    if constexpr (Epi::AFTER_DRAIN) { E.fused(acc, cur, wr, wc, fr, fq, lds, wid, lane); S.done(cur); }
#undef PG8_SA
#undef PG8_SB
#undef PG8_STAGE
#undef PG8_LDA
#undef PG8_LDB
#undef PG8_MMA
#undef PG8_WAIT_V
#undef PG8_WAIT_L
#undef PG8_BAR
#undef PG8_SCHED
}
}
#define GAS __attribute__((address_space(1)))
#define LAS __attribute__((address_space(3)))
typedef unsigned short bf16;
typedef unsigned v4u __attribute__((ext_vector_type(4)));
typedef float f32x4 __attribute__((ext_vector_type(4)));
typedef short bf16x8 __attribute__((ext_vector_type(8)));
typedef GAS unsigned gu32;
typedef GAS unsigned long long gu64;
#define RLX_AGENT __ATOMIC_RELAXED, __HIP_MEMORY_SCOPE_AGENT
#define LDS_WAIT() asm volatile("s_waitcnt lgkmcnt(0)" ::: "memory")
#define VM_WAIT() asm volatile("s_waitcnt vmcnt(0)" ::: "memory")
__device__ __forceinline__ unsigned long long rt() { return __builtin_amdgcn_s_memrealtime(); }
__device__ __forceinline__ unsigned f2bf(float f) { unsigned u = __builtin_bit_cast(unsigned, f); return (u + 0x7fffu + ((u >> 16) & 1u)) >> 16; }
__device__ __forceinline__ unsigned pk2(float lo, float hi) { return f2bf(lo) | (f2bf(hi) << 16); }
#define XB_TMO      128
#define XB_XCNT(j)  (256  + 64 * (j))
#define XB_XSUB(j)  (1280 + 64 * (j))
#define XB_XGEN(j)  (2304 + 64 * (j))
#define XB_TOP      3328
#define XB_TOPGEN   3392
#define XCD_BAR_WORDS 3456
#define XB_SPIN_CAP (1u << 18)

__device__ __forceinline__ unsigned xb_ld(unsigned* p)              { return __hip_atomic_load(p, __ATOMIC_RELAXED, __HIP_MEMORY_SCOPE_AGENT); }
__device__ __forceinline__ unsigned xb_add(unsigned* p, unsigned v) { return __hip_atomic_fetch_add(p, v, __ATOMIC_RELAXED, __HIP_MEMORY_SCOPE_AGENT); }
__device__ __forceinline__ unsigned xb_xcc_id() { return (unsigned)__builtin_amdgcn_s_getreg((3 << 11) | 20) & 0xFu; }
#define XB_SPIN(cond, bar) do { unsigned _sp = 0; while (cond) { __builtin_amdgcn_s_sleep(1); \
    if ((++_sp & 255u) == 0u) { if (xb_ld(&(bar)[XB_TMO])) break; if (_sp > XB_SPIN_CAP) { atomicAdd(&(bar)[XB_TMO], 1u); break; } } } } while (0)

struct XcdBarrier {
    unsigned* bar; unsigned x;
    volatile LAS unsigned* st;
};

__device__ __forceinline__ XcdBarrier xcd_barrier_post(unsigned* bar, volatile LAS unsigned* st) {
    XcdBarrier b; b.bar = bar; b.x = xb_xcc_id(); b.st = st;
    if (threadIdx.x == 0) (void)xb_add(&bar[XB_XCNT(b.x)], 1u);
    return b;
}
__device__ __forceinline__ void xcd_barrier_complete(unsigned* bar, unsigned x, unsigned& nloc, unsigned& nx) {
    const unsigned G = gridDim.x * gridDim.y * gridDim.z;
    unsigned sum, cnt, mine, sp = 0u;
    for (;;) {
        sum = 0u; cnt = 0u; mine = 0u;
#pragma unroll
        for (unsigned j = 0; j < 16; ++j) { const unsigned c = xb_ld(&bar[XB_XCNT(j)]); sum += c; cnt += (c > 0u) ? 1u : 0u; mine = (j == x) ? c : mine; }
        if (sum == G) break;
        __builtin_amdgcn_s_sleep(1);
        if ((++sp & 255u) == 0u) { if (xb_ld(&bar[XB_TMO])) break; if (sp > XB_SPIN_CAP) { atomicAdd(&bar[XB_TMO], 1u); break; } }
    }
    nloc = mine > 0u ? mine : 1u; nx = cnt > 0u ? cnt : 1u;
}

__device__ __forceinline__ void xcd_barrier(const XcdBarrier& b) {
    asm volatile("s_waitcnt vmcnt(0)" ::: "memory");
    __syncthreads();
    if (threadIdx.x == 0) {
        unsigned* bar = b.bar;
        __builtin_amdgcn_s_waitcnt(0);
        unsigned nloc = b.st[0], nx = b.st[1];
        if (nloc == 0u) { xcd_barrier_complete(bar, b.x, nloc, nx); b.st[0] = nloc; b.st[1] = nx; }
        const unsigned old = xb_add(&bar[XB_XSUB(b.x)], 1u);
        const unsigned gen = old / nloc;
        if (old + 1u == (gen + 1u) * nloc) {
            __builtin_amdgcn_fence(__ATOMIC_RELEASE, "agent");
            asm volatile("s_waitcnt vmcnt(0)" ::: "memory");
            const unsigned og = xb_add(&bar[XB_TOP], 1u);
            const unsigned tg = og / nx;
            if (og + 1u == (tg + 1u) * nx) xb_add(&bar[XB_TOPGEN], 1u);
            else XB_SPIN(xb_ld(&bar[XB_TOPGEN]) == tg, bar);
            __builtin_amdgcn_fence(__ATOMIC_ACQUIRE, "agent");
            xb_add(&bar[XB_XGEN(b.x)], 1u);
            asm volatile("s_waitcnt vmcnt(0)" ::: "memory");
        } else {
            XB_SPIN(xb_ld(&bar[XB_XGEN(b.x)]) == gen, bar);
            __builtin_amdgcn_fence(__ATOMIC_ACQUIRE, "agent");
            asm volatile("s_waitcnt vmcnt(0)" ::: "memory");
        }
    }
    __syncthreads();
}
namespace att {
typedef unsigned short bf16_t;
typedef short bf16x8 __attribute__((ext_vector_type(8)));
typedef short s16x4 __attribute__((ext_vector_type(4)));
typedef float f32x16 __attribute__((ext_vector_type(16)));
typedef float f32x4 __attribute__((ext_vector_type(4)));
typedef unsigned u32x4 __attribute__((ext_vector_type(4)));
constexpr int D = 128, NW = 8, QBLK = 32, KVBLK = 64, QB = NW * QBLK;
constexpr int SHM_V = KVBLK * D * 2, SHM_K = KVBLK * D * 2;
constexpr int OFF_WS = 2 * SHM_V + 2 * SHM_K, OFF_BIAS = OFF_WS + NW * 64 * 4, OFF_Q = OFF_BIAS + 2 * 64 * 4, ATT_LDS_BYTES = OFF_Q + NW * 8192;
#ifndef NQREG
#define NQREG 2
#endif
constexpr float SCALE = 0.08838834764831845f, INV_SCALE = 11.313708498984761f, THR = 8.f;
constexpr int WIN = 1 << 30;

#define KSWZ(row, colB) ((row) * 256 + ((colB) ^ (((row) & 7) << 4)))
#define SBAR() __builtin_amdgcn_sched_barrier(0)
__device__ __forceinline__ int v_st(int k, int c) { const int kk = (k & ~0xC) | ((k & 4) << 1) | ((k & 8) >> 1); return ((kk >> 3) * 4 + (c >> 5)) * 512 + ((kk & 7) * 32 + (c & 31)) * 2; }
__device__ __forceinline__ int v_rd_base(int lane) { return ((lane & 3) << 3) | (((lane >> 2) & 3) << 6) | (((lane >> 4) & 1) << 5) | (((lane >> 5) & 1) << 8); }
constexpr int v_rd_off(int d0, int ks, int half) { return d0 * 512 + ks * 4096 + half * 2048; }
__device__ __forceinline__ int crow(int r, int hi) { return (r & 3) + 8 * (r >> 2) + 4 * hi; }
__device__ __forceinline__ unsigned cvtpk(float lo, float hi) { unsigned r; asm volatile("v_cvt_pk_bf16_f32 %0, %1, %2" : "=v"(r) : "v"(lo), "v"(hi)); return r; }
__device__ __forceinline__ bf16x8 load8(const bf16_t* p) { return *reinterpret_cast<const bf16x8*>(p); }
__device__ __forceinline__ void mask_tile(f32x16& p0, f32x16& p1, int dq) {
    const float NEG = -__builtin_inff();
#pragma unroll
    for (int r = 0; r < 16; ++r) {
        const int c = (r & 3) + 8 * (r >> 2);
        if ((unsigned)(dq - c) >= (unsigned)WIN) p0[r] = NEG;
        if ((unsigned)(dq - c - 32) >= (unsigned)WIN) p1[r] = NEG;
    }
}
__device__ __forceinline__ void add_bias(f32x16& p0, f32x16& p1, const float* bl, int hi) {
#pragma unroll
    for (int g = 0; g < 4; ++g) { const f32x4 a = *(const f32x4*)(bl + 8 * g + 4 * hi), b = *(const f32x4*)(bl + 32 + 8 * g + 4 * hi);
#pragma unroll
        for (int i = 0; i < 4; ++i) { p0[4 * g + i] += a[i]; p1[4 * g + i] += b[i]; }
        asm volatile("" ::: "memory"); }
}
__device__ __forceinline__ void partialSM(f32x16& p0, f32x16& p1, float& m_reg, float& mn, float& alpha) {
    float pmax = p0[0]; for (int r = 1; r < 16; ++r) pmax = fmaxf(pmax, p0[r]); for (int r = 0; r < 16; ++r) pmax = fmaxf(pmax, p1[r]);
    { auto rr = __builtin_amdgcn_permlane32_swap(__float_as_uint(pmax), __float_as_uint(pmax), false, false);
      pmax = fmaxf(__uint_as_float(rr[0]), __uint_as_float(rr[1])); }
    constexpr float C2 = 1.4426950408889634f * SCALE;
    if (__builtin_expect(__all((pmax - m_reg) * SCALE <= THR), 1)) { mn = m_reg; alpha = 1.f; }
    else { mn = fmaxf(m_reg, pmax); alpha = __builtin_amdgcn_exp2f((m_reg - mn) * C2); m_reg = mn; }
    const float mnL = -mn * C2;
    for (int r = 0; r < 16; ++r) p0[r] = fmaf(p0[r], C2, mnL); for (int r = 0; r < 16; ++r) p1[r] = fmaf(p1[r], C2, mnL);
    for (int r = 0; r < 16; ++r) p0[r] = __builtin_amdgcn_exp2f(p0[r]);
}
__device__ __forceinline__ void finishSM(f32x16& p0, f32x16& p1, float alpha, float& l_reg, bf16x8& pa0, bf16x8& pa1, bf16x8& pa2, bf16x8& pa3) {
    for (int r = 0; r < 16; ++r) p1[r] = __builtin_amdgcn_exp2f(p1[r]);
    float ps = 0; for (int r = 0; r < 16; ++r) ps += p0[r]; for (int r = 0; r < 16; ++r) ps += p1[r];
    { auto rr = __builtin_amdgcn_permlane32_swap(__float_as_uint(ps), __float_as_uint(ps), false, false);
      ps = __uint_as_float(rr[0]) + __uint_as_float(rr[1]); }
    l_reg = l_reg * alpha + ps;
#define PK4(P, B_, OUT) do { unsigned a0 = cvtpk(P[B_+0], P[B_+1]), a1 = cvtpk(P[B_+2], P[B_+3]);                          \
        unsigned b0 = cvtpk(P[B_+4], P[B_+5]), b1 = cvtpk(P[B_+6], P[B_+7]);                                             \
        auto r0 = __builtin_amdgcn_permlane32_swap(a0, b0, false, false); auto r1 = __builtin_amdgcn_permlane32_swap(a1, b1, false, false); \
        u32x4 w = {r0[0], r1[0], r0[1], r1[1]}; OUT = *reinterpret_cast<bf16x8*>(&w); } while (0)
    PK4(p0, 0, pa0); PK4(p0, 8, pa1); PK4(p1, 0, pa2); PK4(p1, 8, pa3);
#undef PK4
}
template <int KB>
__device__ __forceinline__ void qkt(f32x16& p0, f32x16& p1, const char* K_lds, int r32, int hi, const bf16x8* qr, const char* qw) {
    p0 = f32x16{}; p1 = f32x16{};
    const char* kb[4];
#pragma unroll
    for (int dd = 0; dd < 4; ++dd) kb[dd] = K_lds + KB * SHM_K + KSWZ(r32, (dd * 16 + hi * 8) * 2);
#pragma unroll
    for (int d0 = 0; d0 < 8; ++d0) { const char* a = kb[d0 & 3] + (d0 >> 2) * 128;
        bf16x8 b0 = *reinterpret_cast<const bf16x8*>(a);
        bf16x8 b1 = *reinterpret_cast<const bf16x8*>(a + 32 * 256);
        bf16x8 qf; if (d0 < NQREG) qf = qr[d0]; else qf = *reinterpret_cast<const bf16x8*>(qw + d0 * 1024);
        p0 = __builtin_amdgcn_mfma_f32_32x32x16_bf16(b0, qf, p0, 0, 0, 0);
        p1 = __builtin_amdgcn_mfma_f32_32x32x16_bf16(b1, qf, p1, 0, 0, 0); }
}
template <int VB>
__device__ __forceinline__ void pv_tile(f32x16* o, int vb0, bf16x8 pa0, bf16x8 pa1, bf16x8 pa2, bf16x8 pa3) {
#define TRRD(dst, off) asm volatile("ds_read_b64_tr_b16 %0, %1 offset:%2" : "=&v"(dst) : "v"(vb0), "i"(off) : "memory")
#define PV_D0(d0) do { s16x4 l0, l1, l2, l3, h0, h1, h2, h3; constexpr int b_ = VB * SHM_V + v_rd_off(d0, 0, 0); \
        TRRD(l0, b_); TRRD(h0, b_ + 2048); TRRD(l1, b_ + 4096); TRRD(h1, b_ + 6144); TRRD(l2, b_ + 8192); TRRD(h2, b_ + 10240); TRRD(l3, b_ + 12288); TRRD(h3, b_ + 14336); \
        asm volatile("s_waitcnt lgkmcnt(0)" ::: "memory"); SBAR();   \
        o[d0] = __builtin_amdgcn_mfma_f32_32x32x16_bf16(pa0, (bf16x8){l0[0], l0[1], l0[2], l0[3], h0[0], h0[1], h0[2], h0[3]}, o[d0], 0, 0, 0);   \
        o[d0] = __builtin_amdgcn_mfma_f32_32x32x16_bf16(pa1, (bf16x8){l1[0], l1[1], l1[2], l1[3], h1[0], h1[1], h1[2], h1[3]}, o[d0], 0, 0, 0);   \
        o[d0] = __builtin_amdgcn_mfma_f32_32x32x16_bf16(pa2, (bf16x8){l2[0], l2[1], l2[2], l2[3], h2[0], h2[1], h2[2], h2[3]}, o[d0], 0, 0, 0);   \
        o[d0] = __builtin_amdgcn_mfma_f32_32x32x16_bf16(pa3, (bf16x8){l3[0], l3[1], l3[2], l3[3], h3[0], h3[1], h3[2], h3[3]}, o[d0], 0, 0, 0); } while (0)
    PV_D0(0); PV_D0(1); PV_D0(2); PV_D0(3);
#undef PV_D0
#undef TRRD
}
struct BlockRef { const bf16_t* Q; const bf16_t* K; const bf16_t* V; float* O; const float* cum; int P0, jlo; };
struct Seam { bf16x8 qr[8]; bf16x8 st_v0, st_v1, st_k0, st_k1; float st_b; };
#define ROW(p, k0, rr) ((p) + (size_t)((k0) + (rr)) * D + sc)
#define VMW() asm volatile("s_waitcnt vmcnt(0)" ::: "memory")
#define VMWN(n) asm volatile("s_waitcnt vmcnt(%0)" :: "i"(n) : "memory")
#define SLOAD_H(Kp, Vp, Cp, k0) do { S.st_v0 = load8(ROW(Vp, k0, sr)); S.st_v1 = load8(ROW(Vp, k0, 32 + sr));              \
                         S.st_k0 = load8(ROW(Kp, k0, sr)); S.st_k1 = load8(ROW(Kp, k0, 32 + sr)); if ((Cp) != nullptr && tid < 64) S.st_b = (Cp)[(k0) + tid]; } while (0)
#define SWRITE_HK(bf, Cp) do { *(bf16x8*)(K_lds + (bf) * SHM_K + kws) = S.st_k0; *(bf16x8*)(K_lds + (bf) * SHM_K + kws + 32 * 256) = S.st_k1; \
                         if ((Cp) != nullptr && tid < 64) bias_l[(bf) * 64 + tid] = -S.st_b * INV_SCALE; } while (0)
#define SWRITE_HV(bf) do { *(bf16x8*)(V_lds + (bf) * SHM_V + vst0) = S.st_v0; *(bf16x8*)(V_lds + (bf) * SHM_V + vst1) = S.st_v1; } while (0)
#define SWRITE_H(bf, Cp) do { SWRITE_HV(bf); SWRITE_HK(bf, Cp); } while (0)
__device__ __forceinline__ void attn_prime(const BlockRef& cur, char* lds, Seam& S, const int tid) {
    const int wid = __builtin_amdgcn_readfirstlane(tid >> 6), lane = tid & 63, r32 = lane & 31, hi = lane >> 5;
    const int sr = tid >> 4, sc = (tid & 15) * 8, kws = KSWZ(sr, sc * 2); char* K_lds = lds + 2 * SHM_V; float* bias_l = (float*)(lds + OFF_BIAS);
    for (int d0 = 0; d0 < 8; ++d0) S.qr[d0] = load8(cur.Q + (size_t)(wid * QBLK + r32) * D + d0 * 16 + hi * 8);
    SLOAD_H(cur.K, cur.V, cur.cum, cur.jlo * KVBLK); VMW(); SWRITE_HK(0, cur.cum);
    __syncthreads();
}
__device__ __forceinline__ void attn_block(const BlockRef& cur, const BlockRef& nxt, char* lds, Seam& S, const int tid) {
    const int wid = __builtin_amdgcn_readfirstlane(tid >> 6), lane = tid & 63, r32 = lane & 31, hi = lane >> 5;
    const int NT = (cur.P0 + QB) / KVBLK - cur.jlo;
    const int qlo = cur.P0 + wid * QBLK, qm = qlo + r32 - 4 * hi;
    char* V_lds = lds; char* K_lds = lds + 2 * SHM_V; float* bias_l = (float*)(lds + OFF_BIAS);
    float* ws = (float*)(lds + OFF_WS) + wid * 64; float* li_l = ws, * al_l = ws + 32;
    float m_reg = -1e30f, l_reg = 0; f32x16 o[4] = {};
    const int sr = tid >> 4, sc = (tid & 15) * 8, vst0 = v_st(sr, sc), vst1 = v_st(32 + sr, sc), kws = KSWZ(sr, sc * 2);
    const int vb0 = (int)(uintptr_t)V_lds + v_rd_base(lane);
    const bf16_t* Kh = cur.K; const bf16_t* Vh = cur.V; const float* Ch = cur.cum;
#define RESC(a) do { if (__any((a) < 1.f)) { if (hi == 0) al_l[r32] = (a); asm volatile("s_waitcnt lgkmcnt(0)" ::: "memory");              \
                     for (int d_ = 0; d_ < 4; ++d_) for (int r = 0; r < 16; ++r) o[d_][r] *= al_l[crow(r, hi)]; } } while (0)
#define KBASE(t) ((cur.jlo + (t)) * KVBLK)
#define MASKT(P0_, P1_, t) do { const int kb_ = KBASE(t); if (kb_ + KVBLK - 1 > qlo) mask_tile(P0_, P1_, qm - kb_); } while (0)
#define BIAST(P0_, P1_, bf) do { if (Ch != nullptr) add_bias(P0_, P1_, bias_l + (bf) * 64, hi); } while (0)
    constexpr int NQL = 8;
#define SEAM_K0() do { VMWN(NQL); SWRITE_HK(0, nxt.cum); SBAR(); } while (0)
    f32x16 pA0, pA1, pB0, pB1; float mnA, mnB, alA, alB; bf16x8 pa0, pa1, pa2, pa3;
    char* qw = lds + OFF_Q + wid * 8192 + lane * 16;
#pragma unroll
    for (int d0 = NQREG; d0 < 8; ++d0) *reinterpret_cast<bf16x8*>(qw + d0 * 1024) = S.qr[d0];
    SWRITE_HV(0); SBAR();
    if (NT > 1) SLOAD_H(Kh, Vh, Ch, KBASE(1));
    SBAR(); qkt<0>(pA0, pA1, K_lds, r32, hi, S.qr, qw);
    BIAST(pA0, pA1, 0); MASKT(pA0, pA1, 0); partialSM(pA0, pA1, m_reg, mnA, alA);
    if (NT > 1) { VMW(); SWRITE_H(1, Ch); }
    __syncthreads();
#define HALF_STEP(PX0, PX1, mnX, alX, PY0, PY1, alY, t, KB, VB, SB) do {                                                      \
        SBAR(); qkt<KB>(PX0, PX1, K_lds, r32, hi, S.qr, qw);                                                         \
        finishSM(PY0, PY1, alY, l_reg, pa0, pa1, pa2, pa3); SBAR();                                                           \
        if ((t) + 1 < NT) { SLOAD_H(Kh, Vh, Ch, KBASE((t) + 1)); SBAR(); }                                                    \
        pv_tile<VB>(o, vb0, pa0, pa1, pa2, pa3); BIAST(PX0, PX1, KB); MASKT(PX0, PX1, (t)); partialSM(PX0, PX1, m_reg, mnX, alX); \
        __syncthreads();                                                                                                      \
        if ((t) + 1 < NT) { VMW(); SWRITE_H(SB, Ch); }                                                                        \
        RESC(alX); __syncthreads(); } while (0)
    for (int t = 1; t + 1 < NT; t += 2) {
        HALF_STEP(pB0, pB1, mnB, alB, pA0, pA1, alA, t, 1, 0, 0);
        HALF_STEP(pA0, pA1, mnA, alA, pB0, pB1, alB, t + 1, 0, 1, 1);
    }
    const bool even = (NT & 1) == 0;
    if (even) { SBAR(); qkt<1>(pB0, pB1, K_lds, r32, hi, S.qr, qw); SBAR(); }
    SLOAD_H(nxt.K, nxt.V, nxt.cum, nxt.jlo * KVBLK); SBAR();
#pragma unroll
    for (int d0 = 0; d0 < 8; ++d0) S.qr[d0] = load8(nxt.Q + (size_t)(wid * QBLK + r32) * D + d0 * 16 + hi * 8);
    SBAR();
    finishSM(pA0, pA1, alA, l_reg, pa0, pa1, pa2, pa3); SBAR();
    pv_tile<0>(o, vb0, pa0, pa1, pa2, pa3);
    if (even) { BIAST(pB0, pB1, 1); MASKT(pB0, pB1, NT - 1); partialSM(pB0, pB1, m_reg, mnB, alB); __syncthreads(); RESC(alB);
        finishSM(pB0, pB1, alB, l_reg, pa0, pa1, pa2, pa3); SBAR(); pv_tile<1>(o, vb0, pa0, pa1, pa2, pa3); }
    SBAR(); SEAM_K0();
    if (hi == 0) li_l[r32] = l_reg; asm volatile("s_waitcnt lgkmcnt(0)" ::: "memory");
    float rli[16];
#pragma unroll
    for (int r = 0; r < 16; ++r) rli[r] = __builtin_amdgcn_rcpf(li_l[crow(r, hi)]);
    float* Ow = cur.O + (size_t)(wid * QBLK) * D;
#pragma unroll
    for (int r = 0; r < 16; ++r) { const int orow = crow(r, hi);
#pragma unroll
        for (int d0 = 0; d0 < 4; ++d0) Ow[(size_t)orow * D + d0 * 32 + r32] = o[d0][r] * rli[r]; }
    __syncthreads();
#undef RESC
#undef KBASE
#undef MASKT
#undef BIAST
#undef SEAM_K0
#undef HALF_STEP
}
#undef ROW
#undef VMW
#undef VMWN
#undef SLOAD_H
#undef SWRITE_HK
#undef SWRITE_HV
#undef SWRITE_H
struct Ref2 { const bf16_t* Q; const bf16_t* K; const bf16_t* V0; const bf16_t* V1; float* O0; float* O1; int P0; };
constexpr int A2_V = 0, A2_K = 65536, A2_WS = 98304, A2_Q = 100352, A2_NQ = 8, A2_LDS_BYTES = A2_Q + NW * (8 - A2_NQ) * 1024;
template <int KB>
__device__ __forceinline__ void qkt2(f32x16& p0, f32x16& p1, const char* K_lds, int r32, int hi, const bf16x8* qr, const char* qw) {
    p0 = f32x16{}; p1 = f32x16{};
    const char* kb[4];
#pragma unroll
    for (int dd = 0; dd < 4; ++dd) kb[dd] = K_lds + KB * SHM_K + KSWZ(r32, (dd * 16 + hi * 8) * 2);
#pragma unroll
    for (int d0 = 0; d0 < 8; ++d0) { const char* a = kb[d0 & 3] + (d0 >> 2) * 128;
        bf16x8 b0 = *reinterpret_cast<const bf16x8*>(a);
        bf16x8 b1 = *reinterpret_cast<const bf16x8*>(a + 32 * 256);
        bf16x8 qf; if (d0 < A2_NQ) qf = qr[d0]; else qf = *reinterpret_cast<const bf16x8*>(qw + (d0 - A2_NQ) * 1024);
        p0 = __builtin_amdgcn_mfma_f32_32x32x16_bf16(b0, qf, p0, 0, 0, 0);
        p1 = __builtin_amdgcn_mfma_f32_32x32x16_bf16(b1, qf, p1, 0, 0, 0); }
}
template <int VB, int E>
__device__ __forceinline__ void pv2(f32x16* o, int vb0, bf16x8 pa0, bf16x8 pa1, bf16x8 pa2, bf16x8 pa3) {
#define TRRD(dst, off) asm volatile("ds_read_b64_tr_b16 %0, %1 offset:%2" : "=&v"(dst) : "v"(vb0), "i"(off) : "memory")
#define PV_D0(d0) do { s16x4 l0, l1, l2, l3, h0, h1, h2, h3; constexpr int b_ = VB * 32768 + E * 16384 + v_rd_off(d0, 0, 0); \
        TRRD(l0, b_); TRRD(h0, b_ + 2048); TRRD(l1, b_ + 4096); TRRD(h1, b_ + 6144); TRRD(l2, b_ + 8192); TRRD(h2, b_ + 10240); TRRD(l3, b_ + 12288); TRRD(h3, b_ + 14336); \
        asm volatile("s_waitcnt lgkmcnt(0)" ::: "memory"); SBAR();   \
        o[d0] = __builtin_amdgcn_mfma_f32_32x32x16_bf16(pa0, (bf16x8){l0[0], l0[1], l0[2], l0[3], h0[0], h0[1], h0[2], h0[3]}, o[d0], 0, 0, 0);   \
        o[d0] = __builtin_amdgcn_mfma_f32_32x32x16_bf16(pa1, (bf16x8){l1[0], l1[1], l1[2], l1[3], h1[0], h1[1], h1[2], h1[3]}, o[d0], 0, 0, 0);   \
        o[d0] = __builtin_amdgcn_mfma_f32_32x32x16_bf16(pa2, (bf16x8){l2[0], l2[1], l2[2], l2[3], h2[0], h2[1], h2[2], h2[3]}, o[d0], 0, 0, 0);   \
        o[d0] = __builtin_amdgcn_mfma_f32_32x32x16_bf16(pa3, (bf16x8){l3[0], l3[1], l3[2], l3[3], h3[0], h3[1], h3[2], h3[3]}, o[d0], 0, 0, 0); } while (0)
    PV_D0(0); PV_D0(1); PV_D0(2); PV_D0(3);
#undef PV_D0
#undef TRRD
}
__device__ __forceinline__ void attn2_item(const Ref2& R, char* lds, const int tid_in) {
    int tid = tid_in; asm volatile("" : "+v"(tid));
    const int wid = __builtin_amdgcn_readfirstlane(tid >> 6), lane = tid & 63, r32 = lane & 31, hi = lane >> 5;
    const int NT = (R.P0 + QB) / KVBLK;
    const int qlo = R.P0 + wid * QBLK, qm = qlo + r32 - 4 * hi;
    char* V_lds = lds + A2_V; char* K_lds = lds + A2_K;
    float* ws = (float*)(lds + A2_WS) + wid * 64; float* li_l = ws, * al_l = ws + 32;
    char* qw = lds + A2_Q + wid * ((8 - A2_NQ) * 1024) + lane * 16;
    const int vb0 = (int)(uintptr_t)V_lds + v_rd_base(lane);
    unsigned koff[2], voff[2];
#pragma unroll
    for (int i = 0; i < 2; ++i) {
        { const int row = 8 * wid + 4 * i + (lane >> 4), c = (lane & 15) ^ (row & 7); koff[i] = (unsigned)(row * 256 + c * 16); }
        { const int p = 2 * wid + i, st = 2 * p + (lane >> 5), ch = lane & 31, kk = (st >> 2) * 8 + (ch >> 2), c8 = (st & 3) * 4 + (ch & 3);
          const int k = (kk & ~0xC) | ((kk & 4) << 1) | ((kk & 8) >> 1); voff[i] = (unsigned)(k * 256 + c8 * 16); } }
#define DMA2(gbase, k0, ldsbase, off) do { _Pragma("unroll") for (int i_ = 0; i_ < 2; ++i_) \
        __builtin_amdgcn_global_load_lds((const unsigned*)((const char*)(gbase) + (size_t)(k0) * 256 + (off)[i_]), (__attribute__((address_space(3))) unsigned*)((ldsbase) + (2 * wid + i_) * 1024), 16, 0, 0); } while (0)
#define STAGE2(k0, B) do { DMA2(R.K, k0, K_lds + (B) * SHM_K, koff); DMA2(R.V0, k0, V_lds + (B) * 32768, voff); DMA2(R.V1, k0, V_lds + (B) * 32768 + 16384, voff); } while (0)
    bf16x8 qr[A2_NQ];
    STAGE2(0, 0);
#pragma unroll
    for (int d0 = 0; d0 < 8; ++d0) { const bf16x8 qf = load8(R.Q + (size_t)(wid * QBLK + r32) * D + d0 * 16 + hi * 8);
        if (d0 < A2_NQ) qr[d0] = qf; else *reinterpret_cast<bf16x8*>(qw + (d0 - A2_NQ) * 1024) = qf; }
    asm volatile("s_waitcnt vmcnt(0)" ::: "memory");
    __syncthreads();
    float m_reg = -1e30f, l_reg = 0; f32x16 o[8] = {};
#define RESC2(a) do { if (__any((a) < 1.f)) { if (hi == 0) al_l[r32] = (a); asm volatile("s_waitcnt lgkmcnt(0)" ::: "memory");              \
                     for (int d_ = 0; d_ < 8; ++d_) for (int r = 0; r < 16; ++r) o[d_][r] *= al_l[crow(r, hi)]; } } while (0)
#define STEP2(t, B) do { if ((t) + 1 < NT) STAGE2(((t) + 1) * KVBLK, 1 - B);               \
        SBAR(); f32x16 p0, p1; qkt2<B>(p0, p1, K_lds, r32, hi, qr, qw);                                                                \
        { const int kb_ = (t) * KVBLK; if (kb_ + KVBLK - 1 > qlo) mask_tile(p0, p1, qm - kb_); }                                         \
        float mn_, al_; bf16x8 pa0, pa1, pa2, pa3;                                                                                     \
        partialSM(p0, p1, m_reg, mn_, al_); finishSM(p0, p1, al_, l_reg, pa0, pa1, pa2, pa3); RESC2(al_); SBAR();                      \
        pv2<B, 0>(o, vb0, pa0, pa1, pa2, pa3); pv2<B, 1>(o + 4, vb0, pa0, pa1, pa2, pa3);                                                \
        asm volatile("s_waitcnt vmcnt(0)" ::: "memory"); __syncthreads(); } while (0)
    for (int t = 0; t < NT; t += 2) { STEP2(t, 0); STEP2(t + 1, 1); }
    if (hi == 0) li_l[r32] = l_reg; asm volatile("s_waitcnt lgkmcnt(0)" ::: "memory");
    float rli[16];
#pragma unroll
    for (int r = 0; r < 16; ++r) rli[r] = __builtin_amdgcn_rcpf(li_l[crow(r, hi)]);
    float* Ow0 = R.O0 + (size_t)(wid * QBLK) * D; float* Ow1 = R.O1 + (size_t)(wid * QBLK) * D;
#pragma unroll
    for (int r = 0; r < 16; ++r) { const int orow = crow(r, hi);
#pragma unroll
        for (int d0 = 0; d0 < 4; ++d0) { Ow0[(size_t)orow * D + d0 * 32 + r32] = o[d0][r] * rli[r]; Ow1[(size_t)orow * D + d0 * 32 + r32] = o[4 + d0][r] * rli[r]; } }
    asm volatile("s_waitcnt vmcnt(0)" ::: "memory");
    __syncthreads();
#undef STEP2
#undef RESC2
#undef STAGE2
#undef DMA2
}
}

constexpr size_t MiB = 1u << 20;
constexpr size_t WS_CTL = 0, CTL_ZERO_BYTES = 1 * MiB;
constexpr size_t SZ_WIN = (size_t)DIN_PAD * DM * 2, SZ_WOUT = (size_t)DM * DM * 2, SZ_WFF = (size_t)DFF * DM * 2;
constexpr size_t WS_WIN = 1 * MiB, WS_WOUT = WS_WIN + SZ_WIN, WS_WG = WS_WOUT + SZ_WOUT, WS_WU = WS_WG + SZ_WFF, WS_WD = WS_WU + SZ_WFF;
constexpr size_t WS_H = WS_WD + SZ_WFF;
constexpr size_t WS_P = WS_H + (size_t)M * DM * 2;
constexpr size_t SZ_P = (size_t)NSLAB * M * 128 * 2;
constexpr size_t WS_PS = WS_P + SZ_P;
constexpr size_t WS_Y = WS_PS + (size_t)M * 32 * 4;
constexpr size_t WS_X = WS_Y + (size_t)M * DM * 2;
constexpr size_t WS_OB = WS_X;
constexpr int REC_W = 0, REC_QG = 16384, REC_AQK = 32768, REC_KD = 40960, REC_DMA = 57344, REC_U = 57344, REC_BYTES = 90112;
constexpr size_t WS_DREC = WS_OB + (size_t)24 * M * 128 * 4;
constexpr size_t WS_DL = WS_DREC + (size_t)2048 * REC_BYTES;
constexpr size_t WS_DO = WS_DL + (size_t)2048 * 4;
constexpr size_t WS_CUM = WS_DO + (size_t)M * 8 * 128 * 4;
constexpr size_t WS_XEND = WS_CUM + (size_t)16 * T * 4;
constexpr size_t WS_XB = (WS_XEND + 255) / 256 * 256;
constexpr size_t WS_END = WS_XB + (size_t)M * DM * 2;
static_assert(SZ_P >= (size_t)M * DFF * 2, "gate overlays P");
static_assert(WS_XEND - WS_X >= (size_t)M * DFF * 2, "act overlays region X");
static_assert(WS_WIN % 256 == 0 && WS_H % 256 == 0 && WS_P % 256 == 0 && WS_Y % 256 == 0 && WS_X % 256 == 0, "alignment");
constexpr int CW_BAR = 4096, CW_Q = 8192, CW_NRM = 32768, CW_CV = 16384;
constexpr int LDS_BYTES = 163840, MISC_OFF = LDS_BYTES - 512;
static_assert(att::A2_LDS_BYTES <= MISC_OFF - 2048 && att::ATT_LDS_BYTES <= MISC_OFF - 2048, "attention LDS maps");
constexpr int NWAVES = 8;
typedef unsigned short bf16_t;
typedef unsigned u32x4 __attribute__((ext_vector_type(4)));
typedef unsigned u32x2 __attribute__((ext_vector_type(2)));
typedef float f32x2 __attribute__((ext_vector_type(2)));

struct Args { const float* in[21]; float* out; unsigned char* ws; int ph_lo, ph_hi; };
#define CAS __attribute__((address_space(4)))
typedef const CAS Args* ArgP;
enum { I_X = 0, I_ATTN_NORM, I_W_IN, I_SC_CONV, I_LQ1, I_LK1, I_LQ2, I_LK2, I_DIFF_NORM, I_DN_CONV, I_DN_ALOG, I_DN_DTB, I_DN_NORM, I_FOX_BIAS, I_W_OUT, I_FFN_NORM, I_W_GATE, I_W_UP, I_FFN_CONV, I_W_DOWN, I_FINAL_NORM };

__device__ __forceinline__ float shx(float v, int o, int lane) { return __int_as_float(__builtin_amdgcn_ds_bpermute((lane ^ o) << 2, __float_as_int(v))); }
__device__ __forceinline__ float shup(float v, int o, int lane) { return __int_as_float(__builtin_amdgcn_ds_bpermute(((lane - o) & 63) << 2, __float_as_int(v))); }
__device__ __forceinline__ float shlane(float v, int src) { return __int_as_float(__builtin_amdgcn_ds_bpermute(src << 2, __float_as_int(v))); }
__device__ __forceinline__ float wave_sum(float v, int lane) {
#pragma unroll
    for (int o = 1; o < 64; o <<= 1) v += shx(v, o, lane);
    return v;
}
__device__ __forceinline__ float silu_f(float x) { return x / (1.0f + __expf(-x)); }
__device__ __forceinline__ unsigned pkbf(float lo, float hi) { return pg8::cvt_pk_bf16(lo, hi); }

__host__ __device__ __forceinline__ int win_src(int n) {
    if (n < 10240) return n;
    if (n < 13312) return n + 16;
    const int j = n - 13312;
    if (j < 16) return 10240 + j;
    if (j < 24) return 13328 + (j - 16);
    return -1;
}
constexpr int NI_IN = (DM / 64) * (DIN_PAD / 64), NI_OUT = (DM / 64) * (DM / 64), NI_FF = (DM / 64) * (DFF / 64);
constexpr int CV_TOTAL0 = NI_IN, CV_TOTAL1 = NI_OUT + 3 * NI_FF + NI_IN, CV_TOTAL2 = NI_OUT + 3 * NI_FF;
constexpr int CV_SCR = 64 * 68 * 4;
struct CvItem { const float* W; bf16_t* WT; int Nsrc, K, k0, n0, remap; };
__device__ __forceinline__ CvItem cv_decode(ArgP A, int sel, int r) {
    unsigned char* ws = A->ws; const int l = sel == 2 ? 1 : 0; CvItem it;
    if (sel == 0) { it.W = A->in[I_W_IN]; it.WT = (bf16_t*)(ws + WS_WIN); it.Nsrc = DIN_SRC; it.K = DM; it.k0 = 64 * (r / (DIN_PAD / 64)); it.n0 = 64 * (r % (DIN_PAD / 64)); it.remap = 1; return it; }
    if (r < NI_OUT) { it.W = A->in[I_W_OUT] + (size_t)l * DM * DM; it.WT = (bf16_t*)(ws + WS_WOUT); it.Nsrc = DM; it.K = DM; it.k0 = 64 * (r / (DM / 64)); it.n0 = 64 * (r % (DM / 64)); it.remap = 0; return it; } r -= NI_OUT;
    if (r < NI_FF) { it.W = A->in[I_W_GATE] + (size_t)l * DM * DFF; it.WT = (bf16_t*)(ws + WS_WG); it.Nsrc = DFF; it.K = DM; it.k0 = 64 * (r / (DFF / 64)); it.n0 = 64 * (r % (DFF / 64)); it.remap = 0; return it; } r -= NI_FF;
    if (r < NI_FF) { it.W = A->in[I_W_UP] + (size_t)l * DM * DFF; it.WT = (bf16_t*)(ws + WS_WU); it.Nsrc = DFF; it.K = DM; it.k0 = 64 * (r / (DFF / 64)); it.n0 = 64 * (r % (DFF / 64)); it.remap = 0; return it; } r -= NI_FF;
    if (r < NI_FF) { it.W = A->in[I_W_DOWN] + (size_t)l * DFF * DM; it.WT = (bf16_t*)(ws + WS_WD); it.Nsrc = DM; it.K = DFF; it.k0 = 64 * (r / (DM / 64)); it.n0 = 64 * (r % (DM / 64)); it.remap = 0; return it; } r -= NI_FF;
    it.W = A->in[I_W_IN] + (size_t)DM * DIN_SRC; it.WT = (bf16_t*)(ws + WS_WIN); it.Nsrc = DIN_SRC; it.K = DM; it.k0 = 64 * (r / (DIN_PAD / 64)); it.n0 = 64 * (r % (DIN_PAD / 64)); it.remap = 1; return it;
}
__device__ __forceinline__ void cv_load(const CvItem& it, int lane, f32x4 (&v)[16]) {
    const int nl = 4 * (lane & 15), kr = lane >> 4;
    int sc = it.n0 + nl; if (it.remap) sc = win_src(it.n0 + nl);
#pragma unroll
    for (int i = 0; i < 16; ++i) { v[i] = (f32x4){0.f, 0.f, 0.f, 0.f}; if (sc >= 0) v[i] = *(const f32x4*)(it.W + (size_t)(it.k0 + 4 * i + kr) * it.Nsrc + sc); }
}
__device__ __forceinline__ void cv_store(const CvItem& it, LAS float* scr, int lane, const f32x4 (&v)[16]) {
    const int c4 = lane & 15, kr = lane >> 4;
#pragma unroll
    for (int i = 0; i < 16; ++i) *(LAS f32x4*)(scr + (4 * i + kr) * 68 + 4 * (c4 ^ (i >> 1))) = v[i];
    LDS_WAIT(); asm volatile("" ::: "memory");
    const int kc = lane & 7, nn = lane >> 3;
#pragma unroll
    for (int j = 0; j < 8; ++j) { const int n = nn + 8 * j; const LAS float* s = scr + (8 * kc) * 68 + 4 * ((n >> 2) ^ kc) + (n & 3);
        u32x4 o; o.x = pkbf(s[0 * 68], s[1 * 68]); o.y = pkbf(s[2 * 68], s[3 * 68]); o.z = pkbf(s[4 * 68], s[5 * 68]); o.w = pkbf(s[6 * 68], s[7 * 68]);
        *(u32x4*)(it.WT + (size_t)(it.n0 + n) * it.K + it.k0 + 8 * kc) = o; }
    LDS_WAIT(); asm volatile("" ::: "memory");
}
__device__ __forceinline__ void cv_run(ArgP A, int sel, int first, int n, int stride, LAS float* scr, int lane) {
    if (n <= 0) return;
    f32x4 va[16], vb[16];
    CvItem ia = cv_decode(A, sel, first), ib = ia;
    cv_load(ia, lane, va);
    for (int i = 0; i < n; i += 2) {
        if (i + 1 < n) { ib = cv_decode(A, sel, first + (i + 1) * stride); cv_load(ib, lane, vb); }
        cv_store(ia, scr, lane, va);
        if (i + 1 < n) {
            if (i + 2 < n) { ia = cv_decode(A, sel, first + (i + 2) * stride); cv_load(ia, lane, va); }
            cv_store(ib, scr, lane, vb); }
    }
}
__device__ __forceinline__ void phase_convert(ArgP A, LAS unsigned char* lds, int gw, int NGW, int wave, int lane) {
    LAS float* scr = (LAS float*)(lds + wave * CV_SCR);
    const int n = gw < CV_TOTAL0 ? (CV_TOTAL0 - gw + NGW - 1) / NGW : 0;
    cv_run(A, 0, gw, n, NGW, scr, lane);
}
__device__ __forceinline__ void conv_burst(ArgP A, int sel, unsigned* head, LAS unsigned char* lds, const int tid_in, int nchunks) {
    int tid = tid_in; asm volatile("" : "+v"(tid));
    const int lane = tid & 63, wave = __builtin_amdgcn_readfirstlane(tid >> 6), total = sel == 1 ? CV_TOTAL1 : CV_TOTAL2;
    LAS float* scr = (LAS float*)(lds + wave * CV_SCR);
    __syncthreads();
    for (int c = 0; c < nchunks; ++c) {
        int base = 0; if (lane == 0) base = (int)__hip_atomic_fetch_add(head, 8u, __ATOMIC_RELAXED, __HIP_MEMORY_SCOPE_AGENT);
        base = __builtin_amdgcn_readfirstlane(base);
        if (base >= total) break;
        cv_run(A, sel, base, total - base < 8 ? total - base : 8, 1, scr, lane);
    }
    asm volatile("s_waitcnt vmcnt(0)" ::: "memory");
    __syncthreads();
}
__device__ __forceinline__ void phase_norm(const float* x, const float* g, bf16_t* h, int gw, int NGW, int lane) {
    f32x4 gv[16];
#pragma unroll
    for (int j = 0; j < 16; ++j) gv[j] = *((const f32x4*)g + lane + 64 * j);
    for (int m = gw; m < M; m += NGW) {
        const f32x4* xr = (const f32x4*)(x + (size_t)m * DM) + lane;
        f32x4 v[16]; float s = 0.f;
#pragma unroll
        for (int j = 0; j < 16; ++j) { v[j] = xr[64 * j]; s += (v[j][0] * v[j][0] + v[j][1] * v[j][1]) + (v[j][2] * v[j][2] + v[j][3] * v[j][3]); }
        const float rs = rsqrtf(wave_sum(s, lane) * (1.0f / DM) + EPS);
        u32x2* o = (u32x2*)(h + (size_t)m * DM) + lane;
#pragma unroll
        for (int j = 0; j < 16; ++j) { u32x2 w; w.x = pkbf(v[j][0] * rs * gv[j][0], v[j][1] * rs * gv[j][1]); w.y = pkbf(v[j][2] * rs * gv[j][2], v[j][3] * rs * gv[j][3]); o[64 * j] = w; }
    }
}
__device__ __forceinline__ void phase_norm_b(const bf16_t* x, const float* g, bf16_t* h, int gw, int NGW, int lane) {
    for (int m = gw; m < M; m += NGW) {
        const u32x4* xr = (const u32x4*)(x + (size_t)m * DM) + lane;
        u32x4 w[8]; float s = 0.f;
#pragma unroll
        for (int j = 0; j < 8; ++j) w[j] = xr[64 * j];
#pragma unroll
        for (int j = 0; j < 8; ++j)
#pragma unroll
            for (int q = 0; q < 4; ++q) { const float a = pg8::bf_lo(w[j][q]), b = pg8::bf_hi(w[j][q]); s += a * a + b * b; }
        const float rs = rsqrtf(wave_sum(s, lane) * (1.0f / DM) + EPS);
        u32x4* o = (u32x4*)(h + (size_t)m * DM) + lane;
#pragma unroll
        for (int j = 0; j < 8; ++j) { const f32x4 g0 = *((const f32x4*)g + 2 * (lane + 64 * j)), g1 = *((const f32x4*)g + 2 * (lane + 64 * j) + 1); u32x4 r;
            r.x = pkbf(pg8::bf_lo(w[j].x) * rs * g0[0], pg8::bf_hi(w[j].x) * rs * g0[1]); r.y = pkbf(pg8::bf_lo(w[j].y) * rs * g0[2], pg8::bf_hi(w[j].y) * rs * g0[3]);
            r.z = pkbf(pg8::bf_lo(w[j].z) * rs * g1[0], pg8::bf_hi(w[j].z) * rs * g1[1]); r.w = pkbf(pg8::bf_lo(w[j].w) * rs * g1[2], pg8::bf_hi(w[j].w) * rs * g1[3]);
            o[64 * j] = r; }
    }
}
__device__ __forceinline__ void phase_final_norm_b(const bf16_t* x, float* out, const float* g, int gw, int NGW, int lane) {
    for (int m = gw; m < M; m += NGW) {
        const u32x4* xr = (const u32x4*)(x + (size_t)m * DM) + lane;
        u32x4 w[8]; float s = 0.f;
#pragma unroll
        for (int j = 0; j < 8; ++j) w[j] = xr[64 * j];
#pragma unroll
        for (int j = 0; j < 8; ++j)
#pragma unroll
            for (int q = 0; q < 4; ++q) { const float a = pg8::bf_lo(w[j][q]), b = pg8::bf_hi(w[j][q]); s += a * a + b * b; }
        const float rs = rsqrtf(wave_sum(s, lane) * (1.0f / DM) + EPS);
        f32x4* o = (f32x4*)(out + (size_t)m * DM) + 2 * lane;
#pragma unroll
        for (int j = 0; j < 8; ++j) { const f32x4 g0 = *((const f32x4*)g + 2 * (lane + 64 * j)), g1 = *((const f32x4*)g + 2 * (lane + 64 * j) + 1);
            o[128 * j] = (f32x4){pg8::bf_lo(w[j].x) * rs * g0[0], pg8::bf_hi(w[j].x) * rs * g0[1], pg8::bf_lo(w[j].y) * rs * g0[2], pg8::bf_hi(w[j].y) * rs * g0[3]};
            o[128 * j + 1] = (f32x4){pg8::bf_lo(w[j].z) * rs * g1[0], pg8::bf_hi(w[j].z) * rs * g1[1], pg8::bf_lo(w[j].w) * rs * g1[2], pg8::bf_hi(w[j].w) * rs * g1[3]}; }
    }
}
__device__ __forceinline__ void phase_final_norm(float* x, const float* g, int gw, int NGW, int lane) {
    f32x4 gv[16];
#pragma unroll
    for (int j = 0; j < 16; ++j) gv[j] = *((const f32x4*)g + lane + 64 * j);
    for (int m = gw; m < M; m += NGW) {
        f32x4* xr = (f32x4*)(x + (size_t)m * DM) + lane;
        f32x4 v[16]; float s = 0.f;
#pragma unroll
        for (int j = 0; j < 16; ++j) { v[j] = xr[64 * j]; s += (v[j][0] * v[j][0] + v[j][1] * v[j][1]) + (v[j][2] * v[j][2] + v[j][3] * v[j][3]); }
        const float rs = rsqrtf(wave_sum(s, lane) * (1.0f / DM) + EPS);
#pragma unroll
        for (int j = 0; j < 16; ++j) xr[64 * j] = v[j] * rs * gv[j];
    }
}
__device__ __forceinline__ void small_gemm(const bf16_t* H, const bf16_t* WT, float* psmall, LAS unsigned char* lds, int bid, const int tid_in) {
    int tid = tid_in; asm volatile("" : "+v"(tid));
    const int lane = tid & 63, wave = __builtin_amdgcn_readfirstlane(tid >> 6), fr = lane & 15, fq = lane >> 4;
    const bf16_t* ap = H + (size_t)(bid * 64 + fr) * DM + wave * 512 + 8 * fq;
    const bf16_t* bp = WT + (size_t)(13312 + fr) * DM + wave * 512 + 8 * fq;
    f32x4 acc[4][2];
#pragma unroll
    for (int m = 0; m < 4; ++m) { acc[m][0] = (f32x4){0.f, 0.f, 0.f, 0.f}; acc[m][1] = (f32x4){0.f, 0.f, 0.f, 0.f}; }
#pragma unroll 1
    for (int kb = 0; kb < 512; kb += 128) {
        bf16x8 a[4][4], b[4][2];
#pragma unroll
        for (int j = 0; j < 4; ++j) {
#pragma unroll
            for (int m = 0; m < 4; ++m) a[j][m] = *(const bf16x8*)(ap + (size_t)(16 * m) * DM + kb + 32 * j);
            b[j][0] = *(const bf16x8*)(bp + kb + 32 * j); b[j][1] = *(const bf16x8*)(bp + (size_t)16 * DM + kb + 32 * j); }
#pragma unroll
        for (int j = 0; j < 4; ++j)
#pragma unroll
            for (int m = 0; m < 4; ++m) { acc[m][0] = __builtin_amdgcn_mfma_f32_16x16x32_bf16(a[j][m], b[j][0], acc[m][0], 0, 0, 0); acc[m][1] = __builtin_amdgcn_mfma_f32_16x16x32_bf16(a[j][m], b[j][1], acc[m][1], 0, 0, 0); }
    }
    LAS float* red = (LAS float*)lds;
    __syncthreads();
#pragma unroll
    for (int m = 0; m < 4; ++m)
#pragma unroll
        for (int c = 0; c < 2; ++c)
#pragma unroll
            for (int i = 0; i < 4; ++i) red[(wave * 64 + 16 * m + 4 * fq + i) * 32 + 16 * c + fr] = acc[m][c][i];
    __syncthreads();
    { const int row = tid >> 3, c4 = 4 * (tid & 7); f32x4 s = *(const LAS f32x4*)(red + row * 32 + c4);
#pragma unroll
      for (int w = 1; w < 8; ++w) { const f32x4 t = *(const LAS f32x4*)(red + (w * 64 + row) * 32 + c4); s[0] += t[0]; s[1] += t[1]; s[2] += t[2]; s[3] += t[3]; }
      *(f32x4*)(psmall + (size_t)(bid * 64 + row) * 32 + c4) = s; }
    __syncthreads();
}
__device__ __forceinline__ void unpack8(const u32x4 w, float* f) {
#pragma unroll
    for (int q = 0; q < 4; ++q) { f[2 * q] = pg8::bf_lo(w[q]); f[2 * q + 1] = pg8::bf_hi(w[q]); }
}
__device__ __forceinline__ void phase_prep(ArgP A, int l, LAS float* red, int gtid, int NGT, int gw, int NGW, int lane) {
    unsigned char* ws = A->ws;
    const bf16_t* P = (const bf16_t*)(ws + WS_P); const float* PS = (const float*)(ws + WS_PS); bf16_t* Y = (bf16_t*)(ws + WS_Y);
    { const float* cw = A->in[I_SC_CONV] + (size_t)l * 3 * 1024;
      for (int it = gtid; it < (M / 16) * 128; it += NGT) {
          const int c8 = (it & 127) * 8, slab = c8 >> 7, cc = c8 & 127, m0 = (it >> 7) * 16;
          const bf16_t* ph = P + ((size_t)(0 + slab) * M + m0) * 128 + cc; const bf16_t* pc = P + ((size_t)(8 + slab) * M + m0) * 128 + cc; const bf16_t* pb = P + ((size_t)(16 + slab) * M + m0) * 128 + cc;
          float w[3][8];
#pragma unroll
          for (int j = 0; j < 3; ++j) { const f32x4 wa = *(const f32x4*)(cw + j * 1024 + c8), wb = *(const f32x4*)(cw + j * 1024 + c8 + 4);
#pragma unroll
              for (int i = 0; i < 4; ++i) { w[j][i] = wa[i]; w[j][4 + i] = wb[i]; } }
          float p0[8], p1[8];
          u32x4 H[4], C[4], B[4], h0 = {0u, 0u, 0u, 0u}, c0 = h0, h1 = h0, c1 = h0;
          if ((m0 & (T - 1)) != 0) { h0 = *(const u32x4*)(ph - 256); c0 = *(const u32x4*)(pc - 256); h1 = *(const u32x4*)(ph - 128); c1 = *(const u32x4*)(pc - 128); }
#pragma unroll
          for (int r = 0; r < 4; ++r) { H[r] = *(const u32x4*)(ph + r * 128); C[r] = *(const u32x4*)(pc + r * 128); B[r] = *(const u32x4*)(pb + r * 128); }
          { float a[8], b[8]; unpack8(h0, a); unpack8(c0, b);
#pragma unroll
            for (int i = 0; i < 8; ++i) p0[i] = a[i] * b[i];
            unpack8(h1, a); unpack8(c1, b);
#pragma unroll
            for (int i = 0; i < 8; ++i) p1[i] = a[i] * b[i]; }
#pragma unroll
          for (int rb = 0; rb < 16; rb += 4) {
              u32x4 Hn[4], Cn[4], Bn[4];
              if (rb < 12) {
#pragma unroll
                  for (int r = 0; r < 4; ++r) { Hn[r] = *(const u32x4*)(ph + (rb + 4 + r) * 128); Cn[r] = *(const u32x4*)(pc + (rb + 4 + r) * 128); Bn[r] = *(const u32x4*)(pb + (rb + 4 + r) * 128); } }
#pragma unroll
              for (int r = 0; r < 4; ++r) { float a[8], b[8], bb[8], p2[8], o[8]; unpack8(H[r], a); unpack8(C[r], b); unpack8(B[r], bb);
#pragma unroll
                  for (int i = 0; i < 8; ++i) { p2[i] = a[i] * b[i]; o[i] = bb[i] * (w[0][i] * p0[i] + w[1][i] * p1[i] + w[2][i] * p2[i]); p0[i] = p1[i]; p1[i] = p2[i]; }
                  u32x4 wv; wv.x = pkbf(o[0], o[1]); wv.y = pkbf(o[2], o[3]); wv.z = pkbf(o[4], o[5]); wv.w = pkbf(o[6], o[7]);
                  *(u32x4*)(Y + (size_t)(m0 + rb + r) * DM + c8) = wv; }
              if (rb < 12) {
#pragma unroll
                  for (int r = 0; r < 4; ++r) { H[r] = Hn[r]; C[r] = Cn[r]; B[r] = Bn[r]; } }
          } } }
    { float* NRMP = (float*)(ws + WS_CTL) + CW_NRM + 32768 * l;
      LAS float* wmax = red - 32 - 256;
      float mx0 = 0.f, mx1 = 0.f;
      const bool h5 = (lane & 32) != 0, h4 = (lane & 16) != 0, h3 = (lane & 8) != 0, h2 = (lane & 4) != 0;
      const int myi = (h5 ? 8 : 0) + (h4 ? 4 : 0) + (h3 ? 2 : 0) + (h2 ? 1 : 0);
      for (int mb = gw; mb < M; mb += 4 * NGW) { unsigned raw[4][16];
#pragma unroll
        for (int k = 0; k < 4; ++k) { const int m = mb + k * NGW;
#pragma unroll
          for (int i = 0; i < 16; ++i) raw[k][i] = m < M ? *(const unsigned*)(P + ((size_t)(80 + i) * M + m) * 128 + 2 * lane) : 0u; }
#pragma unroll
        for (int k = 0; k < 4; ++k) { const int m = mb + k * NGW; float s[16];
#pragma unroll
          for (int i = 0; i < 16; ++i) { const unsigned w = raw[k][i]; const float x0 = pg8::bf_lo(w), x1 = pg8::bf_hi(w); s[i] = x0 * x0 + x1 * x1; }
          float v8[8], v4[4], v2[2];
#pragma unroll
          for (int i = 0; i < 8; ++i) v8[i] = (h5 ? s[i + 8] : s[i]) + shx(h5 ? s[i] : s[i + 8], 32, lane);
#pragma unroll
          for (int i = 0; i < 4; ++i) v4[i] = (h4 ? v8[i + 4] : v8[i]) + shx(h4 ? v8[i] : v8[i + 4], 16, lane);
#pragma unroll
          for (int i = 0; i < 2; ++i) v2[i] = (h3 ? v4[i + 2] : v4[i]) + shx(h3 ? v4[i] : v4[i + 2], 8, lane);
          float v1 = (h2 ? v2[1] : v2[0]) + shx(h2 ? v2[0] : v2[1], 4, lane);
          v1 += shx(v1, 2, lane); v1 += shx(v1, 1, lane);
          if (m < M) { if ((m >> 13) == 0) mx0 = fmaxf(mx0, v1); else mx1 = fmaxf(mx1, v1); } } }
      const int wave = gw & 7, bid = gw >> 3;
      if ((lane & 3) == 0) { wmax[wave * 32 + myi] = mx0; wmax[wave * 32 + 16 + myi] = mx1; }
      __syncthreads();
      if (wave == 0 && lane < 32) { float v = wmax[lane];
#pragma unroll
          for (int w2 = 1; w2 < 8; ++w2) v = fmaxf(v, wmax[w2 * 32 + lane]);
          NRMP[bid * 32 + lane] = v; }
      __syncthreads(); }
    { const float* fb = A->in[I_FOX_BIAS] + l * 8; float* CUM = (float*)(ws + WS_CUM);
      const int bid = gw >> 3, tid = gtid & 511, wave = gw & 7;
      if (bid < 16) { const int b = bid >> 3, h = bid & 7; const float bias = fb[h];
          const float* src = PS + (size_t)(b * T + tid * 16) * 32 + 16 + h;
          float v[16]; float tot = 0.f;
#pragma unroll
          for (int i = 0; i < 16; ++i) v[i] = src[(size_t)i * 32];
#pragma unroll
          for (int i = 0; i < 16; ++i) { const float x = v[i] + bias; tot += fminf(x, 0.f) - log1pf(expf(-fabsf(x))); v[i] = tot; }
          float incl = tot;
#pragma unroll
          for (int o = 1; o < 64; o <<= 1) { const float u = shup(incl, o, lane); if (lane >= o) incl += u; }
          if (lane == 63) red[wave] = incl;
          __syncthreads();
          float base = incl - tot;
          for (int w2 = 0; w2 < wave; ++w2) base += red[w2];
          float* dst = CUM + (size_t)bid * T + tid * 16;
#pragma unroll
          for (int q4 = 0; q4 < 4; ++q4) *(f32x4*)(dst + 4 * q4) = (f32x4){v[4 * q4] + base, v[4 * q4 + 1] + base, v[4 * q4 + 2] + base, v[4 * q4 + 3] + base};
          __syncthreads(); } }
}
typedef float f32x16 __attribute__((ext_vector_type(16)));
typedef __bf16 bf16x2n __attribute__((ext_vector_type(2)));
__device__ __forceinline__ unsigned pk_native(float lo, float hi) { const f32x2 v = {lo, hi}; return __builtin_bit_cast(unsigned, __builtin_convertvector(v, bf16x2n)); }
__device__ __forceinline__ bf16_t bf1(float x) { return (bf16_t)(pk_native(x, x) & 0xffffu); }
__device__ __forceinline__ float bf2f(bf16_t x) { return __uint_as_float(((unsigned)x) << 16); }
__device__ __forceinline__ int crow32(int r, int hh) { return (r & 3) + 8 * (r >> 2) + 4 * hh; }
constexpr int DP_KB = 0, DP_QB = 17408, DP_VF = 34816, DP_AM = 68608, DP_AQ = 84992, DP_WB = 94208, DP_GC = 111616;
constexpr int DP_RAWQ = 112640, DP_RAWK = DP_RAWQ + 17152, DP_RAWV = DP_AM;
static_assert(DP_RAWK + 17152 <= MISC_OFF && DP_AM + 17152 <= DP_WB, "raw tiles");
__device__ __forceinline__ void phase_dnprep(ArgP A, int l, LAS unsigned char* lds, int G, int bid, const int tid_in) {
    unsigned char* ws = A->ws;
    const bf16_t* P = (const bf16_t*)(ws + WS_P); const float* PS = (const float*)(ws + WS_PS);
    const float* cw = A->in[I_DN_CONV] + (size_t)l * 4 * 3072; const float* alog = A->in[I_DN_ALOG] + l * 8; const float* dtb = A->in[I_DN_DTB] + l * 8;
    float* DL = (float*)(ws + WS_DL);
    const int tid0 = tid_in;
    LAS bf16_t* KB = (LAS bf16_t*)(lds + DP_KB); LAS bf16_t* QB = (LAS bf16_t*)(lds + DP_QB); LAS float* VF = (LAS float*)(lds + DP_VF);
    LAS float* AM = (LAS float*)(lds + DP_AM); LAS bf16_t* AQ = (LAS bf16_t*)(lds + DP_AQ); LAS bf16_t* WB = (LAS bf16_t*)(lds + DP_WB); LAS float* GC = (LAS float*)(lds + DP_GC);
    for (int it = bid; it < 2048; it += G) {
        int tid = tid0; asm volatile("" : "+v"(tid));
        const int lane = tid & 63, wave = __builtin_amdgcn_readfirstlane(tid >> 6);
        const int bh = it >> 7, n = it & 127, b = bh >> 3, h = bh & 7, t0 = n * 64, m0 = b * T + t0;
        unsigned char* rec = ws + WS_DREC + (size_t)it * REC_BYTES;
        { int tid_s = tid0; asm volatile("" : "+v"(tid_s)); const int tid = tid_s, lane = tid_s & 63; (void)tid; (void)lane; const int tok = tid >> 3, part = tid & 7, c0 = 16 * part, t = t0 + tok, mrow = m0 + tok;
          float r[3][16];
#pragma unroll
          for (int s = 0; s < 3; ++s) {
#pragma unroll
              for (int i = 0; i < 16; ++i) r[s][i] = 0.f;
#pragma unroll
              for (int j = 0; j < 4; ++j) { const int dt = 3 - j;
                  if (t >= dt) { const bf16_t* xp = P + ((size_t)(48 + 8 * s + h) * M + (mrow - dt)) * 128 + c0; float xx[16]; unpack8(*(const u32x4*)xp, xx); unpack8(*(const u32x4*)(xp + 8), xx + 8);
                      const float* wp = cw + j * 3072 + s * 1024 + h * 128 + c0;
#pragma unroll
                      for (int q4 = 0; q4 < 4; ++q4) { const f32x4 wv = *(const f32x4*)(wp + 4 * q4);
#pragma unroll
                          for (int i = 0; i < 4; ++i) r[s][4 * q4 + i] += wv[i] * xx[4 * q4 + i]; } } }
#pragma unroll
              for (int i = 0; i < 16; ++i) r[s][i] = silu_f(r[s][i]);
          }
          float sq = 0.f, sk = 0.f;
#pragma unroll
          for (int i = 0; i < 16; ++i) { sq += r[0][i] * r[0][i]; sk += r[1][i] * r[1][i]; }
#pragma unroll
          for (int o = 1; o < 8; o <<= 1) { sq += shx(sq, o, lane); sk += shx(sk, o, lane); }
          const float rq = rsqrtf(sq + EPS) * 0.08838834764831845f, rk = rsqrtf(sk + EPS);
          u32x4 w0, w1;
#pragma unroll
          for (int i = 0; i < 4; ++i) { w0[i] = pk_native(r[0][2 * i] * rq, r[0][2 * i + 1] * rq); w1[i] = pk_native(r[0][8 + 2 * i] * rq, r[0][9 + 2 * i] * rq); }
          *(LAS u32x4*)(QB + tok * 136 + c0) = w0; *(LAS u32x4*)(QB + tok * 136 + c0 + 8) = w1;
#pragma unroll
          for (int i = 0; i < 4; ++i) { w0[i] = pk_native(r[1][2 * i] * rk, r[1][2 * i + 1] * rk); w1[i] = pk_native(r[1][8 + 2 * i] * rk, r[1][9 + 2 * i] * rk); }
          *(LAS u32x4*)(KB + tok * 136 + c0) = w0; *(LAS u32x4*)(KB + tok * 136 + c0 + 8) = w1;
#pragma unroll
          for (int q4 = 0; q4 < 4; ++q4) *(LAS f32x4*)(VF + tok * 132 + c0 + 4 * q4) = (f32x4){r[2][4 * q4], r[2][4 * q4 + 1], r[2][4 * q4 + 2], r[2][4 * q4 + 3]};
          if (part == 0) { const float a = PS[(size_t)mrow * 32 + h] + dtb[h], bi = PS[(size_t)mrow * 32 + 8 + h];
              GC[tok] = -expf(alog[h]) * (fmaxf(a, 0.f) + log1pf(expf(-fabsf(a)))); GC[64 + tok] = 1.0f / (1.0f + expf(-bi)); } }
        __syncthreads();
        if (wave == 0) { int tid_s = tid0; asm volatile("" : "+v"(tid_s)); const int tid = tid_s, lane = tid_s & 63; (void)tid; (void)lane; float inc = GC[lane];
#pragma unroll
            for (int o = 1; o < 64; o <<= 1) { const float u = shup(inc, o, lane); if (lane >= o) inc += u; }
            const float glast = shlane(inc, 63);
            GC[lane] = inc; GC[128 + lane] = __expf(inc); GC[192 + lane] = __expf(glast - inc);
            if (lane == 63) DL[it] = __expf(inc); }
        __syncthreads();
        if (wave < 6) { int tid_s = tid0; asm volatile("" : "+v"(tid_s)); const int tid = tid_s, lane = tid_s & 63; (void)tid; (void)lane; const int kind = wave >= 3 ? 1 : 0, tl = wave - 3 * kind, itile = tl ? 1 : 0, jtile = tl == 2 ? 1 : 0, c = lane & 31, hh = lane >> 5;
            const LAS bf16_t* XA = kind ? QB : KB;
            f32x16 d = {};
#pragma unroll
            for (int s = 0; s < 8; ++s) { const att::bf16x8 av = *(const LAS att::bf16x8*)(XA + (32 * itile + c) * 136 + 16 * s + 8 * hh), bv = *(const LAS att::bf16x8*)(KB + (32 * jtile + c) * 136 + 16 * s + 8 * hh);
                d = __builtin_amdgcn_mfma_f32_32x32x16_bf16(av, bv, d, 0, 0, 0); }
            const int j = 32 * jtile + c; const float gcj = GC[j];
#pragma unroll
            for (int r = 0; r < 16; ++r) { const int i = 32 * itile + crow32(r, hh); const float e = __expf(fminf(GC[i] - gcj, 0.f));
                if (kind == 0) AM[i * 64 + j] = (i > j) ? GC[64 + i] * d[r] * e : 0.f;
                else AQ[i * 72 + j] = bf1((i >= j) ? d[r] * e : 0.f); } }
        else if (wave == 6) { int tid_s = tid0; asm volatile("" : "+v"(tid_s)); const int tid = tid_s, lane = tid_s & 63; (void)tid; (void)lane; for (int q = lane; q < 1024; q += 64) AM[(q >> 5) * 64 + 32 + (q & 31)] = 0.f; }
        else { int tid_s = tid0; asm volatile("" : "+v"(tid_s)); const int tid = tid_s, lane = tid_s & 63; (void)tid; (void)lane; for (int q = lane; q < 1024; q += 64) AQ[(q >> 5) * 72 + 32 + (q & 31)] = 0; }
        __syncthreads();
        if (wave < 4) { int tid_s = tid0; asm volatile("" : "+v"(tid_s)); const int tid = tid_s, lane = tid_s & 63; (void)tid; (void)lane; const int cc = tid & 127; const bool isW = wave < 2;
            int vz = 0; asm volatile("" : "+v"(vz));
            const LAS float* AMv = AM + vz;
            float x[64];
            if (isW) {
#pragma unroll
                for (int i = 0; i < 64; ++i) x[i] = bf2f(KB[i * 136 + cc]) * (GC[64 + i] * GC[128 + i]); }
            else {
#pragma unroll
                for (int i = 0; i < 64; ++i) x[i] = VF[i * 132 + cc] * GC[64 + i]; }
            __builtin_amdgcn_sched_barrier(0);
#pragma unroll
            for (int i = 1; i < 64; ++i) {
                float s0 = x[i], s1 = 0.f, s2 = 0.f, s3 = 0.f;
#pragma unroll
                for (int j4 = 0; j4 < (i + 3) / 4; ++j4) { const f32x4 a = *(const LAS f32x4*)(AMv + i * 64 + 4 * j4);
                    s0 -= a[0] * x[4 * j4];
                    if (4 * j4 + 1 < i) s1 -= a[1] * x[4 * j4 + 1];
                    if (4 * j4 + 2 < i) s2 -= a[2] * x[4 * j4 + 2];
                    if (4 * j4 + 3 < i) s3 -= a[3] * x[4 * j4 + 3]; }
                x[i] = (s0 + s1) + (s2 + s3); if (i & 1) __builtin_amdgcn_sched_barrier(0); }
            if (isW) {
#pragma unroll
                for (int i = 0; i < 64; ++i) WB[i * 136 + cc] = bf1(-x[i]); }
            else {
#pragma unroll
                for (int i = 0; i < 64; ++i) VF[i * 132 + cc] = x[i]; } }
        else { int tid_s = tid0; asm volatile("" : "+v"(tid_s)); const int tid = tid_s, lane = tid_s & 63; (void)tid; (void)lane; const int lw = wave - 4, c = lane & 31, hh = lane >> 5;
            for (int q = 0; q < 10; ++q) { const int f = lw * 10 + q;
                if (f < 16) { const int mt = f >> 3, ks = f & 7, i = 32 * mt + c; const LAS bf16_t* rp = QB + i * 136 + 16 * ks + 4 * hh; const float e = GC[128 + i];
                    const u32x2 lo = *(const LAS u32x2*)rp, hi2 = *(const LAS u32x2*)(rp + 8);
                    u32x4 w; w.x = pk_native(pg8::bf_lo(lo.x) * e, pg8::bf_hi(lo.x) * e); w.y = pk_native(pg8::bf_lo(lo.y) * e, pg8::bf_hi(lo.y) * e);
                    w.z = pk_native(pg8::bf_lo(hi2.x) * e, pg8::bf_hi(hi2.x) * e); w.w = pk_native(pg8::bf_lo(hi2.y) * e, pg8::bf_hi(hi2.y) * e);
                    *(u32x4*)(rec + REC_QG + f * 1024 + lane * 16) = w; }
                else if (f < 32) { const int g2 = f - 16, mt = g2 >> 2, ks = g2 & 3; float v[8];
#pragma unroll
                    for (int jj = 0; jj < 8; ++jj) { const int row = 16 * ks + 8 * (jj >> 2) + 4 * hh + (jj & 3); v[jj] = bf2f(KB[row * 136 + 32 * mt + c]) * GC[192 + row]; }
                    u32x4 w; w.x = pk_native(v[0], v[1]); w.y = pk_native(v[2], v[3]); w.z = pk_native(v[4], v[5]); w.w = pk_native(v[6], v[7]);
                    *(u32x4*)(rec + REC_KD + g2 * 1024 + lane * 16) = w; }
                else { const int g2 = f - 32, mt = g2 >> 2, ks = g2 & 3; const LAS bf16_t* rp = AQ + (32 * mt + c) * 72 + 16 * ks + 4 * hh;
                    const u32x2 lo = *(const LAS u32x2*)rp, hi2 = *(const LAS u32x2*)(rp + 8);
                    *(u32x4*)(rec + REC_AQK + g2 * 1024 + lane * 16) = (u32x4){lo.x, lo.y, hi2.x, hi2.y}; } } }
        __syncthreads();
        { int tid_s = tid0; asm volatile("" : "+v"(tid_s)); const int tid = tid_s, lane = tid_s & 63; (void)tid; (void)lane; const int c = lane & 31, hh = lane >> 5;
#pragma unroll
          for (int q = 0; q < 2; ++q) { const int f = wave * 2 + q, mt = f >> 3, ks = f & 7; const LAS bf16_t* rp = WB + (32 * mt + c) * 136 + 16 * ks + 4 * hh;
              const u32x2 lo = *(const LAS u32x2*)rp, hi2 = *(const LAS u32x2*)(rp + 8);
              *(u32x4*)(rec + REC_W + f * 1024 + lane * 16) = (u32x4){lo.x, lo.y, hi2.x, hi2.y}; }
          float* U = (float*)(rec + REC_U);
#pragma unroll
          for (int q = 0; q < 4; ++q) { const int idx = tid + 512 * q, row = idx >> 5, c4 = (idx & 31) * 4; *(f32x4*)(U + row * 128 + c4) = *(const LAS f32x4*)(VF + row * 132 + c4); } }
        __syncthreads();
    }
}
__device__ __forceinline__ att::bf16x8 pack_half(const f32x16& x, const int s) {
    u32x4 p; p.x = pk_native(x[8 * s], x[8 * s + 1]); p.y = pk_native(x[8 * s + 2], x[8 * s + 3]); p.z = pk_native(x[8 * s + 4], x[8 * s + 5]); p.w = pk_native(x[8 * s + 6], x[8 * s + 7]);
    return __builtin_bit_cast(att::bf16x8, p);
}
#define DN_BAR() do { asm volatile("s_waitcnt lgkmcnt(0)" ::: "memory"); __builtin_amdgcn_s_barrier(); asm volatile("" ::: "memory"); } while (0)
__device__ __forceinline__ void phase_scan(unsigned char* ws, LAS unsigned char* lds, int bh, int tid) {
    const int lane = tid & 63, wave = __builtin_amdgcn_readfirstlane(tid >> 6);
    const unsigned char* rec0 = ws + WS_DREC + (size_t)bh * 128 * REC_BYTES;
    if (wave >= 4) {
        const int lw = wave - 4;
#pragma unroll
        for (int f = 0; f < 14; ++f) { const int fi = lw * 14 + f;
            __builtin_amdgcn_global_load_lds((const unsigned*)(rec0 + fi * 1024 + lane * 16), (LAS unsigned*)(lds + fi * 1024), 16, 0, 0); }
        asm volatile("s_waitcnt vmcnt(0)" ::: "memory"); DN_BAR();
        for (int n = 0; n < 128; ++n) {
            if (n + 1 < 128) { const unsigned char* rn = rec0 + (size_t)(n + 1) * REC_BYTES; LAS unsigned char* bn = lds + ((n + 1) & 1) * REC_DMA;
#pragma unroll
                for (int f = 0; f < 14; ++f) { const int fi = lw * 14 + f;
                    __builtin_amdgcn_global_load_lds((const unsigned*)(rn + fi * 1024 + lane * 16), (LAS unsigned*)(bn + fi * 1024), 16, 0, 0); } }
            asm volatile("s_waitcnt vmcnt(0)" ::: "memory"); DN_BAR();
        }
    } else {
        const int w = wave, c = lane & 31, hh = lane >> 5, b = bh >> 3, h = bh & 7;
        f32x16 st[4] = {}; f32x16 vn[2];
        { const float* U0 = (const float*)(rec0 + REC_U);
#pragma unroll
          for (int mt = 0; mt < 2; ++mt)
#pragma unroll
              for (int r = 0; r < 16; ++r) vn[mt][r] = U0[(32 * mt + crow32(r, hh)) * 128 + 32 * w + c]; }
        float* DO = (float*)(ws + WS_DO); const float* DL = (const float*)(ws + WS_DL) + bh * 128;
        DN_BAR();
        for (int n = 0; n < 128; ++n) {
            const LAS unsigned char* buf = lds + (n & 1) * REC_DMA + lane * 16;
            const float dl = DL[n];
            att::bf16x8 sb[8];
#pragma unroll
            for (int ks = 0; ks < 8; ++ks) sb[ks] = pack_half(st[ks >> 1], ks & 1);
            f32x16 o[2] = {};
#pragma unroll
            for (int ks = 0; ks < 8; ++ks)
#pragma unroll
                for (int mt = 0; mt < 2; ++mt) {
                    const att::bf16x8 aw = *(const LAS att::bf16x8*)(buf + REC_W + (mt * 8 + ks) * 1024), aq = *(const LAS att::bf16x8*)(buf + REC_QG + (mt * 8 + ks) * 1024);
                    vn[mt] = __builtin_amdgcn_mfma_f32_32x32x16_bf16(aw, sb[ks], vn[mt], 0, 0, 0);
                    o[mt] = __builtin_amdgcn_mfma_f32_32x32x16_bf16(aq, sb[ks], o[mt], 0, 0, 0); }
            att::bf16x8 vb[4];
#pragma unroll
            for (int k4 = 0; k4 < 4; ++k4) vb[k4] = pack_half(vn[k4 >> 1], k4 & 1);
            if (n + 1 < 128) { const float* Un = (const float*)(rec0 + (size_t)(n + 1) * REC_BYTES + REC_U);
#pragma unroll
                for (int mt = 0; mt < 2; ++mt)
#pragma unroll
                    for (int r = 0; r < 16; ++r) vn[mt][r] = Un[(32 * mt + crow32(r, hh)) * 128 + 32 * w + c]; }
#pragma unroll
            for (int k4 = 0; k4 < 4; ++k4)
#pragma unroll
                for (int mt = 0; mt < 2; ++mt) { const att::bf16x8 aa = *(const LAS att::bf16x8*)(buf + REC_AQK + (mt * 4 + k4) * 1024);
                    o[mt] = __builtin_amdgcn_mfma_f32_32x32x16_bf16(aa, vb[k4], o[mt], 0, 0, 0); }
#pragma unroll
            for (int ti = 0; ti < 4; ++ti) { st[ti] = st[ti] * dl;
#pragma unroll
                for (int k4 = 0; k4 < 4; ++k4) { const att::bf16x8 ak = *(const LAS att::bf16x8*)(buf + REC_KD + (ti * 4 + k4) * 1024);
                    st[ti] = __builtin_amdgcn_mfma_f32_32x32x16_bf16(ak, vb[k4], st[ti], 0, 0, 0); } }
#pragma unroll
            for (int mt = 0; mt < 2; ++mt)
#pragma unroll
                for (int r = 0; r < 16; ++r) DO[((size_t)(b * T + 64 * n + 32 * mt + crow32(r, hh)) * 8 + h) * 128 + 32 * w + c] = o[mt][r];
            DN_BAR();
        }
    }
}
constexpr int Q_ITEMS = 64, Q_N = 8;
__device__ __forceinline__ att::Ref2 attn_ref2(unsigned char* ws, int qx, int L) {
    const int sr = L >> 1, mm = L & 1, b = qx >> 2, h = qx & 3, qb = 31 - sr;
    const bf16_t* P = (const bf16_t*)(ws + WS_P);
    att::Ref2 R;
    R.Q = P + ((size_t)(24 + 2 * h + mm) * M + (size_t)b * T + (size_t)qb * 256) * 128;
    R.K = P + ((size_t)(32 + 2 * h + mm) * M + (size_t)b * T) * 128;
    R.V0 = P + ((size_t)(40 + 2 * h) * M + (size_t)b * T) * 128; R.V1 = P + ((size_t)(41 + 2 * h) * M + (size_t)b * T) * 128;
    R.O0 = (float*)(ws + WS_OB) + ((size_t)(4 * h + 2 * mm) * M + (size_t)b * T + (size_t)qb * 256) * 128;
    R.O1 = (float*)(ws + WS_OB) + ((size_t)(4 * h + 2 * mm + 1) * M + (size_t)b * T + (size_t)qb * 256) * 128;
    R.P0 = qb * 256;
    return R;
}
__device__ __forceinline__ att::BlockRef attn_ref(unsigned char* ws, const volatile LAS float* nrm, int qx, int L, int lane) {
    const int sr = L >> 1, ci = L & 1, b = qx >> 2, qb = 31 - sr;
    const int vh = 16 + 2 * (qx & 3) + ci;
    const int h = vh - 16; const int sq = 80 + h, sk = 88 + h, sv = 96 + h; const float* cum = (const float*)(ws + WS_CUM) + (size_t)(b * 8 + h) * T;
    const bf16_t* P = (const bf16_t*)(ws + WS_P);
    att::BlockRef R;
    R.Q = P + ((size_t)sq * M + (size_t)b * T + (size_t)qb * 256) * 128;
    R.K = P + ((size_t)sk * M + (size_t)b * T) * 128;
    R.V = P + ((size_t)sv * M + (size_t)b * T) * 128;
    R.O = (float*)(ws + WS_OB) + ((size_t)vh * M + (size_t)b * T + (size_t)qb * 256) * 128;
    R.cum = cum; R.P0 = qb * 256; R.jlo = 0;
    if (qb > 0) {
        const float q2 = nrm[(qx >> 2) * 16 + (vh - 16)], k2 = nrm[(qx >> 2) * 16 + 8 + (vh - 16)];
        const float thresh = 2.0f * sqrtf(q2 * k2) * att::SCALE + 70.0f, c0 = cum[R.P0];
        const int ntp = 4 * qb;
        const bool s0 = lane < ntp && (cum[64 * lane + 63] - c0 >= thresh), s1 = lane + 64 < ntp && (cum[64 * (lane + 64) + 63] - c0 >= thresh);
        const unsigned long long b0 = __ballot(s0), b1 = __ballot(s1);
        int j = b0 == ~0ull ? 64 + (b1 == ~0ull ? 64 : __builtin_ctzll(~b1)) : __builtin_ctzll(~b0);
        R.jlo = __builtin_amdgcn_readfirstlane(j < ntp ? j : ntp);
    }
    return R;
}
__device__ __forceinline__ int queue_pop(unsigned* heads, int x0, int& k0, int& qx, volatile LAS unsigned* slot, int tid) {
    if (tid == 0) { int k = k0, v = -1;
        for (; k < Q_N; ++k) { const unsigned got = __hip_atomic_fetch_add(heads + 64 * ((x0 + k) & (Q_N - 1)), 1u, __ATOMIC_RELAXED, __HIP_MEMORY_SCOPE_AGENT); if (got < (unsigned)Q_ITEMS) { v = (int)got; break; } }
        slot[0] = (unsigned)v; slot[1] = (unsigned)k; }
    __syncthreads();
    const int v = __builtin_amdgcn_readfirstlane((int)slot[0]); k0 = __builtin_amdgcn_readfirstlane((int)slot[1]); qx = (x0 + k0) & (Q_N - 1);
    __syncthreads();
    return v;
}
__device__ __forceinline__ void phase_mix(ArgP A, unsigned char* ws, unsigned char* lds, int qid, int bid, const int tid) {
    const int lane = tid & 63;
    volatile LAS float* nrm = (volatile LAS float*)((LAS unsigned char*)lds + MISC_OFF + 256);
    { const float* NRMP = (const float*)(ws + WS_CTL) + CW_NRM + 32768 * (qid >> 1); volatile LAS float* part = (volatile LAS float*)((LAS unsigned char*)lds + MISC_OFF - 2048);
      const int G = gridDim.x; float v = 0.f;
      for (int b2 = tid >> 5; b2 < G; b2 += 16) v = fmaxf(v, NRMP[b2 * 32 + (tid & 31)]);
      part[tid] = v;
      __syncthreads();
      if (tid < 32) { float r = part[tid];
#pragma unroll
          for (int k = 1; k < 16; ++k) r = fmaxf(r, part[k * 32 + tid]);
          nrm[tid] = r; }
      __syncthreads(); }
    if (bid < 16) { phase_scan(ws, (LAS unsigned char*)lds, bid, tid); __syncthreads(); }
    unsigned* heads = (unsigned*)(ws + WS_CTL) + CW_Q + 1024 * qid;
    volatile LAS unsigned* slot = (volatile LAS unsigned*)((LAS unsigned char*)lds + MISC_OFF) + 16;
    const int x0 = (int)(xb_xcc_id() & 7u);
    int k0 = 0, qx = 0;
    const int csel = (qid >> 1) == 0 ? 1 : 2; unsigned* chead = (unsigned*)(ws + WS_CTL) + CW_CV + 64 * qid;
    if (bid & 1) conv_burst(A, csel, chead, (LAS unsigned char*)lds, tid, 2);
    { int tv = tid; asm volatile("" : "+v"(tv));
      for (;;) { const int L = queue_pop(heads, x0, k0, qx, slot, tv); if (L < 0) break;
          const att::Ref2 R = attn_ref2(ws, qx, L); att::attn2_item(R, (char*)lds, tv);
          conv_burst(A, csel, chead, (LAS unsigned char*)lds, tv, 1); } }
    { int tv = tid; asm volatile("" : "+v"(tv)); const int lane2 = tv & 63; int k1 = 0;
      for (;;) { const int L = queue_pop(heads + 8 * 64, x0, k1, qx, slot, tv); if (L < 0) break;
          const att::BlockRef cur = attn_ref(ws, nrm, qx, L, lane2); att::Seam S; att::attn_prime(cur, (char*)lds, S, tv); att::attn_block(cur, cur, (char*)lds, S, tv);
          conv_burst(A, csel, chead, (LAS unsigned char*)lds, tv, 1); } }
    conv_burst(A, csel, chead, (LAS unsigned char*)lds, tid, 1 << 30);
}
__device__ __forceinline__ void phase_post(ArgP A, int l, int gw, int NGW, int lane) {
    unsigned char* ws = A->ws;
    const float* OB = (const float*)(ws + WS_OB); const float* DO = (const float*)(ws + WS_DO); const bf16_t* P = (const bf16_t*)(ws + WS_P); bf16_t* Y = (bf16_t*)(ws + WS_Y);
    const float lam_init = 0.8f - 0.6f * expf(-0.3f * (float)l);
    float lam;
    { const float* q1 = A->in[I_LQ1] + l * 128; const float* k1 = A->in[I_LK1] + l * 128; const float* q2 = A->in[I_LQ2] + l * 128; const float* k2 = A->in[I_LK2] + l * 128;
      const float d1 = wave_sum(q1[lane] * k1[lane] + q1[lane + 64] * k1[lane + 64], lane), d2 = wave_sum(q2[lane] * k2[lane] + q2[lane + 64] * k2[lane + 64], lane);
      lam = expf(d1) - expf(d2) + lam_init; }
    const float* dng = A->in[I_DIFF_NORM] + l * 256; const f32x4 gd = *(const f32x4*)(dng + 4 * lane);
    const float* nng = A->in[I_DN_NORM] + l * 128; const f32x2 gn = *(const f32x2*)(nng + 2 * lane);
    const float post = 1.0f - lam_init;
    const int eh = lane >> 5, ec = (4 * lane) & 127;
    for (int m = gw; m < M; m += NGW) {
        f32x4 o1[4], o2[4]; f32x2 od[8]; unsigned zz[8]; f32x2 of[8];
#pragma unroll
        for (int h = 0; h < 4; ++h) { o1[h] = *(const f32x4*)(OB + ((size_t)(4 * h + 0 + eh) * M + m) * 128 + ec); o2[h] = *(const f32x4*)(OB + ((size_t)(4 * h + 2 + eh) * M + m) * 128 + ec); }
#pragma unroll
        for (int h = 0; h < 8; ++h) { od[h] = *(const f32x2*)(DO + ((size_t)m * 8 + h) * 128 + 2 * lane); zz[h] = *(const unsigned*)(P + ((size_t)(72 + h) * M + m) * 128 + 2 * lane);
            of[h] = *(const f32x2*)(OB + ((size_t)(16 + h) * M + m) * 128 + 2 * lane); }
        bf16_t* yr = Y + (size_t)m * DM;
        float sd[4], sn[8];
#pragma unroll
        for (int h = 0; h < 4; ++h) { o1[h] = o1[h] - lam * o2[h]; sd[h] = (o1[h][0] * o1[h][0] + o1[h][1] * o1[h][1]) + (o1[h][2] * o1[h][2] + o1[h][3] * o1[h][3]); }
#pragma unroll
        for (int h = 0; h < 8; ++h) sn[h] = od[h][0] * od[h][0] + od[h][1] * od[h][1];
#pragma unroll
        for (int o = 1; o < 64; o <<= 1) {
#pragma unroll
            for (int h = 0; h < 4; ++h) sd[h] += shx(sd[h], o, lane);
#pragma unroll
            for (int h = 0; h < 8; ++h) sn[h] += shx(sn[h], o, lane); }
#pragma unroll
        for (int h = 0; h < 4; ++h) { const float rs = rsqrtf(sd[h] * (1.0f / 256.0f) + EPS) * post;
            u32x2 w; w.x = pkbf(o1[h][0] * rs * gd[0], o1[h][1] * rs * gd[1]); w.y = pkbf(o1[h][2] * rs * gd[2], o1[h][3] * rs * gd[3]);
            *(u32x2*)(yr + 1024 + h * 256 + 4 * lane) = w; }
#pragma unroll
        for (int h = 0; h < 8; ++h) { const float rs = rsqrtf(sn[h] * (1.0f / 128.0f) + EPS); const float z0 = pg8::bf_lo(zz[h]), z1 = pg8::bf_hi(zz[h]);
            *(unsigned*)(yr + 2048 + h * 128 + 2 * lane) = pkbf(od[h][0] * rs * gn[0] * silu_f(z0), od[h][1] * rs * gn[1] * silu_f(z1));
            *(unsigned*)(yr + 3072 + h * 128 + 2 * lane) = pkbf(of[h][0], of[h][1]); }
    }
}

constexpr int PH_PER_LAYER = 10, PH_FINAL = NLAYER * PH_PER_LAYER, PH_TOTAL = PH_FINAL + 1;
__global__ void __launch_bounds__(NWAVES * 64, 2) mega(Args args) {
    extern __shared__ __attribute__((aligned(16))) unsigned char lds[];
    LAS unsigned char* ldsl = (LAS unsigned char*)lds;
    const int G = gridDim.x, bid = blockIdx.x;
    const int NGW = G * NWAVES, NGT = G * NWAVES * 64;
    volatile LAS unsigned* MISC = (volatile LAS unsigned*)(ldsl + MISC_OFF);
    if (threadIdx.x < 32) MISC[threadIdx.x] = 0u;
    const int wv0 = __builtin_amdgcn_readfirstlane(threadIdx.x >> 6);
    __syncthreads();
    const int lo = args.ph_lo, hi = args.ph_hi;
    XcdBarrier bar; bar.bar = (unsigned*)(args.ws + WS_CTL) + CW_BAR; bar.x = 0; bar.st = nullptr;
    if (hi - lo > 1) bar = xcd_barrier_post((unsigned*)(args.ws + WS_CTL) + CW_BAR, MISC + 8);
#ifndef ONLY_J
#define ONLY_J -1
#endif
#define IN(k) (lo <= (k) && (k) < hi)
#define INJ(j) ((ONLY_J < 0 || ONLY_J == (j)) && IN(pb + (j)))
#define SEAM(k) do { if (IN(k) && IN((k) + 1)) xcd_barrier(bar); } while (0)
#ifndef DUP_SITE
#define DUP_SITE -1
#endif
#define NREP(j) ((DUP_SITE == (j)) ? 2 : 1)
#define SITE() ArgP A = (ArgP)__builtin_amdgcn_kernarg_segment_ptr(); asm volatile("" : "+s"(A)); unsigned char* ws = A->ws; int tid; asm volatile("v_mbcnt_lo_u32_b32 %0, -1, 0\n\tv_mbcnt_hi_u32_b32 %0, -1, %0" : "=v"(tid)); tid += wv0 * 64; \
    const int lane = tid & 63, wave = __builtin_amdgcn_readfirstlane(tid >> 6), gw = bid * NWAVES + wave, gtid = bid * (NWAVES * 64) + tid; (void)lane; (void)wave; (void)gw; (void)gtid; (void)ws
    for (int l = 0; l < NLAYER; ++l) {
        const int pb = l * PH_PER_LAYER;
        for (int rep = 0; rep < NREP(0); ++rep) { if (rep) xcd_barrier(bar);
        if (INJ(0)) { SITE(); if (l == 0) phase_convert(A, ldsl, gw, NGW, wave, lane); if (l == 0) phase_norm(A->in[I_X], A->in[I_ATTN_NORM], (bf16_t*)(ws + WS_H), gw, NGW, lane); else phase_norm_b((const bf16_t*)(ws + WS_XB), A->in[I_ATTN_NORM] + DM, (bf16_t*)(ws + WS_H), gw, NGW, lane); }
        }
        SEAM(pb + 0);
        for (int rep = 0; rep < NREP(1); ++rep) { if (rep) xcd_barrier(bar);
        if (INJ(1)) { SITE(); pg8::Gemm g{(const bf16_t*)(ws + WS_H), (const bf16_t*)(ws + WS_WIN), M, 13312, DM}; pg8::StaticOrder S; S.init(M, 13312, G, bid);
            pg8::EpiSlab E{(bf16_t*)(ws + WS_P), (float*)(ws + WS_PS)};
            pg8::gemm_phase<pg8::EpiSlab, pg8::StaticOrder, true, true>(ldsl, g, S, E, tid);
            small_gemm((const bf16_t*)(ws + WS_H), (const bf16_t*)(ws + WS_WIN), (float*)(ws + WS_PS), ldsl, bid, tid); }
        }
        SEAM(pb + 1);
        for (int rep = 0; rep < NREP(2); ++rep) { if (rep) xcd_barrier(bar);
        if (INJ(2)) { SITE(); phase_prep(A, l, (LAS float*)(ldsl + MISC_OFF + 128), gtid, NGT, gw, NGW, lane); phase_dnprep(A, l, ldsl, G, bid, tid); }
        }
        SEAM(pb + 2);
        for (int rep = 0; rep < NREP(3); ++rep) { if (rep) xcd_barrier(bar);
        if (INJ(3)) { SITE(); phase_mix(A, ws, lds, 2 * l + rep, bid, tid); }
        }
        SEAM(pb + 3);
        for (int rep = 0; rep < NREP(4); ++rep) { if (rep) xcd_barrier(bar);
        if (INJ(4)) { SITE(); phase_post(A, l, gw, NGW, lane); }
        }
        SEAM(pb + 4);
        if (INJ(5)) { SITE(); pg8::Gemm g{(const bf16_t*)(ws + WS_Y), (const bf16_t*)(ws + WS_WOUT), M, DM, DM}; pg8::StaticOrder S; S.init(M, DM, G, bid);
            if (l == 0) { pg8::EpiResidB<true> E{(const void*)A->in[I_X], (bf16_t*)(ws + WS_XB)}; pg8::gemm_phase<pg8::EpiResidB<true>, pg8::StaticOrder, true, true>(ldsl, g, S, E, tid); }
            else { pg8::EpiResidB<false> E{(const void*)(ws + WS_XB), (bf16_t*)(ws + WS_XB)}; pg8::gemm_phase<pg8::EpiResidB<false>, pg8::StaticOrder, true, true>(ldsl, g, S, E, tid); } }
        SEAM(pb + 5);
        for (int rep = 0; rep < NREP(6); ++rep) { if (rep) xcd_barrier(bar);
        if (INJ(6)) { SITE(); phase_norm_b((const bf16_t*)(ws + WS_XB), A->in[I_FFN_NORM] + (size_t)l * DM, (bf16_t*)(ws + WS_H), gw, NGW, lane); }
        }
        SEAM(pb + 6);
        for (int rep = 0; rep < NREP(7); ++rep) { if (rep) xcd_barrier(bar);
        if (INJ(7)) { SITE(); pg8::Gemm g{(const bf16_t*)(ws + WS_H), (const bf16_t*)(ws + WS_WG), M, DFF, DM}; pg8::StaticOrder S; S.init(M, DFF, G, bid);
            pg8::EpiPlain E{(bf16_t*)(ws + WS_P), DFF};
            pg8::gemm_phase<pg8::EpiPlain, pg8::StaticOrder, true, true>(ldsl, g, S, E, tid); }
        }
        SEAM(pb + 7);
        for (int rep = 0; rep < NREP(8); ++rep) { if (rep) xcd_barrier(bar);
        if (INJ(8)) { SITE(); pg8::Gemm g{(const bf16_t*)(ws + WS_H), (const bf16_t*)(ws + WS_WU), M, DFF, DM}; pg8::RevOrder S; S.init(M, DFF, G, bid);
            pg8::EpiAct E{(const bf16_t*)(ws + WS_P), A->in[I_FFN_CONV] + (size_t)l * 3 * DFF, (bf16_t*)(ws + WS_X)};
            pg8::gemm_phase<pg8::EpiAct, pg8::RevOrder, true, true>(ldsl, g, S, E, tid); }
        }
        SEAM(pb + 8);
        if (INJ(9)) { SITE(); pg8::Gemm g{(const bf16_t*)(ws + WS_X), (const bf16_t*)(ws + WS_WD), M, DM, DFF}; pg8::StaticOrder S; S.init(M, DM, G, bid, 2);
            pg8::EpiResidB<false> E{(const void*)(ws + WS_XB), (bf16_t*)(ws + WS_XB)};
            pg8::gemm_phase<pg8::EpiResidB<false>, pg8::StaticOrder, true, true>(ldsl, g, S, E, tid); }
        SEAM(pb + 9);
    }
    if ((ONLY_J < 0 || ONLY_J == 10) && IN(PH_FINAL)) { SITE(); phase_final_norm_b((const bf16_t*)(ws + WS_XB), A->out, A->in[I_FINAL_NORM], gw, NGW, lane); }
#undef IN
#undef INJ
#undef SEAM
#undef SITE
}

extern "C" void kernel_launch(void* const* d_in, const int* in_sizes, int n_in, void* d_out, int out_size, void* d_ws, size_t ws_size, hipStream_t stream) {
    static int grid = 0;
    if (grid == 0) {
        if (n_in != 21 || out_size != M * DM || ws_size < WS_END) { fprintf(stderr, "kernel_launch: unexpected arguments (n_in %d, out %d, ws %zu, need %zu)\n", n_in, out_size, ws_size, (size_t)WS_END); grid = -1; return; }
        int dev = 0, cus = 0, per_cu = 0;
        if (hipGetDevice(&dev) != hipSuccess || hipDeviceGetAttribute(&cus, hipDeviceAttributeMultiprocessorCount, dev) != hipSuccess) { grid = -1; return; }
        if (hipFuncSetAttribute((const void*)mega, hipFuncAttributeMaxDynamicSharedMemorySize, LDS_BYTES) != hipSuccess) { fprintf(stderr, "kernel_launch: hipFuncSetAttribute failed\n"); grid = -1; return; }
        if (hipOccupancyMaxActiveBlocksPerMultiprocessor(&per_cu, (const void*)mega, NWAVES * 64, LDS_BYTES) != hipSuccess || per_cu < 1) fprintf(stderr, "kernel_launch: occupancy query reports %d\n", per_cu);
        (void)hipGetLastError();
        grid = cus;
    }
    if (grid < 0) return;
    (void)hipMemsetAsync((char*)d_ws + WS_CTL, 0, CTL_ZERO_BYTES, stream);
    Args a{};
    for (int i = 0; i < 21; ++i) a.in[i] = (const float*)d_in[i];
    a.out = (float*)d_out; a.ws = (unsigned char*)d_ws;
#ifndef N_CUT
#define N_CUT 1
#endif
#if N_CUT == 0
    for (int p = 0; p < PH_TOTAL; ++p) { a.ph_lo = p; a.ph_hi = p + 1; hipLaunchKernelGGL(mega, dim3(grid), dim3(NWAVES * 64), LDS_BYTES, stream, a); }
#else
    a.ph_lo = 0; a.ph_hi = PH_TOTAL; hipLaunchKernelGGL(mega, dim3(grid), dim3(NWAVES * 64), LDS_BYTES, stream, a);
#endif
}
```

```cpp
#include <hip/hip_runtime.h>
#include <cstdio>
#include <cstdint>
constexpr int NB = 2, T = 8192, M = NB * T, DM = 4096, DFF = 11008, NLAYER = 2;
constexpr int DIN_SRC = 13336;
constexpr int NSLAB = 104;
constexpr int DIN_PAD = 13568;
constexpr float EPS = 1e-6f;
namespace pg8 {
#define PG8_LAS __attribute__((address_space(3)))
typedef unsigned short bf16_t;
typedef short bf16x8 __attribute__((ext_vector_type(8)));
typedef float f32x4 __attribute__((ext_vector_type(4)));
typedef unsigned u32x4 __attribute__((ext_vector_type(4)));
constexpr int BM = 256, BK = 64, HALF = 128, HTB = HALF * BK * 2  , STAGE_BYTES = 8 * HTB, NXCD = 8, WGM = 8;

__host__ __device__ __forceinline__ int lds_byte(int r, int c) { const int st = (r >> 4) * 2 + (c >> 5), rr = r & 15, cc = c & 31, ob = rr * 64 + cc * 2; return st * 1024 + (ob ^ (((ob >> 9) & 1) << 5)); }
__host__ __device__ __forceinline__ void stage_rc(int b, int& R, int& C) { const int st = b / 1024, sb = b % 1024, swz = sb ^ (((sb >> 9) & 1) << 5); R = (st >> 1) * 16 + swz / 64; C = (st & 1) * 32 + (swz % 64) / 2; }
__host__ __device__ __forceinline__ int perm32(int rho) { const int n = rho >> 4, i = rho & 15; return 8 * (i >> 2) + 4 * n + (i & 3); }

struct Unit { int pm, pn; };
struct Gemm { const bf16_t* A; const bf16_t* Bt; int M, N, K; };

struct StaticOrder {
    int nM, nN, nwg, G, c, wgm;
    __host__ __device__ void init(int M, int N, int G_, int c_, int wgm_ = WGM) { nM = M / BM; nN = N / BM; nwg = nM * nN; G = G_; c = c_; wgm = wgm_; }
    __host__ __device__ bool next(int i, Unit& u) const {
        const long L = (long)i * G + c; if (L >= nwg) return false;
        int wgid = (int)L; { const int q = nwg / NXCD, r = nwg % NXCD, xcd = wgid % NXCD, off = wgid / NXCD; wgid = (xcd < r ? xcd * (q + 1) : r * (q + 1) + (xcd - r) * q) + off; }
        const int nig = wgm * nN, gid = wgid / nig, fm = gid * wgm, gsz = (nM - fm) < wgm ? (nM - fm) : wgm;
        u.pm = fm + ((wgid % nig) % gsz); u.pn = (wgid % nig) / gsz; return true;
    }
    __device__ __forceinline__ void a_ready(const Unit&) const {}
    __device__ __forceinline__ void done(const Unit&) const {}
};
struct RevOrder : StaticOrder {
    __host__ __device__ bool next(int i, Unit& u) const {
        const long L = (long)i * G + c; if (L >= nwg) return false;
        int wgid = nwg - 1 - (int)L; { const int q = nwg / NXCD, r = nwg % NXCD, xcd = wgid % NXCD, off = wgid / NXCD; wgid = (xcd < r ? xcd * (q + 1) : r * (q + 1) + (xcd - r) * q) + off; }
        const int nig = wgm * nN, gid = wgid / nig, fm = gid * wgm, gsz = (nM - fm) < wgm ? (nM - fm) : wgm;
        u.pm = fm + ((wgid % nig) % gsz); u.pn = (wgid % nig) / gsz; return true;
    }
};

__device__ __forceinline__ unsigned cvt_pk_bf16(float lo, float hi) { unsigned r; asm volatile("v_cvt_pk_bf16_f32 %0, %1, %2" : "=v"(r) : "v"(lo), "v"(hi)); return r; }
__device__ __forceinline__ float bf_lo(unsigned w) { return __uint_as_float(w << 16); }
__device__ __forceinline__ float bf_hi(unsigned w) { return __uint_as_float(w & 0xffff0000u); }

struct EpiSlab {
    static constexpr bool PERM = true, AFTER_DRAIN = false;
    bf16_t* P; float* psmall;
    __device__ __forceinline__ void operator()(const f32x4 (&acc)[2][2][4][2], const Unit& u, int wr, int wc, int fr, int fq) const {
        const int row0 = u.pm * BM + wr * 64 + fr;
        if (u.pn < 52) {
#pragma unroll
            for (int ai = 0; ai < 2; ++ai)
#pragma unroll
                for (int m = 0; m < 4; ++m) { const int row = row0 + ai * HALF + m * 16;
#pragma unroll
                    for (int bj = 0; bj < 2; ++bj) { const f32x4 v0 = acc[ai][bj][m][0], v1 = acc[ai][bj][m][1];
                        u32x4 w; w.x = cvt_pk_bf16(v0[0], v0[1]); w.y = cvt_pk_bf16(v0[2], v0[3]); w.z = cvt_pk_bf16(v1[0], v1[1]); w.w = cvt_pk_bf16(v1[2], v1[3]);
                        *(u32x4*)(P + ((size_t)(2 * u.pn + bj) * M + row) * 128 + wc * 32 + 8 * fq) = w; } }
        } else if (wc == 0) {
#pragma unroll
            for (int ai = 0; ai < 2; ++ai)
#pragma unroll
                for (int m = 0; m < 4; ++m) { float* rp = psmall + (size_t)(row0 + ai * HALF + m * 16) * 32 + 8 * fq;
                    *(f32x4*)(rp) = acc[ai][0][m][0]; *(f32x4*)(rp + 4) = acc[ai][0][m][1]; }
        }
    }
};
struct EpiPlain {
    static constexpr bool PERM = true, AFTER_DRAIN = false;
    bf16_t* O; int ldc;
    __device__ __forceinline__ void operator()(const f32x4 (&acc)[2][2][4][2], const Unit& u, int wr, int wc, int fr, int fq) const {
        const int row0 = u.pm * BM + wr * 64 + fr, col0 = u.pn * BM + wc * 32 + 8 * fq;
#pragma unroll
        for (int ai = 0; ai < 2; ++ai)
#pragma unroll
            for (int m = 0; m < 4; ++m) { bf16_t* rowp = O + (size_t)(row0 + ai * HALF + m * 16) * ldc + col0;
#pragma unroll
                for (int bj = 0; bj < 2; ++bj) { const f32x4 v0 = acc[ai][bj][m][0], v1 = acc[ai][bj][m][1];
                    u32x4 w; w.x = cvt_pk_bf16(v0[0], v0[1]); w.y = cvt_pk_bf16(v0[2], v0[3]); w.z = cvt_pk_bf16(v1[0], v1[1]); w.w = cvt_pk_bf16(v1[2], v1[3]);
                    *(u32x4*)(rowp + bj * HALF) = w; } }
    }
};
struct EpiAct {
    static constexpr bool PERM = true, AFTER_DRAIN = false;
    const bf16_t* G; const float* cw; bf16_t* O;
    __device__ __forceinline__ void operator()(const f32x4 (&acc)[2][2][4][2], const Unit& u, int wr, int wc, int fr, int fq) const {
        const int row0 = u.pm * BM + wr * 64 + fr, col0 = u.pn * BM + wc * 32 + 8 * fq;
#pragma unroll
        for (int bj = 0; bj < 2; ++bj) {
            const int col = col0 + bj * HALF;
            const f32x4 w0a = *(const f32x4*)(cw + col), w0b = *(const f32x4*)(cw + col + 4);
            const f32x4 w1a = *(const f32x4*)(cw + DFF + col), w1b = *(const f32x4*)(cw + DFF + col + 4);
            const f32x4 w2a = *(const f32x4*)(cw + 2 * DFF + col), w2b = *(const f32x4*)(cw + 2 * DFF + col + 4);
#pragma unroll
            for (int ai = 0; ai < 2; ++ai) {
                u32x4 g2[4], g1[4], g0[4];
#pragma unroll
                for (int m = 0; m < 4; ++m) {
                    const int row = row0 + ai * HALF + m * 16, t = row & (T - 1);
                    const bf16_t* gp = G + (size_t)row * DFF + col;
                    g2[m] = *(const u32x4*)gp; g1[m] = (u32x4){0u, 0u, 0u, 0u}; g0[m] = (u32x4){0u, 0u, 0u, 0u};
                    if (t >= 1) g1[m] = *(const u32x4*)(gp - DFF);
                    if (t >= 2) g0[m] = *(const u32x4*)(gp - 2 * DFF); }
#pragma unroll
                for (int m = 0; m < 4; ++m) {
                    const int row = row0 + ai * HALF + m * 16;
                    float a[8];
#pragma unroll
                    for (int q = 0; q < 4; ++q) {
                        const float wl0 = q < 2 ? w0a[2 * q] : w0b[2 * q - 4], wh0 = q < 2 ? w0a[2 * q + 1] : w0b[2 * q - 3];
                        const float wl1 = q < 2 ? w1a[2 * q] : w1b[2 * q - 4], wh1 = q < 2 ? w1a[2 * q + 1] : w1b[2 * q - 3];
                        const float wl2 = q < 2 ? w2a[2 * q] : w2b[2 * q - 4], wh2 = q < 2 ? w2a[2 * q + 1] : w2b[2 * q - 3];
                        a[2 * q]     = wl0 * bf_lo(g0[m][q]) + wl1 * bf_lo(g1[m][q]) + wl2 * bf_lo(g2[m][q]);
                        a[2 * q + 1] = wh0 * bf_hi(g0[m][q]) + wh1 * bf_hi(g1[m][q]) + wh2 * bf_hi(g2[m][q]);
                    }
                    const f32x4 v0 = acc[ai][bj][m][0], v1 = acc[ai][bj][m][1];
                    float o[8];
#pragma unroll
                    for (int i = 0; i < 8; ++i) { const float up = i < 4 ? v0[i] : v1[i - 4]; o[i] = a[i] * __builtin_amdgcn_rcpf(1.0f + __expf(-a[i])) * up; }
                    u32x4 w; w.x = cvt_pk_bf16(o[0], o[1]); w.y = cvt_pk_bf16(o[2], o[3]); w.z = cvt_pk_bf16(o[4], o[5]); w.w = cvt_pk_bf16(o[6], o[7]);
                    *(u32x4*)(O + (size_t)row * DFF + col) = w;
                }
                asm volatile("" ::: "memory");
            }
        }
    }
};
struct EpiResid {
    static constexpr bool PERM = false, AFTER_DRAIN = false;
    const float* base; float* out;
    __device__ __forceinline__ void operator()(const f32x4 (&acc)[2][2][4][2], const Unit& u, int wr, int wc, int fr, int fq) const {
        const int row0 = u.pm * BM + wr * 64 + fr, col0 = u.pn * BM + wc * 32 + 4 * fq;
#pragma unroll
        for (int ai = 0; ai < 2; ++ai)
#pragma unroll
            for (int mp = 0; mp < 2; ++mp) {
                f32x4 b[2][2][2];
#pragma unroll
                for (int mm = 0; mm < 2; ++mm) { const size_t off = (size_t)(row0 + ai * HALF + (2 * mp + mm) * 16) * DM + col0;
#pragma unroll
                    for (int bj = 0; bj < 2; ++bj)
#pragma unroll
                        for (int n = 0; n < 2; ++n) b[mm][bj][n] = *(const f32x4*)(base + off + bj * HALF + n * 16); }
#pragma unroll
                for (int mm = 0; mm < 2; ++mm) { const size_t off = (size_t)(row0 + ai * HALF + (2 * mp + mm) * 16) * DM + col0;
#pragma unroll
                    for (int bj = 0; bj < 2; ++bj)
#pragma unroll
                        for (int n = 0; n < 2; ++n) *(f32x4*)(out + off + bj * HALF + n * 16) = b[mm][bj][n] + acc[ai][bj][2 * mp + mm][n]; }
                asm volatile("" ::: "memory"); }
    }
};

template <bool F32BASE> struct EpiResidB {
    static constexpr bool PERM = true, AFTER_DRAIN = false;
    const void* base; bf16_t* out;
    __device__ __forceinline__ void operator()(const f32x4 (&acc)[2][2][4][2], const Unit& u, int wr, int wc, int fr, int fq) const {
        const int row0 = u.pm * BM + wr * 64 + fr, col0 = u.pn * BM + wc * 32 + 8 * fq;
#pragma unroll
        for (int ai = 0; ai < 2; ++ai)
#pragma unroll
            for (int mp = 0; mp < 2; ++mp) {
                f32x4 b[2][2][2];
#pragma unroll
                for (int mm = 0; mm < 2; ++mm) { const size_t off = (size_t)(row0 + ai * HALF + (2 * mp + mm) * 16) * DM + col0;
#pragma unroll
                    for (int bj = 0; bj < 2; ++bj) {
                        if constexpr (F32BASE) { const float* bp = (const float*)base + off + bj * HALF; b[mm][bj][0] = *(const f32x4*)bp; b[mm][bj][1] = *(const f32x4*)(bp + 4); }
                        else { const u32x4 w = *(const u32x4*)((const bf16_t*)base + off + bj * HALF);
                            b[mm][bj][0] = (f32x4){bf_lo(w.x), bf_hi(w.x), bf_lo(w.y), bf_hi(w.y)}; b[mm][bj][1] = (f32x4){bf_lo(w.z), bf_hi(w.z), bf_lo(w.w), bf_hi(w.w)}; } } }
#pragma unroll
                for (int mm = 0; mm < 2; ++mm) { const size_t off = (size_t)(row0 + ai * HALF + (2 * mp + mm) * 16) * DM + col0;
#pragma unroll
                    for (int bj = 0; bj < 2; ++bj) { const f32x4 v0 = b[mm][bj][0] + acc[ai][bj][2 * mp + mm][0], v1 = b[mm][bj][1] + acc[ai][bj][2 * mp + mm][1];
                        u32x4 w; w.x = cvt_pk_bf16(v0[0], v0[1]); w.y = cvt_pk_bf16(v0[2], v0[3]); w.z = cvt_pk_bf16(v1[0], v1[1]); w.w = cvt_pk_bf16(v1[2], v1[3]);
                        *(u32x4*)(out + off + bj * HALF) = w; } }
                asm volatile("" ::: "memory"); }
    }
};

template <class Epi, class Sched, bool ALIGN_EPI = false, bool SP2 = false>
__device__ __forceinline__ void gemm_phase(PG8_LAS unsigned char* lds, const Gemm g, const Sched& S, const Epi& E, const int tid_in) {
    int tid = tid_in; asm volatile("" : "+v"(tid));
    const int wid = __builtin_amdgcn_readfirstlane(tid >> 6), lane = tid & 63, wr = wid >> 2, wc = wid & 3, fr = lane & 15, fq = lane >> 4;
    const int K = g.K, nt = K / BK;
    unsigned voffA[2], voffB[2];
#pragma unroll
    for (int i = 0; i < 2; ++i) { int R, C; stage_rc(tid * 16 + i * 8192, R, C); const int Rb = Epi::PERM ? ((R & ~31) + perm32(R & 31)) : R;
        voffA[i] = (unsigned)(R * K + C) * 2u; voffB[i] = (unsigned)(Rb * K + C) * 2u; }
    const size_t kstep = (size_t)(BK * 2);
    const size_t hstep = (size_t)HALF * K * 2;
    const size_t tstep = 2 * hstep;
    const unsigned ldsw = (unsigned)wid * 1024u;
    const int aoff = lds_byte(wr * 64 + fr, fq * 8), boff = lds_byte(wc * 32 + fr, fq * 8);
#define PG8_SA(b, h) (((b) * 2 + (h)) * HTB)
#define PG8_SB(b, h) ((4 + (b) * 2 + (h)) * HTB)
#define PG8_STAGE(bufoff, gbase, voff) do { _Pragma("unroll") for (int _i = 0; _i < 2; ++_i) \
        __builtin_amdgcn_global_load_lds((const unsigned*)((const char*)(gbase) + (voff)[_i]), (PG8_LAS unsigned*)(lds + (bufoff) + ldsw + _i * 8192), 16, 0, 0); } while (0)
#define PG8_LDA(dst, b, h) do { _Pragma("unroll") for (int m = 0; m < 4; ++m) _Pragma("unroll") for (int k = 0; k < 2; ++k) dst[m][k] = *(const PG8_LAS bf16x8*)(lds + PG8_SA(b, h) + aoff + m * 2048 + k * 1024); } while (0)
#define PG8_LDB(dst, b, h) do { _Pragma("unroll") for (int n = 0; n < 2; ++n) _Pragma("unroll") for (int k = 0; k < 2; ++k) dst[n][k] = *(const PG8_LAS bf16x8*)(lds + PG8_SB(b, h) + boff + n * 2048 + k * 1024); } while (0)
#define PG8_MMA(ai, bj, At, Bt) do { __builtin_amdgcn_s_setprio(1); _Pragma("unroll") for (int m = 0; m < 4; ++m) _Pragma("unroll") for (int n = 0; n < 2; ++n) _Pragma("unroll") for (int k = 0; k < 2; ++k) \
        acc[ai][bj][m][n] = __builtin_amdgcn_mfma_f32_16x16x32_bf16(Bt[n][k], At[m][k], acc[ai][bj][m][n], 0, 0, 0); __builtin_amdgcn_s_setprio(0); } while (0)
#define PG8_WAIT_V(n) asm volatile("s_waitcnt vmcnt(" #n ")" ::: "memory")
#define PG8_WAIT_L(n) asm volatile("s_waitcnt lgkmcnt(" #n ")" ::: "memory")
#define PG8_BAR __builtin_amdgcn_s_barrier()
#define PG8_SCHED __builtin_amdgcn_sched_barrier(0)
    Unit cur, nxt; int ui = 0;
    if (!S.next(0, cur)) return;
    f32x4 acc[2][2][4][2];
#pragma unroll
    for (int a = 0; a < 2; ++a)
#pragma unroll
        for (int b = 0; b < 2; ++b)
#pragma unroll
            for (int m = 0; m < 4; ++m)
#pragma unroll
                for (int n = 0; n < 2; ++n) acc[a][b][m][n] = (f32x4){0.f, 0.f, 0.f, 0.f};
    bf16x8 At[4][2], B0[2][2], B1[2][2];
    const char* cA = (const char*)g.A + (size_t)cur.pm * tstep; const char* cB = (const char*)g.Bt + (size_t)cur.pn * tstep;
    S.a_ready(cur);
    if constexpr (SP2) {
        PG8_STAGE(PG8_SB(0, 0), cB, voffB); PG8_STAGE(PG8_SB(0, 1), cB + hstep, voffB); PG8_STAGE(PG8_SA(0, 0), cA, voffA); PG8_STAGE(PG8_SA(0, 1), cA + hstep, voffA);
        if (wr == 1) PG8_BAR;
        PG8_WAIT_V(2); PG8_BAR;
        PG8_STAGE(PG8_SB(1, 0), cB + kstep, voffB); PG8_STAGE(PG8_SA(1, 0), cA + kstep, voffA); PG8_STAGE(PG8_SB(1, 1), cB + hstep + kstep, voffB);
        PG8_WAIT_V(6); PG8_BAR;
    } else {
        PG8_STAGE(PG8_SB(0, 0), cB, voffB); PG8_STAGE(PG8_SA(0, 0), cA, voffA); PG8_STAGE(PG8_SB(0, 1), cB + hstep, voffB); PG8_STAGE(PG8_SA(0, 1), cA + hstep, voffA);
        if (wr == 1) PG8_BAR;
        PG8_WAIT_V(4); PG8_BAR;
        PG8_STAGE(PG8_SB(1, 0), cB + kstep, voffB); PG8_STAGE(PG8_SA(1, 0), cA + kstep, voffA); PG8_STAGE(PG8_SB(1, 1), cB + hstep + kstep, voffB);
        PG8_WAIT_V(6); PG8_BAR;
    }
    for (;;) {
        const bool has_next = S.next(ui + 1, nxt);
        const char* nA = has_next ? (const char*)g.A + (size_t)nxt.pm * tstep : cA; const char* nB = has_next ? (const char*)g.Bt + (size_t)nxt.pn * tstep : cB;
        for (int t = 0; t < nt; t += 2) {
            const bool last = (t == nt - 2);
            const char* a1 = cA + (size_t)(t + 1) * kstep;
            const char* a2 = last ? nA : cA + (size_t)(t + 2) * kstep; const char* b2 = last ? nB : cB + (size_t)(t + 2) * kstep;
            const char* a3 = a2 + kstep; const char* b3 = b2 + kstep;
            if (last && has_next) S.a_ready(nxt);
            if constexpr (SP2) {
            PG8_LDB(B0, 0, 0); PG8_LDB(B1, 0, 1); PG8_SCHED; PG8_LDA(At, 0, 0); PG8_STAGE(PG8_SA(1, 1), a1 + hstep, voffA);
            PG8_WAIT_V(8); PG8_WAIT_L(0); PG8_BAR; PG8_MMA(0, 0, At, B0); PG8_MMA(0, 1, At, B1); PG8_BAR; PG8_SCHED;
            PG8_LDA(At, 0, 1); PG8_STAGE(PG8_SB(0, 0), b2, voffB); PG8_STAGE(PG8_SB(0, 1), b2 + hstep, voffB); PG8_STAGE(PG8_SA(0, 0), a2, voffA);
            PG8_WAIT_V(8); PG8_WAIT_L(0); PG8_BAR; PG8_MMA(1, 0, At, B0); PG8_MMA(1, 1, At, B1); PG8_BAR; PG8_SCHED;
            PG8_LDB(B0, 1, 0); PG8_LDB(B1, 1, 1); PG8_SCHED; PG8_LDA(At, 1, 0); PG8_STAGE(PG8_SA(0, 1), a2 + hstep, voffA);
            PG8_WAIT_V(8); PG8_WAIT_L(0); PG8_BAR; PG8_MMA(0, 0, At, B0); PG8_MMA(0, 1, At, B1); PG8_BAR; PG8_SCHED;
            PG8_LDA(At, 1, 1); PG8_STAGE(PG8_SB(1, 0), b3, voffB); PG8_STAGE(PG8_SB(1, 1), b3 + hstep, voffB); PG8_STAGE(PG8_SA(1, 0), a3, voffA);
            PG8_WAIT_V(8); PG8_WAIT_L(0); PG8_BAR; PG8_MMA(1, 0, At, B0); PG8_MMA(1, 1, At, B1); PG8_BAR; PG8_SCHED;
            } else {
            PG8_LDB(B0, 0, 0); PG8_SCHED; PG8_LDA(At, 0, 0); PG8_STAGE(PG8_SA(1, 1), a1 + hstep, voffA);
            PG8_WAIT_L(8); PG8_BAR; PG8_WAIT_L(0); PG8_MMA(0, 0, At, B0); PG8_BAR; PG8_SCHED;
            PG8_LDB(B1, 0, 1); PG8_STAGE(PG8_SB(0, 0), b2, voffB);
            PG8_BAR; PG8_WAIT_L(0); PG8_MMA(0, 1, At, B1); PG8_BAR;
            PG8_LDA(At, 0, 1); PG8_STAGE(PG8_SA(0, 0), a2, voffA);
            PG8_BAR; PG8_WAIT_L(0); PG8_MMA(1, 0, At, B0); PG8_BAR; PG8_SCHED;
            PG8_STAGE(PG8_SB(0, 1), b2 + hstep, voffB);
            PG8_WAIT_V(6); PG8_BAR; PG8_MMA(1, 1, At, B1); PG8_BAR;
            PG8_LDB(B0, 1, 0); PG8_SCHED; PG8_LDA(At, 1, 0); PG8_STAGE(PG8_SA(0, 1), a2 + hstep, voffA);
            PG8_WAIT_L(8); PG8_BAR; PG8_WAIT_L(0); PG8_MMA(0, 0, At, B0); PG8_BAR; PG8_SCHED;
            PG8_LDB(B1, 1, 1); PG8_STAGE(PG8_SB(1, 0), b3, voffB);
            PG8_BAR; PG8_WAIT_L(0); PG8_MMA(0, 1, At, B1); PG8_BAR;
            PG8_LDA(At, 1, 1); PG8_STAGE(PG8_SA(1, 0), a3, voffA);
            PG8_BAR; PG8_WAIT_L(0); PG8_MMA(1, 0, At, B0); PG8_BAR; PG8_SCHED;
            PG8_STAGE(PG8_SB(1, 1), b3 + hstep, voffB);
            PG8_WAIT_V(6); PG8_BAR; PG8_MMA(1, 1, At, B1); PG8_BAR;
            }
        }
        if constexpr (ALIGN_EPI) { if (wr == 0) PG8_BAR; }
        if constexpr (!Epi::AFTER_DRAIN) { E(acc, cur, wr, wc, fr, fq); S.done(cur); }
        if (!has_next) break;
#pragma unroll
        for (int a = 0; a < 2; ++a)
#pragma unroll
            for (int b = 0; b < 2; ++b)
#pragma unroll
                for (int m = 0; m < 4; ++m)
#pragma unroll
                    for (int n = 0; n < 2; ++n) acc[a][b][m][n] = (f32x4){0.f, 0.f, 0.f, 0.f};
        cur = nxt; cA = nA; cB = nB; ++ui;
        if constexpr (ALIGN_EPI) { if (wr == 1) PG8_BAR; }
    }
    PG8_WAIT_V(0);
    if constexpr (!ALIGN_EPI) { if (wr == 0) PG8_BAR; }
    PG8_BAR;
    if constexpr (Epi::AFTER_DRAIN) { E.fused(acc, cur, wr, wc, fr, fq, lds, wid, lane); S.done(cur); }
#undef PG8_SA
#undef PG8_SB
#undef PG8_STAGE
#undef PG8_LDA
#undef PG8_LDB
#undef PG8_MMA
#undef PG8_WAIT_V
#undef PG8_WAIT_L
#undef PG8_BAR
#undef PG8_SCHED
}
}
#define GAS __attribute__((address_space(1)))
#define LAS __attribute__((address_space(3)))
typedef unsigned short bf16;
typedef unsigned v4u __attribute__((ext_vector_type(4)));
typedef float f32x4 __attribute__((ext_vector_type(4)));
typedef short bf16x8 __attribute__((ext_vector_type(8)));
typedef GAS unsigned gu32;
typedef GAS unsigned long long gu64;
#define RLX_AGENT __ATOMIC_RELAXED, __HIP_MEMORY_SCOPE_AGENT
#define LDS_WAIT() asm volatile("s_waitcnt lgkmcnt(0)" ::: "memory")
#define VM_WAIT() asm volatile("s_waitcnt vmcnt(0)" ::: "memory")
__device__ __forceinline__ unsigned long long rt() { return __builtin_amdgcn_s_memrealtime(); }
__device__ __forceinline__ unsigned f2bf(float f) { unsigned u = __builtin_bit_cast(unsigned, f); return (u + 0x7fffu + ((u >> 16) & 1u)) >> 16; }
__device__ __forceinline__ unsigned pk2(float lo, float hi) { return f2bf(lo) | (f2bf(hi) << 16); }
#define XB_TMO      128
#define XB_XCNT(j)  (256  + 64 * (j))
#define XB_XSUB(j)  (1280 + 64 * (j))
#define XB_XGEN(j)  (2304 + 64 * (j))
#define XB_TOP      3328
#define XB_TOPGEN   3392
#define XCD_BAR_WORDS 3456
#define XB_SPIN_CAP (1u << 18)

__device__ __forceinline__ unsigned xb_ld(unsigned* p)              { return __hip_atomic_load(p, __ATOMIC_RELAXED, __HIP_MEMORY_SCOPE_AGENT); }
__device__ __forceinline__ unsigned xb_add(unsigned* p, unsigned v) { return __hip_atomic_fetch_add(p, v, __ATOMIC_RELAXED, __HIP_MEMORY_SCOPE_AGENT); }
__device__ __forceinline__ unsigned xb_xcc_id() { return (unsigned)__builtin_amdgcn_s_getreg((3 << 11) | 20) & 0xFu; }
#define XB_SPIN(cond, bar) do { unsigned _sp = 0; while (cond) { __builtin_amdgcn_s_sleep(1); \
    if ((++_sp & 255u) == 0u) { if (xb_ld(&(bar)[XB_TMO])) break; if (_sp > XB_SPIN_CAP) { atomicAdd(&(bar)[XB_TMO], 1u); break; } } } } while (0)

struct XcdBarrier {
    unsigned* bar; unsigned x;
    volatile LAS unsigned* st;
};

__device__ __forceinline__ XcdBarrier xcd_barrier_post(unsigned* bar, volatile LAS unsigned* st) {
    XcdBarrier b; b.bar = bar; b.x = xb_xcc_id(); b.st = st;
    if (threadIdx.x == 0) (void)xb_add(&bar[XB_XCNT(b.x)], 1u);
    return b;
}
__device__ __forceinline__ void xcd_barrier_complete(unsigned* bar, unsigned x, unsigned& nloc, unsigned& nx) {
    const unsigned G = gridDim.x * gridDim.y * gridDim.z;
    unsigned sum, cnt, mine, sp = 0u;
    for (;;) {
        sum = 0u; cnt = 0u; mine = 0u;
#pragma unroll
        for (unsigned j = 0; j < 16; ++j) { const unsigned c = xb_ld(&bar[XB_XCNT(j)]); sum += c; cnt += (c > 0u) ? 1u : 0u; mine = (j == x) ? c : mine; }
        if (sum == G) break;
        __builtin_amdgcn_s_sleep(1);
        if ((++sp & 255u) == 0u) { if (xb_ld(&bar[XB_TMO])) break; if (sp > XB_SPIN_CAP) { atomicAdd(&bar[XB_TMO], 1u); break; } }
    }
    nloc = mine > 0u ? mine : 1u; nx = cnt > 0u ? cnt : 1u;
}

__device__ __forceinline__ void xcd_barrier(const XcdBarrier& b) {
    asm volatile("s_waitcnt vmcnt(0)" ::: "memory");
    __syncthreads();
    if (threadIdx.x == 0) {
        unsigned* bar = b.bar;
        __builtin_amdgcn_s_waitcnt(0);
        unsigned nloc = b.st[0], nx = b.st[1];
        if (nloc == 0u) { xcd_barrier_complete(bar, b.x, nloc, nx); b.st[0] = nloc; b.st[1] = nx; }
        const unsigned old = xb_add(&bar[XB_XSUB(b.x)], 1u);
        const unsigned gen = old / nloc;
        if (old + 1u == (gen + 1u) * nloc) {
            __builtin_amdgcn_fence(__ATOMIC_RELEASE, "agent");
            asm volatile("s_waitcnt vmcnt(0)" ::: "memory");
            const unsigned og = xb_add(&bar[XB_TOP], 1u);
            const unsigned tg = og / nx;
            if (og + 1u == (tg + 1u) * nx) xb_add(&bar[XB_TOPGEN], 1u);
            else XB_SPIN(xb_ld(&bar[XB_TOPGEN]) == tg, bar);
            __builtin_amdgcn_fence(__ATOMIC_ACQUIRE, "agent");
            xb_add(&bar[XB_XGEN(b.x)], 1u);
            asm volatile("s_waitcnt vmcnt(0)" ::: "memory");
        } else {
            XB_SPIN(xb_ld(&bar[XB_XGEN(b.x)]) == gen, bar);
            __builtin_amdgcn_fence(__ATOMIC_ACQUIRE, "agent");
            asm volatile("s_waitcnt vmcnt(0)" ::: "memory");
        }
    }
    __syncthreads();
}
namespace att {
typedef unsigned short bf16_t;
typedef short bf16x8 __attribute__((ext_vector_type(8)));
typedef short s16x4 __attribute__((ext_vector_type(4)));
typedef float f32x16 __attribute__((ext_vector_type(16)));
typedef float f32x4 __attribute__((ext_vector_type(4)));
typedef unsigned u32x4 __attribute__((ext_vector_type(4)));
constexpr int D = 128, NW = 8, QBLK = 32, KVBLK = 64, QB = NW * QBLK;
constexpr int SHM_V = KVBLK * D * 2, SHM_K = KVBLK * D * 2;
constexpr int OFF_WS = 2 * SHM_V + 2 * SHM_K, OFF_BIAS = OFF_WS + NW * 64 * 4, OFF_Q = OFF_BIAS + 2 * 64 * 4, ATT_LDS_BYTES = OFF_Q + NW * 8192;
#ifndef NQREG
#define NQREG 2
#endif
constexpr float SCALE = 0.08838834764831845f, INV_SCALE = 11.313708498984761f, THR = 8.f;
constexpr int WIN = 1 << 30;

#define KSWZ(row, colB) ((row) * 256 + ((colB) ^ (((row) & 7) << 4)))
#define SBAR() __builtin_amdgcn_sched_barrier(0)
__device__ __forceinline__ int v_st(int k, int c) { const int kk = (k & ~0xC) | ((k & 4) << 1) | ((k & 8) >> 1); return ((kk >> 3) * 4 + (c >> 5)) * 512 + ((kk & 7) * 32 + (c & 31)) * 2; }
__device__ __forceinline__ int v_rd_base(int lane) { return ((lane & 3) << 3) | (((lane >> 2) & 3) << 6) | (((lane >> 4) & 1) << 5) | (((lane >> 5) & 1) << 8); }
constexpr int v_rd_off(int d0, int ks, int half) { return d0 * 512 + ks * 4096 + half * 2048; }
__device__ __forceinline__ int crow(int r, int hi) { return (r & 3) + 8 * (r >> 2) + 4 * hi; }
__device__ __forceinline__ unsigned cvtpk(float lo, float hi) { unsigned r; asm volatile("v_cvt_pk_bf16_f32 %0, %1, %2" : "=v"(r) : "v"(lo), "v"(hi)); return r; }
__device__ __forceinline__ bf16x8 load8(const bf16_t* p) { return *reinterpret_cast<const bf16x8*>(p); }
__device__ __forceinline__ void mask_tile(f32x16& p0, f32x16& p1, int dq) {
    const float NEG = -__builtin_inff();
#pragma unroll
    for (int r = 0; r < 16; ++r) {
        const int c = (r & 3) + 8 * (r >> 2);
        if ((unsigned)(dq - c) >= (unsigned)WIN) p0[r] = NEG;
        if ((unsigned)(dq - c - 32) >= (unsigned)WIN) p1[r] = NEG;
    }
}
__device__ __forceinline__ void add_bias(f32x16& p0, f32x16& p1, const float* bl, int hi) {
#pragma unroll
    for (int g = 0; g < 4; ++g) { const f32x4 a = *(const f32x4*)(bl + 8 * g + 4 * hi), b = *(const f32x4*)(bl + 32 + 8 * g + 4 * hi);
#pragma unroll
        for (int i = 0; i < 4; ++i) { p0[4 * g + i] += a[i]; p1[4 * g + i] += b[i]; }
        asm volatile("" ::: "memory"); }
}
__device__ __forceinline__ void partialSM(f32x16& p0, f32x16& p1, float& m_reg, float& mn, float& alpha) {
    float pmax = p0[0]; for (int r = 1; r < 16; ++r) pmax = fmaxf(pmax, p0[r]); for (int r = 0; r < 16; ++r) pmax = fmaxf(pmax, p1[r]);
    { auto rr = __builtin_amdgcn_permlane32_swap(__float_as_uint(pmax), __float_as_uint(pmax), false, false);
      pmax = fmaxf(__uint_as_float(rr[0]), __uint_as_float(rr[1])); }
    constexpr float C2 = 1.4426950408889634f * SCALE;
    if (__builtin_expect(__all((pmax - m_reg) * SCALE <= THR), 1)) { mn = m_reg; alpha = 1.f; }
    else { mn = fmaxf(m_reg, pmax); alpha = __builtin_amdgcn_exp2f((m_reg - mn) * C2); m_reg = mn; }
    const float mnL = -mn * C2;
    for (int r = 0; r < 16; ++r) p0[r] = fmaf(p0[r], C2, mnL); for (int r = 0; r < 16; ++r) p1[r] = fmaf(p1[r], C2, mnL);
    for (int r = 0; r < 16; ++r) p0[r] = __builtin_amdgcn_exp2f(p0[r]);
}
__device__ __forceinline__ void finishSM(f32x16& p0, f32x16& p1, float alpha, float& l_reg, bf16x8& pa0, bf16x8& pa1, bf16x8& pa2, bf16x8& pa3) {
    for (int r = 0; r < 16; ++r) p1[r] = __builtin_amdgcn_exp2f(p1[r]);
    float ps = 0; for (int r = 0; r < 16; ++r) ps += p0[r]; for (int r = 0; r < 16; ++r) ps += p1[r];
    { auto rr = __builtin_amdgcn_permlane32_swap(__float_as_uint(ps), __float_as_uint(ps), false, false);
      ps = __uint_as_float(rr[0]) + __uint_as_float(rr[1]); }
    l_reg = l_reg * alpha + ps;
#define PK4(P, B_, OUT) do { unsigned a0 = cvtpk(P[B_+0], P[B_+1]), a1 = cvtpk(P[B_+2], P[B_+3]);                          \
        unsigned b0 = cvtpk(P[B_+4], P[B_+5]), b1 = cvtpk(P[B_+6], P[B_+7]);                                             \
        auto r0 = __builtin_amdgcn_permlane32_swap(a0, b0, false, false); auto r1 = __builtin_amdgcn_permlane32_swap(a1, b1, false, false); \
        u32x4 w = {r0[0], r1[0], r0[1], r1[1]}; OUT = *reinterpret_cast<bf16x8*>(&w); } while (0)
    PK4(p0, 0, pa0); PK4(p0, 8, pa1); PK4(p1, 0, pa2); PK4(p1, 8, pa3);
#undef PK4
}
template <int KB>
__device__ __forceinline__ void qkt(f32x16& p0, f32x16& p1, const char* K_lds, int r32, int hi, const bf16x8* qr, const char* qw) {
    p0 = f32x16{}; p1 = f32x16{};
    const char* kb[4];
#pragma unroll
    for (int dd = 0; dd < 4; ++dd) kb[dd] = K_lds + KB * SHM_K + KSWZ(r32, (dd * 16 + hi * 8) * 2);
#pragma unroll
    for (int d0 = 0; d0 < 8; ++d0) { const char* a = kb[d0 & 3] + (d0 >> 2) * 128;
        bf16x8 b0 = *reinterpret_cast<const bf16x8*>(a);
        bf16x8 b1 = *reinterpret_cast<const bf16x8*>(a + 32 * 256);
        bf16x8 qf; if (d0 < NQREG) qf = qr[d0]; else qf = *reinterpret_cast<const bf16x8*>(qw + d0 * 1024);
        p0 = __builtin_amdgcn_mfma_f32_32x32x16_bf16(b0, qf, p0, 0, 0, 0);
        p1 = __builtin_amdgcn_mfma_f32_32x32x16_bf16(b1, qf, p1, 0, 0, 0); }
}
template <int VB>
__device__ __forceinline__ void pv_tile(f32x16* o, int vb0, bf16x8 pa0, bf16x8 pa1, bf16x8 pa2, bf16x8 pa3) {
#define TRRD(dst, off) asm volatile("ds_read_b64_tr_b16 %0, %1 offset:%2" : "=&v"(dst) : "v"(vb0), "i"(off) : "memory")
#define PV_D0(d0) do { s16x4 l0, l1, l2, l3, h0, h1, h2, h3; constexpr int b_ = VB * SHM_V + v_rd_off(d0, 0, 0); \
        TRRD(l0, b_); TRRD(h0, b_ + 2048); TRRD(l1, b_ + 4096); TRRD(h1, b_ + 6144); TRRD(l2, b_ + 8192); TRRD(h2, b_ + 10240); TRRD(l3, b_ + 12288); TRRD(h3, b_ + 14336); \
        asm volatile("s_waitcnt lgkmcnt(0)" ::: "memory"); SBAR();   \
        o[d0] = __builtin_amdgcn_mfma_f32_32x32x16_bf16(pa0, (bf16x8){l0[0], l0[1], l0[2], l0[3], h0[0], h0[1], h0[2], h0[3]}, o[d0], 0, 0, 0);   \
        o[d0] = __builtin_amdgcn_mfma_f32_32x32x16_bf16(pa1, (bf16x8){l1[0], l1[1], l1[2], l1[3], h1[0], h1[1], h1[2], h1[3]}, o[d0], 0, 0, 0);   \
        o[d0] = __builtin_amdgcn_mfma_f32_32x32x16_bf16(pa2, (bf16x8){l2[0], l2[1], l2[2], l2[3], h2[0], h2[1], h2[2], h2[3]}, o[d0], 0, 0, 0);   \
        o[d0] = __builtin_amdgcn_mfma_f32_32x32x16_bf16(pa3, (bf16x8){l3[0], l3[1], l3[2], l3[3], h3[0], h3[1], h3[2], h3[3]}, o[d0], 0, 0, 0); } while (0)
    PV_D0(0); PV_D0(1); PV_D0(2); PV_D0(3);
#undef PV_D0
#undef TRRD
}
struct BlockRef { const bf16_t* Q; const bf16_t* K; const bf16_t* V; float* O; const float* cum; int P0, jlo; };
struct Seam { bf16x8 qr[8]; bf16x8 st_v0, st_v1, st_k0, st_k1; float st_b; };
#define ROW(p, k0, rr) ((p) + (size_t)((k0) + (rr)) * D + sc)
#define VMW() asm volatile("s_waitcnt vmcnt(0)" ::: "memory")
#define VMWN(n) asm volatile("s_waitcnt vmcnt(%0)" :: "i"(n) : "memory")
#define SLOAD_H(Kp, Vp, Cp, k0) do { S.st_v0 = load8(ROW(Vp, k0, sr)); S.st_v1 = load8(ROW(Vp, k0, 32 + sr));              \
                         S.st_k0 = load8(ROW(Kp, k0, sr)); S.st_k1 = load8(ROW(Kp, k0, 32 + sr)); if ((Cp) != nullptr && tid < 64) S.st_b = (Cp)[(k0) + tid]; } while (0)
#define SWRITE_HK(bf, Cp) do { *(bf16x8*)(K_lds + (bf) * SHM_K + kws) = S.st_k0; *(bf16x8*)(K_lds + (bf) * SHM_K + kws + 32 * 256) = S.st_k1; \
                         if ((Cp) != nullptr && tid < 64) bias_l[(bf) * 64 + tid] = -S.st_b * INV_SCALE; } while (0)
#define SWRITE_HV(bf) do { *(bf16x8*)(V_lds + (bf) * SHM_V + vst0) = S.st_v0; *(bf16x8*)(V_lds + (bf) * SHM_V + vst1) = S.st_v1; } while (0)
#define SWRITE_H(bf, Cp) do { SWRITE_HV(bf); SWRITE_HK(bf, Cp); } while (0)
__device__ __forceinline__ void attn_prime(const BlockRef& cur, char* lds, Seam& S, const int tid) {
    const int wid = __builtin_amdgcn_readfirstlane(tid >> 6), lane = tid & 63, r32 = lane & 31, hi = lane >> 5;
    const int sr = tid >> 4, sc = (tid & 15) * 8, kws = KSWZ(sr, sc * 2); char* K_lds = lds + 2 * SHM_V; float* bias_l = (float*)(lds + OFF_BIAS);
    for (int d0 = 0; d0 < 8; ++d0) S.qr[d0] = load8(cur.Q + (size_t)(wid * QBLK + r32) * D + d0 * 16 + hi * 8);
    SLOAD_H(cur.K, cur.V, cur.cum, cur.jlo * KVBLK); VMW(); SWRITE_HK(0, cur.cum);
    __syncthreads();
}
__device__ __forceinline__ void attn_block(const BlockRef& cur, const BlockRef& nxt, char* lds, Seam& S, const int tid) {
    const int wid = __builtin_amdgcn_readfirstlane(tid >> 6), lane = tid & 63, r32 = lane & 31, hi = lane >> 5;
    const int NT = (cur.P0 + QB) / KVBLK - cur.jlo;
    const int qlo = cur.P0 + wid * QBLK, qm = qlo + r32 - 4 * hi;
    char* V_lds = lds; char* K_lds = lds + 2 * SHM_V; float* bias_l = (float*)(lds + OFF_BIAS);
    float* ws = (float*)(lds + OFF_WS) + wid * 64; float* li_l = ws, * al_l = ws + 32;
    float m_reg = -1e30f, l_reg = 0; f32x16 o[4] = {};
    const int sr = tid >> 4, sc = (tid & 15) * 8, vst0 = v_st(sr, sc), vst1 = v_st(32 + sr, sc), kws = KSWZ(sr, sc * 2);
    const int vb0 = (int)(uintptr_t)V_lds + v_rd_base(lane);
    const bf16_t* Kh = cur.K; const bf16_t* Vh = cur.V; const float* Ch = cur.cum;
#define RESC(a) do { if (__any((a) < 1.f)) { if (hi == 0) al_l[r32] = (a); asm volatile("s_waitcnt lgkmcnt(0)" ::: "memory");              \
                     for (int d_ = 0; d_ < 4; ++d_) for (int r = 0; r < 16; ++r) o[d_][r] *= al_l[crow(r, hi)]; } } while (0)
#define KBASE(t) ((cur.jlo + (t)) * KVBLK)
#define MASKT(P0_, P1_, t) do { const int kb_ = KBASE(t); if (kb_ + KVBLK - 1 > qlo) mask_tile(P0_, P1_, qm - kb_); } while (0)
#define BIAST(P0_, P1_, bf) do { if (Ch != nullptr) add_bias(P0_, P1_, bias_l + (bf) * 64, hi); } while (0)
    constexpr int NQL = 8;
#define SEAM_K0() do { VMWN(NQL); SWRITE_HK(0, nxt.cum); SBAR(); } while (0)
    f32x16 pA0, pA1, pB0, pB1; float mnA, mnB, alA, alB; bf16x8 pa0, pa1, pa2, pa3;
    char* qw = lds + OFF_Q + wid * 8192 + lane * 16;
#pragma unroll
    for (int d0 = NQREG; d0 < 8; ++d0) *reinterpret_cast<bf16x8*>(qw + d0 * 1024) = S.qr[d0];
    SWRITE_HV(0); SBAR();
    if (NT > 1) SLOAD_H(Kh, Vh, Ch, KBASE(1));
    SBAR(); qkt<0>(pA0, pA1, K_lds, r32, hi, S.qr, qw);
    BIAST(pA0, pA1, 0); MASKT(pA0, pA1, 0); partialSM(pA0, pA1, m_reg, mnA, alA);
    if (NT > 1) { VMW(); SWRITE_H(1, Ch); }
    __syncthreads();
#define HALF_STEP(PX0, PX1, mnX, alX, PY0, PY1, alY, t, KB, VB, SB) do {                                                      \
        SBAR(); qkt<KB>(PX0, PX1, K_lds, r32, hi, S.qr, qw);                                                         \
        finishSM(PY0, PY1, alY, l_reg, pa0, pa1, pa2, pa3); SBAR();                                                           \
        if ((t) + 1 < NT) { SLOAD_H(Kh, Vh, Ch, KBASE((t) + 1)); SBAR(); }                                                    \
        pv_tile<VB>(o, vb0, pa0, pa1, pa2, pa3); BIAST(PX0, PX1, KB); MASKT(PX0, PX1, (t)); partialSM(PX0, PX1, m_reg, mnX, alX); \
        __syncthreads();                                                                                                      \
        if ((t) + 1 < NT) { VMW(); SWRITE_H(SB, Ch); }                                                                        \
        RESC(alX); __syncthreads(); } while (0)
    for (int t = 1; t + 1 < NT; t += 2) {
        HALF_STEP(pB0, pB1, mnB, alB, pA0, pA1, alA, t, 1, 0, 0);
        HALF_STEP(pA0, pA1, mnA, alA, pB0, pB1, alB, t + 1, 0, 1, 1);
    }
    const bool even = (NT & 1) == 0;
    if (even) { SBAR(); qkt<1>(pB0, pB1, K_lds, r32, hi, S.qr, qw); SBAR(); }
    SLOAD_H(nxt.K, nxt.V, nxt.cum, nxt.jlo * KVBLK); SBAR();
#pragma unroll
    for (int d0 = 0; d0 < 8; ++d0) S.qr[d0] = load8(nxt.Q + (size_t)(wid * QBLK + r32) * D + d0 * 16 + hi * 8);
    SBAR();
    finishSM(pA0, pA1, alA, l_reg, pa0, pa1, pa2, pa3); SBAR();
    pv_tile<0>(o, vb0, pa0, pa1, pa2, pa3);
    if (even) { BIAST(pB0, pB1, 1); MASKT(pB0, pB1, NT - 1); partialSM(pB0, pB1, m_reg, mnB, alB); __syncthreads(); RESC(alB);
        finishSM(pB0, pB1, alB, l_reg, pa0, pa1, pa2, pa3); SBAR(); pv_tile<1>(o, vb0, pa0, pa1, pa2, pa3); }
    SBAR(); SEAM_K0();
    if (hi == 0) li_l[r32] = l_reg; asm volatile("s_waitcnt lgkmcnt(0)" ::: "memory");
    float rli[16];
#pragma unroll
    for (int r = 0; r < 16; ++r) rli[r] = __builtin_amdgcn_rcpf(li_l[crow(r, hi)]);
    float* Ow = cur.O + (size_t)(wid * QBLK) * D;
#pragma unroll
    for (int r = 0; r < 16; ++r) { const int orow = crow(r, hi);
#pragma unroll
        for (int d0 = 0; d0 < 4; ++d0) Ow[(size_t)orow * D + d0 * 32 + r32] = o[d0][r] * rli[r]; }
    __syncthreads();
#undef RESC
#undef KBASE
#undef MASKT
#undef BIAST
#undef SEAM_K0
#undef HALF_STEP
}
#undef ROW
#undef VMW
#undef VMWN
#undef SLOAD_H
#undef SWRITE_HK
#undef SWRITE_HV
#undef SWRITE_H
struct Ref2 { const bf16_t* Q; const bf16_t* K; const bf16_t* V0; const bf16_t* V1; float* O0; float* O1; int P0; };
constexpr int A2_V = 0, A2_K = 65536, A2_WS = 98304, A2_Q = 100352, A2_NQ = 8, A2_LDS_BYTES = A2_Q + NW * (8 - A2_NQ) * 1024;
template <int KB>
__device__ __forceinline__ void qkt2(f32x16& p0, f32x16& p1, const char* K_lds, int r32, int hi, const bf16x8* qr, const char* qw) {
    p0 = f32x16{}; p1 = f32x16{};
    const char* kb[4];
#pragma unroll
    for (int dd = 0; dd < 4; ++dd) kb[dd] = K_lds + KB * SHM_K + KSWZ(r32, (dd * 16 + hi * 8) * 2);
#pragma unroll
    for (int d0 = 0; d0 < 8; ++d0) { const char* a = kb[d0 & 3] + (d0 >> 2) * 128;
        bf16x8 b0 = *reinterpret_cast<const bf16x8*>(a);
        bf16x8 b1 = *reinterpret_cast<const bf16x8*>(a + 32 * 256);
        bf16x8 qf; if (d0 < A2_NQ) qf = qr[d0]; else qf = *reinterpret_cast<const bf16x8*>(qw + (d0 - A2_NQ) * 1024);
        p0 = __builtin_amdgcn_mfma_f32_32x32x16_bf16(b0, qf, p0, 0, 0, 0);
        p1 = __builtin_amdgcn_mfma_f32_32x32x16_bf16(b1, qf, p1, 0, 0, 0); }
}
template <int VB, int E>
__device__ __forceinline__ void pv2(f32x16* o, int vb0, bf16x8 pa0, bf16x8 pa1, bf16x8 pa2, bf16x8 pa3) {
#define TRRD(dst, off) asm volatile("ds_read_b64_tr_b16 %0, %1 offset:%2" : "=&v"(dst) : "v"(vb0), "i"(off) : "memory")
#define PV_D0(d0) do { s16x4 l0, l1, l2, l3, h0, h1, h2, h3; constexpr int b_ = VB * 32768 + E * 16384 + v_rd_off(d0, 0, 0); \
        TRRD(l0, b_); TRRD(h0, b_ + 2048); TRRD(l1, b_ + 4096); TRRD(h1, b_ + 6144); TRRD(l2, b_ + 8192); TRRD(h2, b_ + 10240); TRRD(l3, b_ + 12288); TRRD(h3, b_ + 14336); \
        asm volatile("s_waitcnt lgkmcnt(0)" ::: "memory"); SBAR();   \
        o[d0] = __builtin_amdgcn_mfma_f32_32x32x16_bf16(pa0, (bf16x8){l0[0], l0[1], l0[2], l0[3], h0[0], h0[1], h0[2], h0[3]}, o[d0], 0, 0, 0);   \
        o[d0] = __builtin_amdgcn_mfma_f32_32x32x16_bf16(pa1, (bf16x8){l1[0], l1[1], l1[2], l1[3], h1[0], h1[1], h1[2], h1[3]}, o[d0], 0, 0, 0);   \
        o[d0] = __builtin_amdgcn_mfma_f32_32x32x16_bf16(pa2, (bf16x8){l2[0], l2[1], l2[2], l2[3], h2[0], h2[1], h2[2], h2[3]}, o[d0], 0, 0, 0);   \
        o[d0] = __builtin_amdgcn_mfma_f32_32x32x16_bf16(pa3, (bf16x8){l3[0], l3[1], l3[2], l3[3], h3[0], h3[1], h3[2], h3[3]}, o[d0], 0, 0, 0); } while (0)
    PV_D0(0); PV_D0(1); PV_D0(2); PV_D0(3);
#undef PV_D0
#undef TRRD
}
__device__ __forceinline__ void attn2_item(const Ref2& R, char* lds, const int tid_in) {
    int tid = tid_in; asm volatile("" : "+v"(tid));
    const int wid = __builtin_amdgcn_readfirstlane(tid >> 6), lane = tid & 63, r32 = lane & 31, hi = lane >> 5;
    const int NT = (R.P0 + QB) / KVBLK;
    const int qlo = R.P0 + wid * QBLK, qm = qlo + r32 - 4 * hi;
    char* V_lds = lds + A2_V; char* K_lds = lds + A2_K;
    float* ws = (float*)(lds + A2_WS) + wid * 64; float* li_l = ws, * al_l = ws + 32;
    char* qw = lds + A2_Q + wid * ((8 - A2_NQ) * 1024) + lane * 16;
    const int vb0 = (int)(uintptr_t)V_lds + v_rd_base(lane);
    unsigned koff[2], voff[2];
#pragma unroll
    for (int i = 0; i < 2; ++i) {
        { const int row = 8 * wid + 4 * i + (lane >> 4), c = (lane & 15) ^ (row & 7); koff[i] = (unsigned)(row * 256 + c * 16); }
        { const int p = 2 * wid + i, st = 2 * p + (lane >> 5), ch = lane & 31, kk = (st >> 2) * 8 + (ch >> 2), c8 = (st & 3) * 4 + (ch & 3);
          const int k = (kk & ~0xC) | ((kk & 4) << 1) | ((kk & 8) >> 1); voff[i] = (unsigned)(k * 256 + c8 * 16); } }
#define DMA2(gbase, k0, ldsbase, off) do { _Pragma("unroll") for (int i_ = 0; i_ < 2; ++i_) \
        __builtin_amdgcn_global_load_lds((const unsigned*)((const char*)(gbase) + (size_t)(k0) * 256 + (off)[i_]), (__attribute__((address_space(3))) unsigned*)((ldsbase) + (2 * wid + i_) * 1024), 16, 0, 0); } while (0)
#define STAGE2(k0, B) do { DMA2(R.K, k0, K_lds + (B) * SHM_K, koff); DMA2(R.V0, k0, V_lds + (B) * 32768, voff); DMA2(R.V1, k0, V_lds + (B) * 32768 + 16384, voff); } while (0)
    bf16x8 qr[A2_NQ];
    STAGE2(0, 0);
#pragma unroll
    for (int d0 = 0; d0 < 8; ++d0) { const bf16x8 qf = load8(R.Q + (size_t)(wid * QBLK + r32) * D + d0 * 16 + hi * 8);
        if (d0 < A2_NQ) qr[d0] = qf; else *reinterpret_cast<bf16x8*>(qw + (d0 - A2_NQ) * 1024) = qf; }
    asm volatile("s_waitcnt vmcnt(0)" ::: "memory");
    __syncthreads();
    float m_reg = -1e30f, l_reg = 0; f32x16 o[8] = {};
#define RESC2(a) do { if (__any((a) < 1.f)) { if (hi == 0) al_l[r32] = (a); asm volatile("s_waitcnt lgkmcnt(0)" ::: "memory");              \
                     for (int d_ = 0; d_ < 8; ++d_) for (int r = 0; r < 16; ++r) o[d_][r] *= al_l[crow(r, hi)]; } } while (0)
#define STEP2(t, B) do { if ((t) + 1 < NT) STAGE2(((t) + 1) * KVBLK, 1 - B);               \
        SBAR(); f32x16 p0, p1; qkt2<B>(p0, p1, K_lds, r32, hi, qr, qw);                                                                \
        { const int kb_ = (t) * KVBLK; if (kb_ + KVBLK - 1 > qlo) mask_tile(p0, p1, qm - kb_); }                                         \
        float mn_, al_; bf16x8 pa0, pa1, pa2, pa3;                                                                                     \
        partialSM(p0, p1, m_reg, mn_, al_); finishSM(p0, p1, al_, l_reg, pa0, pa1, pa2, pa3); RESC2(al_); SBAR();                      \
        pv2<B, 0>(o, vb0, pa0, pa1, pa2, pa3); pv2<B, 1>(o + 4, vb0, pa0, pa1, pa2, pa3);                                                \
        asm volatile("s_waitcnt vmcnt(0)" ::: "memory"); __syncthreads(); } while (0)
    for (int t = 0; t < NT; t += 2) { STEP2(t, 0); STEP2(t + 1, 1); }
    if (hi == 0) li_l[r32] = l_reg; asm volatile("s_waitcnt lgkmcnt(0)" ::: "memory");
    float rli[16];
#pragma unroll
    for (int r = 0; r < 16; ++r) rli[r] = __builtin_amdgcn_rcpf(li_l[crow(r, hi)]);
    float* Ow0 = R.O0 + (size_t)(wid * QBLK) * D; float* Ow1 = R.O1 + (size_t)(wid * QBLK) * D;
#pragma unroll
    for (int r = 0; r < 16; ++r) { const int orow = crow(r, hi);
#pragma unroll
        for (int d0 = 0; d0 < 4; ++d0) { Ow0[(size_t)orow * D + d0 * 32 + r32] = o[d0][r] * rli[r]; Ow1[(size_t)orow * D + d0 * 32 + r32] = o[4 + d0][r] * rli[r]; } }
    asm volatile("s_waitcnt vmcnt(0)" ::: "memory");
    __syncthreads();
#undef STEP2
#undef RESC2
#undef STAGE2
#undef DMA2
}
}

constexpr size_t MiB = 1u << 20;
constexpr size_t WS_CTL = 0, CTL_ZERO_BYTES = 1 * MiB;
constexpr size_t SZ_WIN = (size_t)DIN_PAD * DM * 2, SZ_WOUT = (size_t)DM * DM * 2, SZ_WFF = (size_t)DFF * DM * 2;
constexpr size_t WS_WIN = 1 * MiB, WS_WOUT = WS_WIN + SZ_WIN, WS_WG = WS_WOUT + SZ_WOUT, WS_WU = WS_WG + SZ_WFF, WS_WD = WS_WU + SZ_WFF;
constexpr size_t WS_H = WS_WD + SZ_WFF;
constexpr size_t WS_P = WS_H + (size_t)M * DM * 2;
constexpr size_t SZ_P = (size_t)NSLAB * M * 128 * 2;
constexpr size_t WS_PS = WS_P + SZ_P;
constexpr size_t WS_Y = WS_PS + (size_t)M * 32 * 4;
constexpr size_t WS_X = WS_Y + (size_t)M * DM * 2;
constexpr size_t WS_OB = WS_X;
constexpr int REC_W = 0, REC_QG = 16384, REC_AQK = 32768, REC_KD = 40960, REC_DMA = 57344, REC_U = 57344, REC_BYTES = 90112;
constexpr size_t WS_DREC = WS_OB + (size_t)24 * M * 128 * 4;
constexpr size_t WS_DL = WS_DREC + (size_t)2048 * REC_BYTES;
constexpr size_t WS_DO = WS_DL + (size_t)2048 * 4;
constexpr size_t WS_CUM = WS_DO + (size_t)M * 8 * 128 * 4;
constexpr size_t WS_XEND = WS_CUM + (size_t)16 * T * 4;
constexpr size_t WS_XB = (WS_XEND + 255) / 256 * 256;
constexpr size_t WS_END = WS_XB + (size_t)M * DM * 2;
static_assert(SZ_P >= (size_t)M * DFF * 2, "gate overlays P");
static_assert(WS_XEND - WS_X >= (size_t)M * DFF * 2, "act overlays region X");
static_assert(WS_WIN % 256 == 0 && WS_H % 256 == 0 && WS_P % 256 == 0 && WS_Y % 256 == 0 && WS_X % 256 == 0, "alignment");
constexpr int CW_BAR = 4096, CW_Q = 8192, CW_NRM = 32768, CW_CV = 16384;
constexpr int LDS_BYTES = 163840, MISC_OFF = LDS_BYTES - 512;
static_assert(att::A2_LDS_BYTES <= MISC_OFF - 2048 && att::ATT_LDS_BYTES <= MISC_OFF - 2048, "attention LDS maps");
constexpr int NWAVES = 8;
typedef unsigned short bf16_t;
typedef unsigned u32x4 __attribute__((ext_vector_type(4)));
typedef unsigned u32x2 __attribute__((ext_vector_type(2)));
typedef float f32x2 __attribute__((ext_vector_type(2)));

struct Args { const float* in[21]; float* out; unsigned char* ws; int ph_lo, ph_hi; };
#define CAS __attribute__((address_space(4)))
typedef const CAS Args* ArgP;
enum { I_X = 0, I_ATTN_NORM, I_W_IN, I_SC_CONV, I_LQ1, I_LK1, I_LQ2, I_LK2, I_DIFF_NORM, I_DN_CONV, I_DN_ALOG, I_DN_DTB, I_DN_NORM, I_FOX_BIAS, I_W_OUT, I_FFN_NORM, I_W_GATE, I_W_UP, I_FFN_CONV, I_W_DOWN, I_FINAL_NORM };

__device__ __forceinline__ float shx(float v, int o, int lane) { return __int_as_float(__builtin_amdgcn_ds_bpermute((lane ^ o) << 2, __float_as_int(v))); }
__device__ __forceinline__ float shup(float v, int o, int lane) { return __int_as_float(__builtin_amdgcn_ds_bpermute(((lane - o) & 63) << 2, __float_as_int(v))); }
__device__ __forceinline__ float shlane(float v, int src) { return __int_as_float(__builtin_amdgcn_ds_bpermute(src << 2, __float_as_int(v))); }
__device__ __forceinline__ float wave_sum(float v, int lane) {
#pragma unroll
    for (int o = 1; o < 64; o <<= 1) v += shx(v, o, lane);
    return v;
}
__device__ __forceinline__ float silu_f(float x) { return x / (1.0f + __expf(-x)); }
__device__ __forceinline__ unsigned pkbf(float lo, float hi) { return pg8::cvt_pk_bf16(lo, hi); }

__host__ __device__ __forceinline__ int win_src(int n) {
    if (n < 10240) return n;
    if (n < 13312) return n + 16;
    const int j = n - 13312;
    if (j < 16) return 10240 + j;
    if (j < 24) return 13328 + (j - 16);
    return -1;
}
constexpr int NI_IN = (DM / 64) * (DIN_PAD / 64), NI_OUT = (DM / 64) * (DM / 64), NI_FF = (DM / 64) * (DFF / 64);
constexpr int CV_TOTAL0 = NI_IN, CV_TOTAL1 = NI_OUT + 3 * NI_FF + NI_IN, CV_TOTAL2 = NI_OUT + 3 * NI_FF;
constexpr int CV_SCR = 64 * 68 * 4;
struct CvItem { const float* W; bf16_t* WT; int Nsrc, K, k0, n0, remap; };
__device__ __forceinline__ CvItem cv_decode(ArgP A, int sel, int r) {
    unsigned char* ws = A->ws; const int l = sel == 2 ? 1 : 0; CvItem it;
    if (sel == 0) { it.W = A->in[I_W_IN]; it.WT = (bf16_t*)(ws + WS_WIN); it.Nsrc = DIN_SRC; it.K = DM; it.k0 = 64 * (r / (DIN_PAD / 64)); it.n0 = 64 * (r % (DIN_PAD / 64)); it.remap = 1; return it; }
    if (r < NI_OUT) { it.W = A->in[I_W_OUT] + (size_t)l * DM * DM; it.WT = (bf16_t*)(ws + WS_WOUT); it.Nsrc = DM; it.K = DM; it.k0 = 64 * (r / (DM / 64)); it.n0 = 64 * (r % (DM / 64)); it.remap = 0; return it; } r -= NI_OUT;
    if (r < NI_FF) { it.W = A->in[I_W_GATE] + (size_t)l * DM * DFF; it.WT = (bf16_t*)(ws + WS_WG); it.Nsrc = DFF; it.K = DM; it.k0 = 64 * (r / (DFF / 64)); it.n0 = 64 * (r % (DFF / 64)); it.remap = 0; return it; } r -= NI_FF;
    if (r < NI_FF) { it.W = A->in[I_W_UP] + (size_t)l * DM * DFF; it.WT = (bf16_t*)(ws + WS_WU); it.Nsrc = DFF; it.K = DM; it.k0 = 64 * (r / (DFF / 64)); it.n0 = 64 * (r % (DFF / 64)); it.remap = 0; return it; } r -= NI_FF;
    if (r < NI_FF) { it.W = A->in[I_W_DOWN] + (size_t)l * DFF * DM; it.WT = (bf16_t*)(ws + WS_WD); it.Nsrc = DM; it.K = DFF; it.k0 = 64 * (r / (DM / 64)); it.n0 = 64 * (r % (DM / 64)); it.remap = 0; return it; } r -= NI_FF;
    it.W = A->in[I_W_IN] + (size_t)DM * DIN_SRC; it.WT = (bf16_t*)(ws + WS_WIN); it.Nsrc = DIN_SRC; it.K = DM; it.k0 = 64 * (r / (DIN_PAD / 64)); it.n0 = 64 * (r % (DIN_PAD / 64)); it.remap = 1; return it;
}
__device__ __forceinline__ void cv_load(const CvItem& it, int lane, f32x4 (&v)[16]) {
    const int nl = 4 * (lane & 15), kr = lane >> 4;
    int sc = it.n0 + nl; if (it.remap) sc = win_src(it.n0 + nl);
#pragma unroll
    for (int i = 0; i < 16; ++i) { v[i] = (f32x4){0.f, 0.f, 0.f, 0.f}; if (sc >= 0) v[i] = *(const f32x4*)(it.W + (size_t)(it.k0 + 4 * i + kr) * it.Nsrc + sc); }
}
__device__ __forceinline__ void cv_store(const CvItem& it, LAS float* scr, int lane, const f32x4 (&v)[16]) {
    const int c4 = lane & 15, kr = lane >> 4;
#pragma unroll
    for (int i = 0; i < 16; ++i) *(LAS f32x4*)(scr + (4 * i + kr) * 68 + 4 * (c4 ^ (i >> 1))) = v[i];
    LDS_WAIT(); asm volatile("" ::: "memory");
    const int kc = lane & 7, nn = lane >> 3;
#pragma unroll
    for (int j = 0; j < 8; ++j) { const int n = nn + 8 * j; const LAS float* s = scr + (8 * kc) * 68 + 4 * ((n >> 2) ^ kc) + (n & 3);
        u32x4 o; o.x = pkbf(s[0 * 68], s[1 * 68]); o.y = pkbf(s[2 * 68], s[3 * 68]); o.z = pkbf(s[4 * 68], s[5 * 68]); o.w = pkbf(s[6 * 68], s[7 * 68]);
        *(u32x4*)(it.WT + (size_t)(it.n0 + n) * it.K + it.k0 + 8 * kc) = o; }
    LDS_WAIT(); asm volatile("" ::: "memory");
}
__device__ __forceinline__ void cv_run(ArgP A, int sel, int first, int n, int stride, LAS float* scr, int lane) {
    if (n <= 0) return;
    f32x4 va[16], vb[16];
    CvItem ia = cv_decode(A, sel, first), ib = ia;
    cv_load(ia, lane, va);
    for (int i = 0; i < n; i += 2) {
        if (i + 1 < n) { ib = cv_decode(A, sel, first + (i + 1) * stride); cv_load(ib, lane, vb); }
        cv_store(ia, scr, lane, va);
        if (i + 1 < n) {
            if (i + 2 < n) { ia = cv_decode(A, sel, first + (i + 2) * stride); cv_load(ia, lane, va); }
            cv_store(ib, scr, lane, vb); }
    }
}
__device__ __forceinline__ void phase_convert(ArgP A, LAS unsigned char* lds, int gw, int NGW, int wave, int lane) {
    LAS float* scr = (LAS float*)(lds + wave * CV_SCR);
    const int n = gw < CV_TOTAL0 ? (CV_TOTAL0 - gw + NGW - 1) / NGW : 0;
    cv_run(A, 0, gw, n, NGW, scr, lane);
}
__device__ __forceinline__ void conv_burst(ArgP A, int sel, unsigned* head, LAS unsigned char* lds, const int tid_in, int nchunks) {
    int tid = tid_in; asm volatile("" : "+v"(tid));
    const int lane = tid & 63, wave = __builtin_amdgcn_readfirstlane(tid >> 6), total = sel == 1 ? CV_TOTAL1 : CV_TOTAL2;
    LAS float* scr = (LAS float*)(lds + wave * CV_SCR);
    __syncthreads();
    for (int c = 0; c < nchunks; ++c) {
        int base = 0; if (lane == 0) base = (int)__hip_atomic_fetch_add(head, 8u, __ATOMIC_RELAXED, __HIP_MEMORY_SCOPE_AGENT);
        base = __builtin_amdgcn_readfirstlane(base);
        if (base >= total) break;
        cv_run(A, sel, base, total - base < 8 ? total - base : 8, 1, scr, lane);
    }
    asm volatile("s_waitcnt vmcnt(0)" ::: "memory");
    __syncthreads();
}
__device__ __forceinline__ void phase_norm(const float* x, const float* g, bf16_t* h, int gw, int NGW, int lane) {
    f32x4 gv[16];
#pragma unroll
    for (int j = 0; j < 16; ++j) gv[j] = *((const f32x4*)g + lane + 64 * j);
    for (int m = gw; m < M; m += NGW) {
        const f32x4* xr = (const f32x4*)(x + (size_t)m * DM) + lane;
        f32x4 v[16]; float s = 0.f;
#pragma unroll
        for (int j = 0; j < 16; ++j) { v[j] = xr[64 * j]; s += (v[j][0] * v[j][0] + v[j][1] * v[j][1]) + (v[j][2] * v[j][2] + v[j][3] * v[j][3]); }
        const float rs = rsqrtf(wave_sum(s, lane) * (1.0f / DM) + EPS);
        u32x2* o = (u32x2*)(h + (size_t)m * DM) + lane;
#pragma unroll
        for (int j = 0; j < 16; ++j) { u32x2 w; w.x = pkbf(v[j][0] * rs * gv[j][0], v[j][1] * rs * gv[j][1]); w.y = pkbf(v[j][2] * rs * gv[j][2], v[j][3] * rs * gv[j][3]); o[64 * j] = w; }
    }
}
__device__ __forceinline__ void phase_norm_b(const bf16_t* x, const float* g, bf16_t* h, int gw, int NGW, int lane) {
    for (int m = gw; m < M; m += NGW) {
        const u32x4* xr = (const u32x4*)(x + (size_t)m * DM) + lane;
        u32x4 w[8]; float s = 0.f;
#pragma unroll
        for (int j = 0; j < 8; ++j) w[j] = xr[64 * j];
#pragma unroll
        for (int j = 0; j < 8; ++j)
#pragma unroll
            for (int q = 0; q < 4; ++q) { const float a = pg8::bf_lo(w[j][q]), b = pg8::bf_hi(w[j][q]); s += a * a + b * b; }
        const float rs = rsqrtf(wave_sum(s, lane) * (1.0f / DM) + EPS);
        u32x4* o = (u32x4*)(h + (size_t)m * DM) + lane;
#pragma unroll
        for (int j = 0; j < 8; ++j) { const f32x4 g0 = *((const f32x4*)g + 2 * (lane + 64 * j)), g1 = *((const f32x4*)g + 2 * (lane + 64 * j) + 1); u32x4 r;
            r.x = pkbf(pg8::bf_lo(w[j].x) * rs * g0[0], pg8::bf_hi(w[j].x) * rs * g0[1]); r.y = pkbf(pg8::bf_lo(w[j].y) * rs * g0[2], pg8::bf_hi(w[j].y) * rs * g0[3]);
            r.z = pkbf(pg8::bf_lo(w[j].z) * rs * g1[0], pg8::bf_hi(w[j].z) * rs * g1[1]); r.w = pkbf(pg8::bf_lo(w[j].w) * rs * g1[2], pg8::bf_hi(w[j].w) * rs * g1[3]);
            o[64 * j] = r; }
    }
}
__device__ __forceinline__ void phase_final_norm_b(const bf16_t* x, float* out, const float* g, int gw, int NGW, int lane) {
    for (int m = gw; m < M; m += NGW) {
        const u32x4* xr = (const u32x4*)(x + (size_t)m * DM) + lane;
        u32x4 w[8]; float s = 0.f;
#pragma unroll
        for (int j = 0; j < 8; ++j) w[j] = xr[64 * j];
#pragma unroll
        for (int j = 0; j < 8; ++j)
#pragma unroll
            for (int q = 0; q < 4; ++q) { const float a = pg8::bf_lo(w[j][q]), b = pg8::bf_hi(w[j][q]); s += a * a + b * b; }
        const float rs = rsqrtf(wave_sum(s, lane) * (1.0f / DM) + EPS);
        f32x4* o = (f32x4*)(out + (size_t)m * DM) + 2 * lane;
#pragma unroll
        for (int j = 0; j < 8; ++j) { const f32x4 g0 = *((const f32x4*)g + 2 * (lane + 64 * j)), g1 = *((const f32x4*)g + 2 * (lane + 64 * j) + 1);
            o[128 * j] = (f32x4){pg8::bf_lo(w[j].x) * rs * g0[0], pg8::bf_hi(w[j].x) * rs * g0[1], pg8::bf_lo(w[j].y) * rs * g0[2], pg8::bf_hi(w[j].y) * rs * g0[3]};
            o[128 * j + 1] = (f32x4){pg8::bf_lo(w[j].z) * rs * g1[0], pg8::bf_hi(w[j].z) * rs * g1[1], pg8::bf_lo(w[j].w) * rs * g1[2], pg8::bf_hi(w[j].w) * rs * g1[3]}; }
    }
}
__device__ __forceinline__ void phase_final_norm(float* x, const float* g, int gw, int NGW, int lane) {
    f32x4 gv[16];
#pragma unroll
    for (int j = 0; j < 16; ++j) gv[j] = *((const f32x4*)g + lane + 64 * j);
    for (int m = gw; m < M; m += NGW) {
        f32x4* xr = (f32x4*)(x + (size_t)m * DM) + lane;
        f32x4 v[16]; float s = 0.f;
#pragma unroll
        for (int j = 0; j < 16; ++j) { v[j] = xr[64 * j]; s += (v[j][0] * v[j][0] + v[j][1] * v[j][1]) + (v[j][2] * v[j][2] + v[j][3] * v[j][3]); }
        const float rs = rsqrtf(wave_sum(s, lane) * (1.0f / DM) + EPS);
#pragma unroll
        for (int j = 0; j < 16; ++j) xr[64 * j] = v[j] * rs * gv[j];
    }
}
__device__ __forceinline__ void small_gemm(const bf16_t* H, const bf16_t* WT, float* psmall, LAS unsigned char* lds, int bid, const int tid_in) {
    int tid = tid_in; asm volatile("" : "+v"(tid));
    const int lane = tid & 63, wave = __builtin_amdgcn_readfirstlane(tid >> 6), fr = lane & 15, fq = lane >> 4;
    const bf16_t* ap = H + (size_t)(bid * 64 + fr) * DM + wave * 512 + 8 * fq;
    const bf16_t* bp = WT + (size_t)(13312 + fr) * DM + wave * 512 + 8 * fq;
    f32x4 acc[4][2];
#pragma unroll
    for (int m = 0; m < 4; ++m) { acc[m][0] = (f32x4){0.f, 0.f, 0.f, 0.f}; acc[m][1] = (f32x4){0.f, 0.f, 0.f, 0.f}; }
#pragma unroll 1
    for (int kb = 0; kb < 512; kb += 128) {
        bf16x8 a[4][4], b[4][2];
#pragma unroll
        for (int j = 0; j < 4; ++j) {
#pragma unroll
            for (int m = 0; m < 4; ++m) a[j][m] = *(const bf16x8*)(ap + (size_t)(16 * m) * DM + kb + 32 * j);
            b[j][0] = *(const bf16x8*)(bp + kb + 32 * j); b[j][1] = *(const bf16x8*)(bp + (size_t)16 * DM + kb + 32 * j); }
#pragma unroll
        for (int j = 0; j < 4; ++j)
#pragma unroll
            for (int m = 0; m < 4; ++m) { acc[m][0] = __builtin_amdgcn_mfma_f32_16x16x32_bf16(a[j][m], b[j][0], acc[m][0], 0, 0, 0); acc[m][1] = __builtin_amdgcn_mfma_f32_16x16x32_bf16(a[j][m], b[j][1], acc[m][1], 0, 0, 0); }
    }
    LAS float* red = (LAS float*)lds;
    __syncthreads();
#pragma unroll
    for (int m = 0; m < 4; ++m)
#pragma unroll
        for (int c = 0; c < 2; ++c)
#pragma unroll
            for (int i = 0; i < 4; ++i) red[(wave * 64 + 16 * m + 4 * fq + i) * 32 + 16 * c + fr] = acc[m][c][i];
    __syncthreads();
    { const int row = tid >> 3, c4 = 4 * (tid & 7); f32x4 s = *(const LAS f32x4*)(red + row * 32 + c4);
#pragma unroll
      for (int w = 1; w < 8; ++w) { const f32x4 t = *(const LAS f32x4*)(red + (w * 64 + row) * 32 + c4); s[0] += t[0]; s[1] += t[1]; s[2] += t[2]; s[3] += t[3]; }
      *(f32x4*)(psmall + (size_t)(bid * 64 + row) * 32 + c4) = s; }
    __syncthreads();
}
__device__ __forceinline__ void unpack8(const u32x4 w, float* f) {
#pragma unroll
    for (int q = 0; q < 4; ++q) { f[2 * q] = pg8::bf_lo(w[q]); f[2 * q + 1] = pg8::bf_hi(w[q]); }
}
__device__ __forceinline__ void phase_prep(ArgP A, int l, LAS float* red, int gtid, int NGT, int gw, int NGW, int lane) {
    unsigned char* ws = A->ws;
    const bf16_t* P = (const bf16_t*)(ws + WS_P); const float* PS = (const float*)(ws + WS_PS); bf16_t* Y = (bf16_t*)(ws + WS_Y);
    { const float* cw = A->in[I_SC_CONV] + (size_t)l * 3 * 1024;
      for (int it = gtid; it < (M / 16) * 128; it += NGT) {
          const int c8 = (it & 127) * 8, slab = c8 >> 7, cc = c8 & 127, m0 = (it >> 7) * 16;
          const bf16_t* ph = P + ((size_t)(0 + slab) * M + m0) * 128 + cc; const bf16_t* pc = P + ((size_t)(8 + slab) * M + m0) * 128 + cc; const bf16_t* pb = P + ((size_t)(16 + slab) * M + m0) * 128 + cc;
          float w[3][8];
#pragma unroll
          for (int j = 0; j < 3; ++j) { const f32x4 wa = *(const f32x4*)(cw + j * 1024 + c8), wb = *(const f32x4*)(cw + j * 1024 + c8 + 4);
#pragma unroll
              for (int i = 0; i < 4; ++i) { w[j][i] = wa[i]; w[j][4 + i] = wb[i]; } }
          float p0[8], p1[8];
          u32x4 H[4], C[4], B[4], h0 = {0u, 0u, 0u, 0u}, c0 = h0, h1 = h0, c1 = h0;
          if ((m0 & (T - 1)) != 0) { h0 = *(const u32x4*)(ph - 256); c0 = *(const u32x4*)(pc - 256); h1 = *(const u32x4*)(ph - 128); c1 = *(const u32x4*)(pc - 128); }
#pragma unroll
          for (int r = 0; r < 4; ++r) { H[r] = *(const u32x4*)(ph + r * 128); C[r] = *(const u32x4*)(pc + r * 128); B[r] = *(const u32x4*)(pb + r * 128); }
          { float a[8], b[8]; unpack8(h0, a); unpack8(c0, b);
#pragma unroll
            for (int i = 0; i < 8; ++i) p0[i] = a[i] * b[i];
            unpack8(h1, a); unpack8(c1, b);
#pragma unroll
            for (int i = 0; i < 8; ++i) p1[i] = a[i] * b[i]; }
#pragma unroll
          for (int rb = 0; rb < 16; rb += 4) {
              u32x4 Hn[4], Cn[4], Bn[4];
              if (rb < 12) {
#pragma unroll
                  for (int r = 0; r < 4; ++r) { Hn[r] = *(const u32x4*)(ph + (rb + 4 + r) * 128); Cn[r] = *(const u32x4*)(pc + (rb + 4 + r) * 128); Bn[r] = *(const u32x4*)(pb + (rb + 4 + r) * 128); } }
#pragma unroll
              for (int r = 0; r < 4; ++r) { float a[8], b[8], bb[8], p2[8], o[8]; unpack8(H[r], a); unpack8(C[r], b); unpack8(B[r], bb);
#pragma unroll
                  for (int i = 0; i < 8; ++i) { p2[i] = a[i] * b[i]; o[i] = bb[i] * (w[0][i] * p0[i] + w[1][i] * p1[i] + w[2][i] * p2[i]); p0[i] = p1[i]; p1[i] = p2[i]; }
                  u32x4 wv; wv.x = pkbf(o[0], o[1]); wv.y = pkbf(o[2], o[3]); wv.z = pkbf(o[4], o[5]); wv.w = pkbf(o[6], o[7]);
                  *(u32x4*)(Y + (size_t)(m0 + rb + r) * DM + c8) = wv; }
              if (rb < 12) {
#pragma unroll
                  for (int r = 0; r < 4; ++r) { H[r] = Hn[r]; C[r] = Cn[r]; B[r] = Bn[r]; } }
          } } }
    { float* NRMP = (float*)(ws + WS_CTL) + CW_NRM + 32768 * l;
      LAS float* wmax = red - 32 - 256;
      float mx0 = 0.f, mx1 = 0.f;
      const bool h5 = (lane & 32) != 0, h4 = (lane & 16) != 0, h3 = (lane & 8) != 0, h2 = (lane & 4) != 0;
      const int myi = (h5 ? 8 : 0) + (h4 ? 4 : 0) + (h3 ? 2 : 0) + (h2 ? 1 : 0);
      for (int mb = gw; mb < M; mb += 4 * NGW) { unsigned raw[4][16];
#pragma unroll
        for (int k = 0; k < 4; ++k) { const int m = mb + k * NGW;
#pragma unroll
          for (int i = 0; i < 16; ++i) raw[k][i] = m < M ? *(const unsigned*)(P + ((size_t)(80 + i) * M + m) * 128 + 2 * lane) : 0u; }
#pragma unroll
        for (int k = 0; k < 4; ++k) { const int m = mb + k * NGW; float s[16];
#pragma unroll
          for (int i = 0; i < 16; ++i) { const unsigned w = raw[k][i]; const float x0 = pg8::bf_lo(w), x1 = pg8::bf_hi(w); s[i] = x0 * x0 + x1 * x1; }
          float v8[8], v4[4], v2[2];
#pragma unroll
          for (int i = 0; i < 8; ++i) v8[i] = (h5 ? s[i + 8] : s[i]) + shx(h5 ? s[i] : s[i + 8], 32, lane);
#pragma unroll
          for (int i = 0; i < 4; ++i) v4[i] = (h4 ? v8[i + 4] : v8[i]) + shx(h4 ? v8[i] : v8[i + 4], 16, lane);
#pragma unroll
          for (int i = 0; i < 2; ++i) v2[i] = (h3 ? v4[i + 2] : v4[i]) + shx(h3 ? v4[i] : v4[i + 2], 8, lane);
          float v1 = (h2 ? v2[1] : v2[0]) + shx(h2 ? v2[0] : v2[1], 4, lane);
          v1 += shx(v1, 2, lane); v1 += shx(v1, 1, lane);
          if (m < M) { if ((m >> 13) == 0) mx0 = fmaxf(mx0, v1); else mx1 = fmaxf(mx1, v1); } } }
      const int wave = gw & 7, bid = gw >> 3;
      if ((lane & 3) == 0) { wmax[wave * 32 + myi] = mx0; wmax[wave * 32 + 16 + myi] = mx1; }
      __syncthreads();
      if (wave == 0 && lane < 32) { float v = wmax[lane];
#pragma unroll
          for (int w2 = 1; w2 < 8; ++w2) v = fmaxf(v, wmax[w2 * 32 + lane]);
          NRMP[bid * 32 + lane] = v; }
      __syncthreads(); }
    { const float* fb = A->in[I_FOX_BIAS] + l * 8; float* CUM = (float*)(ws + WS_CUM);
      const int bid = gw >> 3, tid = gtid & 511, wave = gw & 7;
      if (bid < 16) { const int b = bid >> 3, h = bid & 7; const float bias = fb[h];
          const float* src = PS + (size_t)(b * T + tid * 16) * 32 + 16 + h;
          float v[16]; float tot = 0.f;
#pragma unroll
          for (int i = 0; i < 16; ++i) v[i] = src[(size_t)i * 32];
#pragma unroll
          for (int i = 0; i < 16; ++i) { const float x = v[i] + bias; tot += fminf(x, 0.f) - log1pf(expf(-fabsf(x))); v[i] = tot; }
          float incl = tot;
#pragma unroll
          for (int o = 1; o < 64; o <<= 1) { const float u = shup(incl, o, lane); if (lane >= o) incl += u; }
          if (lane == 63) red[wave] = incl;
          __syncthreads();
          float base = incl - tot;
          for (int w2 = 0; w2 < wave; ++w2) base += red[w2];
          float* dst = CUM + (size_t)bid * T + tid * 16;
#pragma unroll
          for (int q4 = 0; q4 < 4; ++q4) *(f32x4*)(dst + 4 * q4) = (f32x4){v[4 * q4] + base, v[4 * q4 + 1] + base, v[4 * q4 + 2] + base, v[4 * q4 + 3] + base};
          __syncthreads(); } }
}
typedef float f32x16 __attribute__((ext_vector_type(16)));
typedef __bf16 bf16x2n __attribute__((ext_vector_type(2)));
__device__ __forceinline__ unsigned pk_native(float lo, float hi) { const f32x2 v = {lo, hi}; return __builtin_bit_cast(unsigned, __builtin_convertvector(v, bf16x2n)); }
__device__ __forceinline__ bf16_t bf1(float x) { return (bf16_t)(pk_native(x, x) & 0xffffu); }
__device__ __forceinline__ float bf2f(bf16_t x) { return __uint_as_float(((unsigned)x) << 16); }
__device__ __forceinline__ int crow32(int r, int hh) { return (r & 3) + 8 * (r >> 2) + 4 * hh; }
constexpr int DP_KB = 0, DP_QB = 17408, DP_VF = 34816, DP_AM = 68608, DP_AQ = 84992, DP_WB = 94208, DP_GC = 111616;
constexpr int DP_RAWQ = 112640, DP_RAWK = DP_RAWQ + 17152, DP_RAWV = DP_AM;
static_assert(DP_RAWK + 17152 <= MISC_OFF && DP_AM + 17152 <= DP_WB, "raw tiles");
__device__ __forceinline__ void phase_dnprep(ArgP A, int l, LAS unsigned char* lds, int G, int bid, const int tid_in) {
    unsigned char* ws = A->ws;
    const bf16_t* P = (const bf16_t*)(ws + WS_P); const float* PS = (const float*)(ws + WS_PS);
    const float* cw = A->in[I_DN_CONV] + (size_t)l * 4 * 3072; const float* alog = A->in[I_DN_ALOG] + l * 8; const float* dtb = A->in[I_DN_DTB] + l * 8;
    float* DL = (float*)(ws + WS_DL);
    const int tid0 = tid_in;
    LAS bf16_t* KB = (LAS bf16_t*)(lds + DP_KB); LAS bf16_t* QB = (LAS bf16_t*)(lds + DP_QB); LAS float* VF = (LAS float*)(lds + DP_VF);
    LAS float* AM = (LAS float*)(lds + DP_AM); LAS bf16_t* AQ = (LAS bf16_t*)(lds + DP_AQ); LAS bf16_t* WB = (LAS bf16_t*)(lds + DP_WB); LAS float* GC = (LAS float*)(lds + DP_GC);
    for (int it = bid; it < 2048; it += G) {
        int tid = tid0; asm volatile("" : "+v"(tid));
        const int lane = tid & 63, wave = __builtin_amdgcn_readfirstlane(tid >> 6);
        const int bh = it >> 7, n = it & 127, b = bh >> 3, h = bh & 7, t0 = n * 64, m0 = b * T + t0;
        unsigned char* rec = ws + WS_DREC + (size_t)it * REC_BYTES;
        { int tid_s = tid0; asm volatile("" : "+v"(tid_s)); const int tid = tid_s, lane = tid_s & 63; (void)tid; (void)lane; const int tok = tid >> 3, part = tid & 7, c0 = 16 * part, t = t0 + tok, mrow = m0 + tok;
          float r[3][16];
          u32x4 raw[3][4][2];
#pragma unroll
          for (int s = 0; s < 3; ++s)
#pragma unroll
              for (int j = 0; j < 4; ++j) { const int dt = 3 - j; const bf16_t* xp = P + ((size_t)(48 + 8 * s + h) * M + (t >= dt ? mrow - dt : mrow)) * 128 + c0; raw[s][j][0] = *(const u32x4*)xp; raw[s][j][1] = *(const u32x4*)(xp + 8); }
#pragma unroll
          for (int s = 0; s < 3; ++s) {
#pragma unroll
              for (int i = 0; i < 16; ++i) r[s][i] = 0.f;
#pragma unroll
              for (int j = 0; j < 4; ++j) { const int dt = 3 - j;
                  if (t >= dt) { float xx[16]; unpack8(raw[s][j][0], xx); unpack8(raw[s][j][1], xx + 8);
                      const float* wp = cw + j * 3072 + s * 1024 + h * 128 + c0;
#pragma unroll
                      for (int q4 = 0; q4 < 4; ++q4) { const f32x4 wv = *(const f32x4*)(wp + 4 * q4);
#pragma unroll
                          for (int i = 0; i < 4; ++i) r[s][4 * q4 + i] += wv[i] * xx[4 * q4 + i]; } } }
#pragma unroll
              for (int i = 0; i < 16; ++i) r[s][i] = silu_f(r[s][i]);
          }
          float sq = 0.f, sk = 0.f;
#pragma unroll
          for (int i = 0; i < 16; ++i) { sq += r[0][i] * r[0][i]; sk += r[1][i] * r[1][i]; }
#pragma unroll
          for (int o = 1; o < 8; o <<= 1) { sq += shx(sq, o, lane); sk += shx(sk, o, lane); }
          const float rq = rsqrtf(sq + EPS) * 0.08838834764831845f, rk = rsqrtf(sk + EPS);
          u32x4 w0, w1;
#pragma unroll
          for (int i = 0; i < 4; ++i) { w0[i] = pk_native(r[0][2 * i] * rq, r[0][2 * i + 1] * rq); w1[i] = pk_native(r[0][8 + 2 * i] * rq, r[0][9 + 2 * i] * rq); }
          *(LAS u32x4*)(QB + tok * 136 + c0) = w0; *(LAS u32x4*)(QB + tok * 136 + c0 + 8) = w1;
#pragma unroll
          for (int i = 0; i < 4; ++i) { w0[i] = pk_native(r[1][2 * i] * rk, r[1][2 * i + 1] * rk); w1[i] = pk_native(r[1][8 + 2 * i] * rk, r[1][9 + 2 * i] * rk); }
          *(LAS u32x4*)(KB + tok * 136 + c0) = w0; *(LAS u32x4*)(KB + tok * 136 + c0 + 8) = w1;
#pragma unroll
          for (int q4 = 0; q4 < 4; ++q4) *(LAS f32x4*)(VF + tok * 132 + c0 + 4 * q4) = (f32x4){r[2][4 * q4], r[2][4 * q4 + 1], r[2][4 * q4 + 2], r[2][4 * q4 + 3]};
          if (part == 0) { const float a = PS[(size_t)mrow * 32 + h] + dtb[h], bi = PS[(size_t)mrow * 32 + 8 + h];
              GC[tok] = -expf(alog[h]) * (fmaxf(a, 0.f) + log1pf(expf(-fabsf(a)))); GC[64 + tok] = 1.0f / (1.0f + expf(-bi)); } }
        __syncthreads();
        if (wave == 0) { int tid_s = tid0; asm volatile("" : "+v"(tid_s)); const int tid = tid_s, lane = tid_s & 63; (void)tid; (void)lane; float inc = GC[lane];
#pragma unroll
            for (int o = 1; o < 64; o <<= 1) { const float u = shup(inc, o, lane); if (lane >= o) inc += u; }
            const float glast = shlane(inc, 63);
            GC[lane] = inc; GC[128 + lane] = __expf(inc); GC[192 + lane] = __expf(glast - inc);
            if (lane == 63) DL[it] = __expf(inc); }
        __syncthreads();
        if (wave < 6) { int tid_s = tid0; asm volatile("" : "+v"(tid_s)); const int tid = tid_s, lane = tid_s & 63; (void)tid; (void)lane; const int kind = wave >= 3 ? 1 : 0, tl = wave - 3 * kind, itile = tl ? 1 : 0, jtile = tl == 2 ? 1 : 0, c = lane & 31, hh = lane >> 5;
            const LAS bf16_t* XA = kind ? QB : KB;
            f32x16 d = {};
#pragma unroll
            for (int s = 0; s < 8; ++s) { const att::bf16x8 av = *(const LAS att::bf16x8*)(XA + (32 * itile + c) * 136 + 16 * s + 8 * hh), bv = *(const LAS att::bf16x8*)(KB + (32 * jtile + c) * 136 + 16 * s + 8 * hh);
                d = __builtin_amdgcn_mfma_f32_32x32x16_bf16(av, bv, d, 0, 0, 0); }
            const int j = 32 * jtile + c; const float gcj = GC[j];
#pragma unroll
            for (int r = 0; r < 16; ++r) { const int i = 32 * itile + crow32(r, hh); const float e = __expf(fminf(GC[i] - gcj, 0.f));
                if (kind == 0) AM[i * 64 + j] = (i > j) ? GC[64 + i] * d[r] * e : 0.f;
                else AQ[i * 72 + j] = bf1((i >= j) ? d[r] * e : 0.f); } }
        else if (wave == 6) { int tid_s = tid0; asm volatile("" : "+v"(tid_s)); const int tid = tid_s, lane = tid_s & 63; (void)tid; (void)lane; for (int q = lane; q < 1024; q += 64) AM[(q >> 5) * 64 + 32 + (q & 31)] = 0.f; }
        else { int tid_s = tid0; asm volatile("" : "+v"(tid_s)); const int tid = tid_s, lane = tid_s & 63; (void)tid; (void)lane; for (int q = lane; q < 1024; q += 64) AQ[(q >> 5) * 72 + 32 + (q & 31)] = 0; }
        __syncthreads();
        if (wave < 4) { int tid_s = tid0; asm volatile("" : "+v"(tid_s)); const int tid = tid_s, lane = tid_s & 63; (void)tid; (void)lane; const int cc = tid & 127; const bool isW = wave < 2;
            int vz = 0; asm volatile("" : "+v"(vz));
            const LAS float* AMv = AM + vz;
            float x[64];
            if (isW) {
#pragma unroll
                for (int i = 0; i < 64; ++i) x[i] = bf2f(KB[i * 136 + cc]) * (GC[64 + i] * GC[128 + i]); }
            else {
#pragma unroll
                for (int i = 0; i < 64; ++i) x[i] = VF[i * 132 + cc] * GC[64 + i]; }
            __builtin_amdgcn_sched_barrier(0);
#pragma unroll
            for (int i = 1; i < 64; ++i) {
                float s0 = x[i], s1 = 0.f, s2 = 0.f, s3 = 0.f;
#pragma unroll
                for (int j4 = 0; j4 < (i + 3) / 4; ++j4) { const f32x4 a = *(const LAS f32x4*)(AMv + i * 64 + 4 * j4);
                    s0 -= a[0] * x[4 * j4];
                    if (4 * j4 + 1 < i) s1 -= a[1] * x[4 * j4 + 1];
                    if (4 * j4 + 2 < i) s2 -= a[2] * x[4 * j4 + 2];
                    if (4 * j4 + 3 < i) s3 -= a[3] * x[4 * j4 + 3]; }
                x[i] = (s0 + s1) + (s2 + s3); if (i & 1) __builtin_amdgcn_sched_barrier(0); }
            if (isW) {
#pragma unroll
                for (int i = 0; i < 64; ++i) WB[i * 136 + cc] = bf1(-x[i]); }
            else {
#pragma unroll
                for (int i = 0; i < 64; ++i) VF[i * 132 + cc] = x[i]; } }
        else { int tid_s = tid0; asm volatile("" : "+v"(tid_s)); const int tid = tid_s, lane = tid_s & 63; (void)tid; (void)lane; const int lw = wave - 4, c = lane & 31, hh = lane >> 5;
            for (int q = 0; q < 10; ++q) { const int f = lw * 10 + q;
                if (f < 16) { const int mt = f >> 3, ks = f & 7, i = 32 * mt + c; const LAS bf16_t* rp = QB + i * 136 + 16 * ks + 4 * hh; const float e = GC[128 + i];
                    const u32x2 lo = *(const LAS u32x2*)rp, hi2 = *(const LAS u32x2*)(rp + 8);
                    u32x4 w; w.x = pk_native(pg8::bf_lo(lo.x) * e, pg8::bf_hi(lo.x) * e); w.y = pk_native(pg8::bf_lo(lo.y) * e, pg8::bf_hi(lo.y) * e);
                    w.z = pk_native(pg8::bf_lo(hi2.x) * e, pg8::bf_hi(hi2.x) * e); w.w = pk_native(pg8::bf_lo(hi2.y) * e, pg8::bf_hi(hi2.y) * e);
                    *(u32x4*)(rec + REC_QG + f * 1024 + lane * 16) = w; }
                else if (f < 32) { const int g2 = f - 16, mt = g2 >> 2, ks = g2 & 3; float v[8];
#pragma unroll
                    for (int jj = 0; jj < 8; ++jj) { const int row = 16 * ks + 8 * (jj >> 2) + 4 * hh + (jj & 3); v[jj] = bf2f(KB[row * 136 + 32 * mt + c]) * GC[192 + row]; }
                    u32x4 w; w.x = pk_native(v[0], v[1]); w.y = pk_native(v[2], v[3]); w.z = pk_native(v[4], v[5]); w.w = pk_native(v[6], v[7]);
                    *(u32x4*)(rec + REC_KD + g2 * 1024 + lane * 16) = w; }
                else { const int g2 = f - 32, mt = g2 >> 2, ks = g2 & 3; const LAS bf16_t* rp = AQ + (32 * mt + c) * 72 + 16 * ks + 4 * hh;
                    const u32x2 lo = *(const LAS u32x2*)rp, hi2 = *(const LAS u32x2*)(rp + 8);
                    *(u32x4*)(rec + REC_AQK + g2 * 1024 + lane * 16) = (u32x4){lo.x, lo.y, hi2.x, hi2.y}; } } }
        __syncthreads();
        { int tid_s = tid0; asm volatile("" : "+v"(tid_s)); const int tid = tid_s, lane = tid_s & 63; (void)tid; (void)lane; const int c = lane & 31, hh = lane >> 5;
#pragma unroll
          for (int q = 0; q < 2; ++q) { const int f = wave * 2 + q, mt = f >> 3, ks = f & 7; const LAS bf16_t* rp = WB + (32 * mt + c) * 136 + 16 * ks + 4 * hh;
              const u32x2 lo = *(const LAS u32x2*)rp, hi2 = *(const LAS u32x2*)(rp + 8);
              *(u32x4*)(rec + REC_W + f * 1024 + lane * 16) = (u32x4){lo.x, lo.y, hi2.x, hi2.y}; }
          float* U = (float*)(rec + REC_U);
#pragma unroll
          for (int q = 0; q < 4; ++q) { const int idx = tid + 512 * q, row = idx >> 5, c4 = (idx & 31) * 4; *(f32x4*)(U + row * 128 + c4) = *(const LAS f32x4*)(VF + row * 132 + c4); } }
        __syncthreads();
    }
}
__device__ __forceinline__ att::bf16x8 pack_half(const f32x16& x, const int s) {
    u32x4 p; p.x = pk_native(x[8 * s], x[8 * s + 1]); p.y = pk_native(x[8 * s + 2], x[8 * s + 3]); p.z = pk_native(x[8 * s + 4], x[8 * s + 5]); p.w = pk_native(x[8 * s + 6], x[8 * s + 7]);
    return __builtin_bit_cast(att::bf16x8, p);
}
#define DN_BAR() do { asm volatile("s_waitcnt lgkmcnt(0)" ::: "memory"); __builtin_amdgcn_s_barrier(); asm volatile("" ::: "memory"); } while (0)
__device__ __forceinline__ void phase_scan(unsigned char* ws, LAS unsigned char* lds, int bh, int tid) {
    const int lane = tid & 63, wave = __builtin_amdgcn_readfirstlane(tid >> 6);
    const unsigned char* rec0 = ws + WS_DREC + (size_t)bh * 128 * REC_BYTES;
    if (wave >= 4) {
        const int lw = wave - 4;
#pragma unroll
        for (int f = 0; f < 14; ++f) { const int fi = lw * 14 + f;
            __builtin_amdgcn_global_load_lds((const unsigned*)(rec0 + fi * 1024 + lane * 16), (LAS unsigned*)(lds + fi * 1024), 16, 0, 0); }
        asm volatile("s_waitcnt vmcnt(0)" ::: "memory"); DN_BAR();
        for (int n = 0; n < 128; ++n) {
            if (n + 1 < 128) { const unsigned char* rn = rec0 + (size_t)(n + 1) * REC_BYTES; LAS unsigned char* bn = lds + ((n + 1) & 1) * REC_DMA;
#pragma unroll
                for (int f = 0; f < 14; ++f) { const int fi = lw * 14 + f;
                    __builtin_amdgcn_global_load_lds((const unsigned*)(rn + fi * 1024 + lane * 16), (LAS unsigned*)(bn + fi * 1024), 16, 0, 0); } }
            asm volatile("s_waitcnt vmcnt(0)" ::: "memory"); DN_BAR();
        }
    } else {
        const int w = wave, c = lane & 31, hh = lane >> 5, b = bh >> 3, h = bh & 7;
        f32x16 st[4] = {}; f32x16 vn[2];
        { const float* U0 = (const float*)(rec0 + REC_U);
#pragma unroll
          for (int mt = 0; mt < 2; ++mt)
#pragma unroll
              for (int r = 0; r < 16; ++r) vn[mt][r] = U0[(32 * mt + crow32(r, hh)) * 128 + 32 * w + c]; }
        float* DO = (float*)(ws + WS_DO); const float* DL = (const float*)(ws + WS_DL) + bh * 128;
        DN_BAR();
        for (int n = 0; n < 128; ++n) {
            const LAS unsigned char* buf = lds + (n & 1) * REC_DMA + lane * 16;
            const float dl = DL[n];
            att::bf16x8 sb[8];
#pragma unroll
            for (int ks = 0; ks < 8; ++ks) sb[ks] = pack_half(st[ks >> 1], ks & 1);
            f32x16 o[2] = {};
#pragma unroll
            for (int ks = 0; ks < 8; ++ks)
#pragma unroll
                for (int mt = 0; mt < 2; ++mt) {
                    const att::bf16x8 aw = *(const LAS att::bf16x8*)(buf + REC_W + (mt * 8 + ks) * 1024), aq = *(const LAS att::bf16x8*)(buf + REC_QG + (mt * 8 + ks) * 1024);
                    vn[mt] = __builtin_amdgcn_mfma_f32_32x32x16_bf16(aw, sb[ks], vn[mt], 0, 0, 0);
                    o[mt] = __builtin_amdgcn_mfma_f32_32x32x16_bf16(aq, sb[ks], o[mt], 0, 0, 0); }
            att::bf16x8 vb[4];
#pragma unroll
            for (int k4 = 0; k4 < 4; ++k4) vb[k4] = pack_half(vn[k4 >> 1], k4 & 1);
            if (n + 1 < 128) { const float* Un = (const float*)(rec0 + (size_t)(n + 1) * REC_BYTES + REC_U);
#pragma unroll
                for (int mt = 0; mt < 2; ++mt)
#pragma unroll
                    for (int r = 0; r < 16; ++r) vn[mt][r] = Un[(32 * mt + crow32(r, hh)) * 128 + 32 * w + c]; }
#pragma unroll
            for (int k4 = 0; k4 < 4; ++k4)
#pragma unroll
                for (int mt = 0; mt < 2; ++mt) { const att::bf16x8 aa = *(const LAS att::bf16x8*)(buf + REC_AQK + (mt * 4 + k4) * 1024);
                    o[mt] = __builtin_amdgcn_mfma_f32_32x32x16_bf16(aa, vb[k4], o[mt], 0, 0, 0); }
#pragma unroll
            for (int ti = 0; ti < 4; ++ti) { st[ti] = st[ti] * dl;
#pragma unroll
                for (int k4 = 0; k4 < 4; ++k4) { const att::bf16x8 ak = *(const LAS att::bf16x8*)(buf + REC_KD + (ti * 4 + k4) * 1024);
                    st[ti] = __builtin_amdgcn_mfma_f32_32x32x16_bf16(ak, vb[k4], st[ti], 0, 0, 0); } }
#pragma unroll
            for (int mt = 0; mt < 2; ++mt)
#pragma unroll
                for (int r = 0; r < 16; ++r) DO[((size_t)(b * T + 64 * n + 32 * mt + crow32(r, hh)) * 8 + h) * 128 + 32 * w + c] = o[mt][r];
            DN_BAR();
        }
    }
}
constexpr int Q_ITEMS = 64, Q_N = 8;
__device__ __forceinline__ att::Ref2 attn_ref2(unsigned char* ws, int qx, int L) {
    const int sr = L >> 1, mm = L & 1, b = qx >> 2, h = qx & 3, qb = 31 - sr;
    const bf16_t* P = (const bf16_t*)(ws + WS_P);
    att::Ref2 R;
    R.Q = P + ((size_t)(24 + 2 * h + mm) * M + (size_t)b * T + (size_t)qb * 256) * 128;
    R.K = P + ((size_t)(32 + 2 * h + mm) * M + (size_t)b * T) * 128;
    R.V0 = P + ((size_t)(40 + 2 * h) * M + (size_t)b * T) * 128; R.V1 = P + ((size_t)(41 + 2 * h) * M + (size_t)b * T) * 128;
    R.O0 = (float*)(ws + WS_OB) + ((size_t)(4 * h + 2 * mm) * M + (size_t)b * T + (size_t)qb * 256) * 128;
    R.O1 = (float*)(ws + WS_OB) + ((size_t)(4 * h + 2 * mm + 1) * M + (size_t)b * T + (size_t)qb * 256) * 128;
    R.P0 = qb * 256;
    return R;
}
__device__ __forceinline__ att::BlockRef attn_ref(unsigned char* ws, const volatile LAS float* nrm, int qx, int L, int lane) {
    const int sr = L >> 1, ci = L & 1, b = qx >> 2, qb = 31 - sr;
    const int vh = 16 + 2 * (qx & 3) + ci;
    const int h = vh - 16; const int sq = 80 + h, sk = 88 + h, sv = 96 + h; const float* cum = (const float*)(ws + WS_CUM) + (size_t)(b * 8 + h) * T;
    const bf16_t* P = (const bf16_t*)(ws + WS_P);
    att::BlockRef R;
    R.Q = P + ((size_t)sq * M + (size_t)b * T + (size_t)qb * 256) * 128;
    R.K = P + ((size_t)sk * M + (size_t)b * T) * 128;
    R.V = P + ((size_t)sv * M + (size_t)b * T) * 128;
    R.O = (float*)(ws + WS_OB) + ((size_t)vh * M + (size_t)b * T + (size_t)qb * 256) * 128;
    R.cum = cum; R.P0 = qb * 256; R.jlo = 0;
    if (qb > 0) {
        const float q2 = nrm[(qx >> 2) * 16 + (vh - 16)], k2 = nrm[(qx >> 2) * 16 + 8 + (vh - 16)];
        const float thresh = 2.0f * sqrtf(q2 * k2) * att::SCALE + 70.0f, c0 = cum[R.P0];
        const int ntp = 4 * qb;
        const bool s0 = lane < ntp && (cum[64 * lane + 63] - c0 >= thresh), s1 = lane + 64 < ntp && (cum[64 * (lane + 64) + 63] - c0 >= thresh);
        const unsigned long long b0 = __ballot(s0), b1 = __ballot(s1);
        int j = b0 == ~0ull ? 64 + (b1 == ~0ull ? 64 : __builtin_ctzll(~b1)) : __builtin_ctzll(~b0);
        R.jlo = __builtin_amdgcn_readfirstlane(j < ntp ? j : ntp);
    }
    return R;
}
__device__ __forceinline__ int queue_pop(unsigned* heads, int x0, int& k0, int& qx, volatile LAS unsigned* slot, int tid) {
    if (tid == 0) { int k = k0, v = -1;
        for (; k < Q_N; ++k) { const unsigned got = __hip_atomic_fetch_add(heads + 64 * ((x0 + k) & (Q_N - 1)), 1u, __ATOMIC_RELAXED, __HIP_MEMORY_SCOPE_AGENT); if (got < (unsigned)Q_ITEMS) { v = (int)got; break; } }
        slot[0] = (unsigned)v; slot[1] = (unsigned)k; }
    __syncthreads();
    const int v = __builtin_amdgcn_readfirstlane((int)slot[0]); k0 = __builtin_amdgcn_readfirstlane((int)slot[1]); qx = (x0 + k0) & (Q_N - 1);
    __syncthreads();
    return v;
}
__device__ __forceinline__ void phase_mix(ArgP A, unsigned char* ws, unsigned char* lds, int qid, int bid, const int tid) {
    const int lane = tid & 63;
    volatile LAS float* nrm = (volatile LAS float*)((LAS unsigned char*)lds + MISC_OFF + 256);
    { const float* NRMP = (const float*)(ws + WS_CTL) + CW_NRM + 32768 * (qid >> 1); volatile LAS float* part = (volatile LAS float*)((LAS unsigned char*)lds + MISC_OFF - 2048);
      const int G = gridDim.x; float v = 0.f;
      for (int b2 = tid >> 5; b2 < G; b2 += 16) v = fmaxf(v, NRMP[b2 * 32 + (tid & 31)]);
      part[tid] = v;
      __syncthreads();
      if (tid < 32) { float r = part[tid];
#pragma unroll
          for (int k = 1; k < 16; ++k) r = fmaxf(r, part[k * 32 + tid]);
          nrm[tid] = r; }
      __syncthreads(); }
    if (bid < 16) { phase_scan(ws, (LAS unsigned char*)lds, bid, tid); __syncthreads(); }
    unsigned* heads = (unsigned*)(ws + WS_CTL) + CW_Q + 1024 * qid;
    volatile LAS unsigned* slot = (volatile LAS unsigned*)((LAS unsigned char*)lds + MISC_OFF) + 16;
    const int x0 = (int)(xb_xcc_id() & 7u);
    int k0 = 0, qx = 0;
    const int csel = (qid >> 1) == 0 ? 1 : 2; unsigned* chead = (unsigned*)(ws + WS_CTL) + CW_CV + 64 * qid;
    if (bid & 1) conv_burst(A, csel, chead, (LAS unsigned char*)lds, tid, 2);
    { int tv = tid; asm volatile("" : "+v"(tv));
      for (;;) { const int L = queue_pop(heads, x0, k0, qx, slot, tv); if (L < 0) break;
          const att::Ref2 R = attn_ref2(ws, qx, L); att::attn2_item(R, (char*)lds, tv);
          conv_burst(A, csel, chead, (LAS unsigned char*)lds, tv, 1); } }
    { int tv = tid; asm volatile("" : "+v"(tv)); const int lane2 = tv & 63; int k1 = 0;
      for (;;) { const int L = queue_pop(heads + 8 * 64, x0, k1, qx, slot, tv); if (L < 0) break;
          const att::BlockRef cur = attn_ref(ws, nrm, qx, L, lane2); att::Seam S; att::attn_prime(cur, (char*)lds, S, tv); att::attn_block(cur, cur, (char*)lds, S, tv);
          conv_burst(A, csel, chead, (LAS unsigned char*)lds, tv, 1); } }
    conv_burst(A, csel, chead, (LAS unsigned char*)lds, tid, 1 << 30);
}
__device__ __forceinline__ void phase_post(ArgP A, int l, int gw, int NGW, int lane) {
    unsigned char* ws = A->ws;
    const float* OB = (const float*)(ws + WS_OB); const float* DO = (const float*)(ws + WS_DO); const bf16_t* P = (const bf16_t*)(ws + WS_P); bf16_t* Y = (bf16_t*)(ws + WS_Y);
    const float lam_init = 0.8f - 0.6f * expf(-0.3f * (float)l);
    float lam;
    { const float* q1 = A->in[I_LQ1] + l * 128; const float* k1 = A->in[I_LK1] + l * 128; const float* q2 = A->in[I_LQ2] + l * 128; const float* k2 = A->in[I_LK2] + l * 128;
      const float d1 = wave_sum(q1[lane] * k1[lane] + q1[lane + 64] * k1[lane + 64], lane), d2 = wave_sum(q2[lane] * k2[lane] + q2[lane + 64] * k2[lane + 64], lane);
      lam = expf(d1) - expf(d2) + lam_init; }
    const float* dng = A->in[I_DIFF_NORM] + l * 256; const f32x4 gd = *(const f32x4*)(dng + 4 * lane);
    const float* nng = A->in[I_DN_NORM] + l * 128; const f32x2 gn = *(const f32x2*)(nng + 2 * lane);
    const float post = 1.0f - lam_init;
    const int eh = lane >> 5, ec = (4 * lane) & 127;
    for (int m = gw; m < M; m += NGW) {
        f32x4 o1[4], o2[4]; f32x2 od[8]; unsigned zz[8]; f32x2 of[8];
#pragma unroll
        for (int h = 0; h < 4; ++h) { o1[h] = *(const f32x4*)(OB + ((size_t)(4 * h + 0 + eh) * M + m) * 128 + ec); o2[h] = *(const f32x4*)(OB + ((size_t)(4 * h + 2 + eh) * M + m) * 128 + ec); }
#pragma unroll
        for (int h = 0; h < 8; ++h) { od[h] = *(const f32x2*)(DO + ((size_t)m * 8 + h) * 128 + 2 * lane); zz[h] = *(const unsigned*)(P + ((size_t)(72 + h) * M + m) * 128 + 2 * lane);
            of[h] = *(const f32x2*)(OB + ((size_t)(16 + h) * M + m) * 128 + 2 * lane); }
        bf16_t* yr = Y + (size_t)m * DM;
        float sd[4], sn[8];
#pragma unroll
        for (int h = 0; h < 4; ++h) { o1[h] = o1[h] - lam * o2[h]; sd[h] = (o1[h][0] * o1[h][0] + o1[h][1] * o1[h][1]) + (o1[h][2] * o1[h][2] + o1[h][3] * o1[h][3]); }
#pragma unroll
        for (int h = 0; h < 8; ++h) sn[h] = od[h][0] * od[h][0] + od[h][1] * od[h][1];
#pragma unroll
        for (int o = 1; o < 64; o <<= 1) {
#pragma unroll
            for (int h = 0; h < 4; ++h) sd[h] += shx(sd[h], o, lane);
#pragma unroll
            for (int h = 0; h < 8; ++h) sn[h] += shx(sn[h], o, lane); }
#pragma unroll
        for (int h = 0; h < 4; ++h) { const float rs = rsqrtf(sd[h] * (1.0f / 256.0f) + EPS) * post;
            u32x2 w; w.x = pkbf(o1[h][0] * rs * gd[0], o1[h][1] * rs * gd[1]); w.y = pkbf(o1[h][2] * rs * gd[2], o1[h][3] * rs * gd[3]);
            *(u32x2*)(yr + 1024 + h * 256 + 4 * lane) = w; }
#pragma unroll
        for (int h = 0; h < 8; ++h) { const float rs = rsqrtf(sn[h] * (1.0f / 128.0f) + EPS); const float z0 = pg8::bf_lo(zz[h]), z1 = pg8::bf_hi(zz[h]);
            *(unsigned*)(yr + 2048 + h * 128 + 2 * lane) = pkbf(od[h][0] * rs * gn[0] * silu_f(z0), od[h][1] * rs * gn[1] * silu_f(z1));
            *(unsigned*)(yr + 3072 + h * 128 + 2 * lane) = pkbf(of[h][0], of[h][1]); }
    }
}

constexpr int PH_PER_LAYER = 10, PH_FINAL = NLAYER * PH_PER_LAYER, PH_TOTAL = PH_FINAL + 1;
__global__ void __launch_bounds__(NWAVES * 64, 2) mega(Args args) {
    extern __shared__ __attribute__((aligned(16))) unsigned char lds[];
    LAS unsigned char* ldsl = (LAS unsigned char*)lds;
    const int G = gridDim.x, bid = blockIdx.x;
    const int NGW = G * NWAVES, NGT = G * NWAVES * 64;
    volatile LAS unsigned* MISC = (volatile LAS unsigned*)(ldsl + MISC_OFF);
    if (threadIdx.x < 32) MISC[threadIdx.x] = 0u;
    const int wv0 = __builtin_amdgcn_readfirstlane(threadIdx.x >> 6);
    __syncthreads();
    const int lo = args.ph_lo, hi = args.ph_hi;
    XcdBarrier bar; bar.bar = (unsigned*)(args.ws + WS_CTL) + CW_BAR; bar.x = 0; bar.st = nullptr;
    if (hi - lo > 1) bar = xcd_barrier_post((unsigned*)(args.ws + WS_CTL) + CW_BAR, MISC + 8);
#ifndef ONLY_J
#define ONLY_J -1
#endif
#define IN(k) (lo <= (k) && (k) < hi)
#define INJ(j) ((ONLY_J < 0 || ONLY_J == (j)) && IN(pb + (j)))
#define SEAM(k) do { if (IN(k) && IN((k) + 1)) xcd_barrier(bar); } while (0)
#ifndef DUP_SITE
#define DUP_SITE -1
#endif
#define NREP(j) ((DUP_SITE == (j)) ? 2 : 1)
#define SITE() ArgP A = (ArgP)__builtin_amdgcn_kernarg_segment_ptr(); asm volatile("" : "+s"(A)); unsigned char* ws = A->ws; int tid; asm volatile("v_mbcnt_lo_u32_b32 %0, -1, 0\n\tv_mbcnt_hi_u32_b32 %0, -1, %0" : "=v"(tid)); tid += wv0 * 64; \
    const int lane = tid & 63, wave = __builtin_amdgcn_readfirstlane(tid >> 6), gw = bid * NWAVES + wave, gtid = bid * (NWAVES * 64) + tid; (void)lane; (void)wave; (void)gw; (void)gtid; (void)ws
    for (int l = 0; l < NLAYER; ++l) {
        const int pb = l * PH_PER_LAYER;
        for (int rep = 0; rep < NREP(0); ++rep) { if (rep) xcd_barrier(bar);
        if (INJ(0)) { SITE(); if (l == 0) phase_convert(A, ldsl, gw, NGW, wave, lane); if (l == 0) phase_norm(A->in[I_X], A->in[I_ATTN_NORM], (bf16_t*)(ws + WS_H), gw, NGW, lane); else phase_norm_b((const bf16_t*)(ws + WS_XB), A->in[I_ATTN_NORM] + DM, (bf16_t*)(ws + WS_H), gw, NGW, lane); }
        }
        SEAM(pb + 0);
        for (int rep = 0; rep < NREP(1); ++rep) { if (rep) xcd_barrier(bar);
        if (INJ(1)) { SITE(); pg8::Gemm g{(const bf16_t*)(ws + WS_H), (const bf16_t*)(ws + WS_WIN), M, 13312, DM}; pg8::StaticOrder S; S.init(M, 13312, G, bid);
            pg8::EpiSlab E{(bf16_t*)(ws + WS_P), (float*)(ws + WS_PS)};
            pg8::gemm_phase<pg8::EpiSlab, pg8::StaticOrder, true, true>(ldsl, g, S, E, tid);
            small_gemm((const bf16_t*)(ws + WS_H), (const bf16_t*)(ws + WS_WIN), (float*)(ws + WS_PS), ldsl, bid, tid); }
        }
        SEAM(pb + 1);
        for (int rep = 0; rep < NREP(2); ++rep) { if (rep) xcd_barrier(bar);
        if (INJ(2)) { SITE(); phase_prep(A, l, (LAS float*)(ldsl + MISC_OFF + 128), gtid, NGT, gw, NGW, lane); phase_dnprep(A, l, ldsl, G, bid, tid); }
        }
        SEAM(pb + 2);
        for (int rep = 0; rep < NREP(3); ++rep) { if (rep) xcd_barrier(bar);
        if (INJ(3)) { SITE(); phase_mix(A, ws, lds, 2 * l + rep, bid, tid); }
        }
        SEAM(pb + 3);
        for (int rep = 0; rep < NREP(4); ++rep) { if (rep) xcd_barrier(bar);
        if (INJ(4)) { SITE(); phase_post(A, l, gw, NGW, lane); }
        }
        SEAM(pb + 4);
        if (INJ(5)) { SITE(); pg8::Gemm g{(const bf16_t*)(ws + WS_Y), (const bf16_t*)(ws + WS_WOUT), M, DM, DM}; pg8::StaticOrder S; S.init(M, DM, G, bid);
            if (l == 0) { pg8::EpiResidB<true> E{(const void*)A->in[I_X], (bf16_t*)(ws + WS_XB)}; pg8::gemm_phase<pg8::EpiResidB<true>, pg8::StaticOrder, true, true>(ldsl, g, S, E, tid); }
            else { pg8::EpiResidB<false> E{(const void*)(ws + WS_XB), (bf16_t*)(ws + WS_XB)}; pg8::gemm_phase<pg8::EpiResidB<false>, pg8::StaticOrder, true, true>(ldsl, g, S, E, tid); } }
        SEAM(pb + 5);
        for (int rep = 0; rep < NREP(6); ++rep) { if (rep) xcd_barrier(bar);
        if (INJ(6)) { SITE(); phase_norm_b((const bf16_t*)(ws + WS_XB), A->in[I_FFN_NORM] + (size_t)l * DM, (bf16_t*)(ws + WS_H), gw, NGW, lane); }
        }
        SEAM(pb + 6);
        for (int rep = 0; rep < NREP(7); ++rep) { if (rep) xcd_barrier(bar);
        if (INJ(7)) { SITE(); pg8::Gemm g{(const bf16_t*)(ws + WS_H), (const bf16_t*)(ws + WS_WG), M, DFF, DM}; pg8::StaticOrder S; S.init(M, DFF, G, bid);
            pg8::EpiPlain E{(bf16_t*)(ws + WS_P), DFF};
            pg8::gemm_phase<pg8::EpiPlain, pg8::StaticOrder, true, true>(ldsl, g, S, E, tid); }
        }
        SEAM(pb + 7);
        for (int rep = 0; rep < NREP(8); ++rep) { if (rep) xcd_barrier(bar);
        if (INJ(8)) { SITE(); pg8::Gemm g{(const bf16_t*)(ws + WS_H), (const bf16_t*)(ws + WS_WU), M, DFF, DM}; pg8::RevOrder S; S.init(M, DFF, G, bid);
            pg8::EpiAct E{(const bf16_t*)(ws + WS_P), A->in[I_FFN_CONV] + (size_t)l * 3 * DFF, (bf16_t*)(ws + WS_X)};
            pg8::gemm_phase<pg8::EpiAct, pg8::RevOrder, true, true>(ldsl, g, S, E, tid); }
        }
        SEAM(pb + 8);
        if (INJ(9)) { SITE(); pg8::Gemm g{(const bf16_t*)(ws + WS_X), (const bf16_t*)(ws + WS_WD), M, DM, DFF}; pg8::StaticOrder S; S.init(M, DM, G, bid, 2);
            pg8::EpiResidB<false> E{(const void*)(ws + WS_XB), (bf16_t*)(ws + WS_XB)};
            pg8::gemm_phase<pg8::EpiResidB<false>, pg8::StaticOrder, true, true>(ldsl, g, S, E, tid); }
        SEAM(pb + 9);
    }
    if ((ONLY_J < 0 || ONLY_J == 10) && IN(PH_FINAL)) { SITE(); phase_final_norm_b((const bf16_t*)(ws + WS_XB), A->out, A->in[I_FINAL_NORM], gw, NGW, lane); }
#undef IN
#undef INJ
#undef SEAM
#undef SITE
}

extern "C" void kernel_launch(void* const* d_in, const int* in_sizes, int n_in, void* d_out, int out_size, void* d_ws, size_t ws_size, hipStream_t stream) {
    static int grid = 0;
    if (grid == 0) {
        if (n_in != 21 || out_size != M * DM || ws_size < WS_END) { fprintf(stderr, "kernel_launch: unexpected arguments (n_in %d, out %d, ws %zu, need %zu)\n", n_in, out_size, ws_size, (size_t)WS_END); grid = -1; return; }
        int dev = 0, cus = 0, per_cu = 0;
        if (hipGetDevice(&dev) != hipSuccess || hipDeviceGetAttribute(&cus, hipDeviceAttributeMultiprocessorCount, dev) != hipSuccess) { grid = -1; return; }
        if (hipFuncSetAttribute((const void*)mega, hipFuncAttributeMaxDynamicSharedMemorySize, LDS_BYTES) != hipSuccess) { fprintf(stderr, "kernel_launch: hipFuncSetAttribute failed\n"); grid = -1; return; }
        if (hipOccupancyMaxActiveBlocksPerMultiprocessor(&per_cu, (const void*)mega, NWAVES * 64, LDS_BYTES) != hipSuccess || per_cu < 1) fprintf(stderr, "kernel_launch: occupancy query reports %d\n", per_cu);
        (void)hipGetLastError();
        grid = cus;
    }
    if (grid < 0) return;
    (void)hipMemsetAsync((char*)d_ws + WS_CTL, 0, CTL_ZERO_BYTES, stream);
    Args a{};
    for (int i = 0; i < 21; ++i) a.in[i] = (const float*)d_in[i];
    a.out = (float*)d_out; a.ws = (unsigned char*)d_ws;
#ifndef N_CUT
#define N_CUT 1
#endif
#if N_CUT == 0
    for (int p = 0; p < PH_TOTAL; ++p) { a.ph_lo = p; a.ph_hi = p + 1; hipLaunchKernelGGL(mega, dim3(grid), dim3(NWAVES * 64), LDS_BYTES, stream, a); }
#else
    a.ph_lo = 0; a.ph_hi = PH_TOTAL; hipLaunchKernelGGL(mega, dim3(grid), dim3(NWAVES * 64), LDS_BYTES, stream, a);
#endif
}
```

```cpp
#include <hip/hip_runtime.h>
#include <cstdio>
#include <cstdint>
constexpr int NB = 2, T = 8192, M = NB * T, DM = 4096, DFF = 11008, NLAYER = 2;
constexpr int DIN_SRC = 13336;
constexpr int NSLAB = 104;
constexpr int DIN_PAD = 13568;
constexpr float EPS = 1e-6f;
namespace pg8 {
#define PG8_LAS __attribute__((address_space(3)))
typedef unsigned short bf16_t;
typedef short bf16x8 __attribute__((ext_vector_type(8)));
typedef float f32x4 __attribute__((ext_vector_type(4)));
typedef unsigned u32x4 __attribute__((ext_vector_type(4)));
constexpr int BM = 256, BK = 64, HALF = 128, HTB = HALF * BK * 2  , STAGE_BYTES = 8 * HTB, NXCD = 8, WGM = 8;

__host__ __device__ __forceinline__ int lds_byte(int r, int c) { const int st = (r >> 4) * 2 + (c >> 5), rr = r & 15, cc = c & 31, ob = rr * 64 + cc * 2; return st * 1024 + (ob ^ (((ob >> 9) & 1) << 5)); }
__host__ __device__ __forceinline__ void stage_rc(int b, int& R, int& C) { const int st = b / 1024, sb = b % 1024, swz = sb ^ (((sb >> 9) & 1) << 5); R = (st >> 1) * 16 + swz / 64; C = (st & 1) * 32 + (swz % 64) / 2; }
__host__ __device__ __forceinline__ int perm32(int rho) { const int n = rho >> 4, i = rho & 15; return 8 * (i >> 2) + 4 * n + (i & 3); }

struct Unit { int pm, pn; };
struct Gemm { const bf16_t* A; const bf16_t* Bt; int M, N, K; };

struct StaticOrder {
    int nM, nN, nwg, G, c, wgm;
    __host__ __device__ void init(int M, int N, int G_, int c_, int wgm_ = WGM) { nM = M / BM; nN = N / BM; nwg = nM * nN; G = G_; c = c_; wgm = wgm_; }
    __host__ __device__ bool next(int i, Unit& u) const {
        const long L = (long)i * G + c; if (L >= nwg) return false;
        int wgid = (int)L; { const int q = nwg / NXCD, r = nwg % NXCD, xcd = wgid % NXCD, off = wgid / NXCD; wgid = (xcd < r ? xcd * (q + 1) : r * (q + 1) + (xcd - r) * q) + off; }
        const int nig = wgm * nN, gid = wgid / nig, fm = gid * wgm, gsz = (nM - fm) < wgm ? (nM - fm) : wgm;
        u.pm = fm + ((wgid % nig) % gsz); u.pn = (wgid % nig) / gsz; return true;
    }
    __device__ __forceinline__ void a_ready(const Unit&) const {}
    __device__ __forceinline__ void done(const Unit&) const {}
};
struct RevOrder : StaticOrder {
    __host__ __device__ bool next(int i, Unit& u) const {
        const long L = (long)i * G + c; if (L >= nwg) return false;
        int wgid = nwg - 1 - (int)L; { const int q = nwg / NXCD, r = nwg % NXCD, xcd = wgid % NXCD, off = wgid / NXCD; wgid = (xcd < r ? xcd * (q + 1) : r * (q + 1) + (xcd - r) * q) + off; }
        const int nig = wgm * nN, gid = wgid / nig, fm = gid * wgm, gsz = (nM - fm) < wgm ? (nM - fm) : wgm;
        u.pm = fm + ((wgid % nig) % gsz); u.pn = (wgid % nig) / gsz; return true;
    }
};

__device__ __forceinline__ unsigned cvt_pk_bf16(float lo, float hi) { unsigned r; asm volatile("v_cvt_pk_bf16_f32 %0, %1, %2" : "=v"(r) : "v"(lo), "v"(hi)); return r; }
__device__ __forceinline__ float bf_lo(unsigned w) { return __uint_as_float(w << 16); }
__device__ __forceinline__ float bf_hi(unsigned w) { return __uint_as_float(w & 0xffff0000u); }

struct EpiSlab {
    static constexpr bool PERM = true, AFTER_DRAIN = false;
    bf16_t* P; float* psmall;
    __device__ __forceinline__ void operator()(const f32x4 (&acc)[2][2][4][2], const Unit& u, int wr, int wc, int fr, int fq) const {
        const int row0 = u.pm * BM + wr * 64 + fr;
        if (u.pn < 52) {
#pragma unroll
            for (int ai = 0; ai < 2; ++ai)
#pragma unroll
                for (int m = 0; m < 4; ++m) { const int row = row0 + ai * HALF + m * 16;
#pragma unroll
                    for (int bj = 0; bj < 2; ++bj) { const f32x4 v0 = acc[ai][bj][m][0], v1 = acc[ai][bj][m][1];
                        u32x4 w; w.x = cvt_pk_bf16(v0[0], v0[1]); w.y = cvt_pk_bf16(v0[2], v0[3]); w.z = cvt_pk_bf16(v1[0], v1[1]); w.w = cvt_pk_bf16(v1[2], v1[3]);
                        *(u32x4*)(P + ((size_t)(2 * u.pn + bj) * M + row) * 128 + wc * 32 + 8 * fq) = w; } }
        } else if (wc == 0) {
#pragma unroll
            for (int ai = 0; ai < 2; ++ai)
#pragma unroll
                for (int m = 0; m < 4; ++m) { float* rp = psmall + (size_t)(row0 + ai * HALF + m * 16) * 32 + 8 * fq;
                    *(f32x4*)(rp) = acc[ai][0][m][0]; *(f32x4*)(rp + 4) = acc[ai][0][m][1]; }
        }
    }
};
struct EpiPlain {
    static constexpr bool PERM = true, AFTER_DRAIN = false;
    bf16_t* O; int ldc;
    __device__ __forceinline__ void operator()(const f32x4 (&acc)[2][2][4][2], const Unit& u, int wr, int wc, int fr, int fq) const {
        const int row0 = u.pm * BM + wr * 64 + fr, col0 = u.pn * BM + wc * 32 + 8 * fq;
#pragma unroll
        for (int ai = 0; ai < 2; ++ai)
#pragma unroll
            for (int m = 0; m < 4; ++m) { bf16_t* rowp = O + (size_t)(row0 + ai * HALF + m * 16) * ldc + col0;
#pragma unroll
                for (int bj = 0; bj < 2; ++bj) { const f32x4 v0 = acc[ai][bj][m][0], v1 = acc[ai][bj][m][1];
                    u32x4 w; w.x = cvt_pk_bf16(v0[0], v0[1]); w.y = cvt_pk_bf16(v0[2], v0[3]); w.z = cvt_pk_bf16(v1[0], v1[1]); w.w = cvt_pk_bf16(v1[2], v1[3]);
                    *(u32x4*)(rowp + bj * HALF) = w; } }
    }
};
struct EpiAct {
    static constexpr bool PERM = true, AFTER_DRAIN = false;
    const bf16_t* G; const float* cw; bf16_t* O;
    __device__ __forceinline__ void operator()(const f32x4 (&acc)[2][2][4][2], const Unit& u, int wr, int wc, int fr, int fq) const {
        const int row0 = u.pm * BM + wr * 64 + fr, col0 = u.pn * BM + wc * 32 + 8 * fq;
#pragma unroll
        for (int bj = 0; bj < 2; ++bj) {
            const int col = col0 + bj * HALF;
            const f32x4 w0a = *(const f32x4*)(cw + col), w0b = *(const f32x4*)(cw + col + 4);
            const f32x4 w1a = *(const f32x4*)(cw + DFF + col), w1b = *(const f32x4*)(cw + DFF + col + 4);
            const f32x4 w2a = *(const f32x4*)(cw + 2 * DFF + col), w2b = *(const f32x4*)(cw + 2 * DFF + col + 4);
#pragma unroll
            for (int ai = 0; ai < 2; ++ai) {
                u32x4 g2[4], g1[4], g0[4];
#pragma unroll
                for (int m = 0; m < 4; ++m) {
                    const int row = row0 + ai * HALF + m * 16, t = row & (T - 1);
                    const bf16_t* gp = G + (size_t)row * DFF + col;
                    g2[m] = *(const u32x4*)gp; g1[m] = (u32x4){0u, 0u, 0u, 0u}; g0[m] = (u32x4){0u, 0u, 0u, 0u};
                    if (t >= 1) g1[m] = *(const u32x4*)(gp - DFF);
                    if (t >= 2) g0[m] = *(const u32x4*)(gp - 2 * DFF); }
#pragma unroll
                for (int m = 0; m < 4; ++m) {
                    const int row = row0 + ai * HALF + m * 16;
                    float a[8];
#pragma unroll
                    for (int q = 0; q < 4; ++q) {
                        const float wl0 = q < 2 ? w0a[2 * q] : w0b[2 * q - 4], wh0 = q < 2 ? w0a[2 * q + 1] : w0b[2 * q - 3];
                        const float wl1 = q < 2 ? w1a[2 * q] : w1b[2 * q - 4], wh1 = q < 2 ? w1a[2 * q + 1] : w1b[2 * q - 3];
                        const float wl2 = q < 2 ? w2a[2 * q] : w2b[2 * q - 4], wh2 = q < 2 ? w2a[2 * q + 1] : w2b[2 * q - 3];
                        a[2 * q]     = wl0 * bf_lo(g0[m][q]) + wl1 * bf_lo(g1[m][q]) + wl2 * bf_lo(g2[m][q]);
                        a[2 * q + 1] = wh0 * bf_hi(g0[m][q]) + wh1 * bf_hi(g1[m][q]) + wh2 * bf_hi(g2[m][q]);
                    }
                    const f32x4 v0 = acc[ai][bj][m][0], v1 = acc[ai][bj][m][1];
                    float o[8];
#pragma unroll
                    for (int i = 0; i < 8; ++i) { const float up = i < 4 ? v0[i] : v1[i - 4]; o[i] = a[i] * __builtin_amdgcn_rcpf(1.0f + __expf(-a[i])) * up; }
                    u32x4 w; w.x = cvt_pk_bf16(o[0], o[1]); w.y = cvt_pk_bf16(o[2], o[3]); w.z = cvt_pk_bf16(o[4], o[5]); w.w = cvt_pk_bf16(o[6], o[7]);
                    *(u32x4*)(O + (size_t)row * DFF + col) = w;
                }
                asm volatile("" ::: "memory");
            }
        }
    }
};
struct EpiResid {
    static constexpr bool PERM = false, AFTER_DRAIN = false;
    const float* base; float* out;
    __device__ __forceinline__ void operator()(const f32x4 (&acc)[2][2][4][2], const Unit& u, int wr, int wc, int fr, int fq) const {
        const int row0 = u.pm * BM + wr * 64 + fr, col0 = u.pn * BM + wc * 32 + 4 * fq;
#pragma unroll
        for (int ai = 0; ai < 2; ++ai)
#pragma unroll
            for (int mp = 0; mp < 2; ++mp) {
                f32x4 b[2][2][2];
#pragma unroll
                for (int mm = 0; mm < 2; ++mm) { const size_t off = (size_t)(row0 + ai * HALF + (2 * mp + mm) * 16) * DM + col0;
#pragma unroll
                    for (int bj = 0; bj < 2; ++bj)
#pragma unroll
                        for (int n = 0; n < 2; ++n) b[mm][bj][n] = *(const f32x4*)(base + off + bj * HALF + n * 16); }
#pragma unroll
                for (int mm = 0; mm < 2; ++mm) { const size_t off = (size_t)(row0 + ai * HALF + (2 * mp + mm) * 16) * DM + col0;
#pragma unroll
                    for (int bj = 0; bj < 2; ++bj)
#pragma unroll
                        for (int n = 0; n < 2; ++n) *(f32x4*)(out + off + bj * HALF + n * 16) = b[mm][bj][n] + acc[ai][bj][2 * mp + mm][n]; }
                asm volatile("" ::: "memory"); }
    }
};

template <bool F32BASE> struct EpiResidB {
    static constexpr bool PERM = true, AFTER_DRAIN = false;
    const void* base; bf16_t* out;
    __device__ __forceinline__ void operator()(const f32x4 (&acc)[2][2][4][2], const Unit& u, int wr, int wc, int fr, int fq) const {
        const int row0 = u.pm * BM + wr * 64 + fr, col0 = u.pn * BM + wc * 32 + 8 * fq;
#pragma unroll
        for (int ai = 0; ai < 2; ++ai)
#pragma unroll
            for (int mp = 0; mp < 2; ++mp) {
                f32x4 b[2][2][2];
#pragma unroll
                for (int mm = 0; mm < 2; ++mm) { const size_t off = (size_t)(row0 + ai * HALF + (2 * mp + mm) * 16) * DM + col0;
#pragma unroll
                    for (int bj = 0; bj < 2; ++bj) {
                        if constexpr (F32BASE) { const float* bp = (const float*)base + off + bj * HALF; b[mm][bj][0] = *(const f32x4*)bp; b[mm][bj][1] = *(const f32x4*)(bp + 4); }
                        else { const u32x4 w = *(const u32x4*)((const bf16_t*)base + off + bj * HALF);
                            b[mm][bj][0] = (f32x4){bf_lo(w.x), bf_hi(w.x), bf_lo(w.y), bf_hi(w.y)}; b[mm][bj][1] = (f32x4){bf_lo(w.z), bf_hi(w.z), bf_lo(w.w), bf_hi(w.w)}; } } }
#pragma unroll
                for (int mm = 0; mm < 2; ++mm) { const size_t off = (size_t)(row0 + ai * HALF + (2 * mp + mm) * 16) * DM + col0;
#pragma unroll
                    for (int bj = 0; bj < 2; ++bj) { const f32x4 v0 = b[mm][bj][0] + acc[ai][bj][2 * mp + mm][0], v1 = b[mm][bj][1] + acc[ai][bj][2 * mp + mm][1];
                        u32x4 w; w.x = cvt_pk_bf16(v0[0], v0[1]); w.y = cvt_pk_bf16(v0[2], v0[3]); w.z = cvt_pk_bf16(v1[0], v1[1]); w.w = cvt_pk_bf16(v1[2], v1[3]);
                        *(u32x4*)(out + off + bj * HALF) = w; } }
                asm volatile("" ::: "memory"); }
    }
};

template <class Epi, class Sched, bool ALIGN_EPI = false, bool SP2 = false>
__device__ __forceinline__ void gemm_phase(PG8_LAS unsigned char* lds, const Gemm g, const Sched& S, const Epi& E, const int tid_in) {
    int tid = tid_in; asm volatile("" : "+v"(tid));
    const int wid = __builtin_amdgcn_readfirstlane(tid >> 6), lane = tid & 63, wr = wid >> 2, wc = wid & 3, fr = lane & 15, fq = lane >> 4;
    const int K = g.K, nt = K / BK;
    unsigned voffA[2], voffB[2];
#pragma unroll
    for (int i = 0; i < 2; ++i) { int R, C; stage_rc(tid * 16 + i * 8192, R, C); const int Rb = Epi::PERM ? ((R & ~31) + perm32(R & 31)) : R;
        voffA[i] = (unsigned)(R * K + C) * 2u; voffB[i] = (unsigned)(Rb * K + C) * 2u; }
    const size_t kstep = (size_t)(BK * 2);
    const size_t hstep = (size_t)HALF * K * 2;
    const size_t tstep = 2 * hstep;
    const unsigned ldsw = (unsigned)wid * 1024u;
    const int aoff = lds_byte(wr * 64 + fr, fq * 8), boff = lds_byte(wc * 32 + fr, fq * 8);
#define PG8_SA(b, h) (((b) * 2 + (h)) * HTB)
#define PG8_SB(b, h) ((4 + (b) * 2 + (h)) * HTB)
#define PG8_STAGE(bufoff, gbase, voff) do { _Pragma("unroll") for (int _i = 0; _i < 2; ++_i) \
        __builtin_amdgcn_global_load_lds((const unsigned*)((const char*)(gbase) + (voff)[_i]), (PG8_LAS unsigned*)(lds + (bufoff) + ldsw + _i * 8192), 16, 0, 0); } while (0)
#define PG8_LDA(dst, b, h) do { _Pragma("unroll") for (int m = 0; m < 4; ++m) _Pragma("unroll") for (int k = 0; k < 2; ++k) dst[m][k] = *(const PG8_LAS bf16x8*)(lds + PG8_SA(b, h) + aoff + m * 2048 + k * 1024); } while (0)
#define PG8_LDB(dst, b, h) do { _Pragma("unroll") for (int n = 0; n < 2; ++n) _Pragma("unroll") for (int k = 0; k < 2; ++k) dst[n][k] = *(const PG8_LAS bf16x8*)(lds + PG8_SB(b, h) + boff + n * 2048 + k * 1024); } while (0)
#define PG8_MMA(ai, bj, At, Bt) do { __builtin_amdgcn_s_setprio(1); _Pragma("unroll") for (int m = 0; m < 4; ++m) _Pragma("unroll") for (int n = 0; n < 2; ++n) _Pragma("unroll") for (int k = 0; k < 2; ++k) \
        acc[ai][bj][m][n] = __builtin_amdgcn_mfma_f32_16x16x32_bf16(Bt[n][k], At[m][k], acc[ai][bj][m][n], 0, 0, 0); __builtin_amdgcn_s_setprio(0); } while (0)
#define PG8_WAIT_V(n) asm volatile("s_waitcnt vmcnt(" #n ")" ::: "memory")
#define PG8_WAIT_L(n) asm volatile("s_waitcnt lgkmcnt(" #n ")" ::: "memory")
#define PG8_BAR __builtin_amdgcn_s_barrier()
#define PG8_SCHED __builtin_amdgcn_sched_barrier(0)
    Unit cur, nxt; int ui = 0;
    if (!S.next(0, cur)) return;
    f32x4 acc[2][2][4][2];
#pragma unroll
    for (int a = 0; a < 2; ++a)
#pragma unroll
        for (int b = 0; b < 2; ++b)
#pragma unroll
            for (int m = 0; m < 4; ++m)
#pragma unroll
                for (int n = 0; n < 2; ++n) acc[a][b][m][n] = (f32x4){0.f, 0.f, 0.f, 0.f};
    bf16x8 At[4][2], B0[2][2], B1[2][2];
    const char* cA = (const char*)g.A + (size_t)cur.pm * tstep; const char* cB = (const char*)g.Bt + (size_t)cur.pn * tstep;
    S.a_ready(cur);
    if constexpr (SP2) {
        PG8_STAGE(PG8_SB(0, 0), cB, voffB); PG8_STAGE(PG8_SB(0, 1), cB + hstep, voffB); PG8_STAGE(PG8_SA(0, 0), cA, voffA); PG8_STAGE(PG8_SA(0, 1), cA + hstep, voffA);
        if (wr == 1) PG8_BAR;
        PG8_WAIT_V(2); PG8_BAR;
        PG8_STAGE(PG8_SB(1, 0), cB + kstep, voffB); PG8_STAGE(PG8_SA(1, 0), cA + kstep, voffA); PG8_STAGE(PG8_SB(1, 1), cB + hstep + kstep, voffB);
        PG8_WAIT_V(6); PG8_BAR;
    } else {
        PG8_STAGE(PG8_SB(0, 0), cB, voffB); PG8_STAGE(PG8_SA(0, 0), cA, voffA); PG8_STAGE(PG8_SB(0, 1), cB + hstep, voffB); PG8_STAGE(PG8_SA(0, 1), cA + hstep, voffA);
        if (wr == 1) PG8_BAR;
        PG8_WAIT_V(4); PG8_BAR;
        PG8_STAGE(PG8_SB(1, 0), cB + kstep, voffB); PG8_STAGE(PG8_SA(1, 0), cA + kstep, voffA); PG8_STAGE(PG8_SB(1, 1), cB + hstep + kstep, voffB);
        PG8_WAIT_V(6); PG8_BAR;
    }
    for (;;) {
        const bool has_next = S.next(ui + 1, nxt);
        const char* nA = has_next ? (const char*)g.A + (size_t)nxt.pm * tstep : cA; const char* nB = has_next ? (const char*)g.Bt + (size_t)nxt.pn * tstep : cB;
        for (int t = 0; t < nt; t += 2) {
            const bool last = (t == nt - 2);
            const char* a1 = cA + (size_t)(t + 1) * kstep;
            const char* a2 = last ? nA : cA + (size_t)(t + 2) * kstep; const char* b2 = last ? nB : cB + (size_t)(t + 2) * kstep;
            const char* a3 = a2 + kstep; const char* b3 = b2 + kstep;
            if (last && has_next) S.a_ready(nxt);
            if constexpr (SP2) {
            PG8_LDB(B0, 0, 0); PG8_LDB(B1, 0, 1); PG8_SCHED; PG8_LDA(At, 0, 0); PG8_STAGE(PG8_SA(1, 1), a1 + hstep, voffA);
            PG8_WAIT_V(8); PG8_WAIT_L(0); PG8_BAR; PG8_MMA(0, 0, At, B0); PG8_MMA(0, 1, At, B1); PG8_BAR; PG8_SCHED;
            PG8_LDA(At, 0, 1); PG8_STAGE(PG8_SB(0, 0), b2, voffB); PG8_STAGE(PG8_SB(0, 1), b2 + hstep, voffB); PG8_STAGE(PG8_SA(0, 0), a2, voffA);
            PG8_WAIT_V(8); PG8_WAIT_L(0); PG8_BAR; PG8_MMA(1, 0, At, B0); PG8_MMA(1, 1, At, B1); PG8_BAR; PG8_SCHED;
            PG8_LDB(B0, 1, 0); PG8_LDB(B1, 1, 1); PG8_SCHED; PG8_LDA(At, 1, 0); PG8_STAGE(PG8_SA(0, 1), a2 + hstep, voffA);
            PG8_WAIT_V(8); PG8_WAIT_L(0); PG8_BAR; PG8_MMA(0, 0, At, B0); PG8_MMA(0, 1, At, B1); PG8_BAR; PG8_SCHED;
            PG8_LDA(At, 1, 1); PG8_STAGE(PG8_SB(1, 0), b3, voffB); PG8_STAGE(PG8_SB(1, 1), b3 + hstep, voffB); PG8_STAGE(PG8_SA(1, 0), a3, voffA);
            PG8_WAIT_V(8); PG8_WAIT_L(0); PG8_BAR; PG8_MMA(1, 0, At, B0); PG8_MMA(1, 1, At, B1); PG8_BAR; PG8_SCHED;
            } else {
            PG8_LDB(B0, 0, 0); PG8_SCHED; PG8_LDA(At, 0, 0); PG8_STAGE(PG8_SA(1, 1), a1 + hstep, voffA);
            PG8_WAIT_L(8); PG8_BAR; PG8_WAIT_L(0); PG8_MMA(0, 0, At, B0); PG8_BAR; PG8_SCHED;
            PG8_LDB(B1, 0, 1); PG8_STAGE(PG8_SB(0, 0), b2, voffB);
            PG8_BAR; PG8_WAIT_L(0); PG8_MMA(0, 1, At, B1); PG8_BAR;
            PG8_LDA(At, 0, 1); PG8_STAGE(PG8_SA(0, 0), a2, voffA);
            PG8_BAR; PG8_WAIT_L(0); PG8_MMA(1, 0, At, B0); PG8_BAR; PG8_SCHED;
            PG8_STAGE(PG8_SB(0, 1), b2 + hstep, voffB);
            PG8_WAIT_V(6); PG8_BAR; PG8_MMA(1, 1, At, B1); PG8_BAR;
            PG8_LDB(B0, 1, 0); PG8_SCHED; PG8_LDA(At, 1, 0); PG8_STAGE(PG8_SA(0, 1), a2 + hstep, voffA);
            PG8_WAIT_L(8); PG8_BAR; PG8_WAIT_L(0); PG8_MMA(0, 0, At, B0); PG8_BAR; PG8_SCHED;
            PG8_LDB(B1, 1, 1); PG8_STAGE(PG8_SB(1, 0), b3, voffB);
            PG8_BAR; PG8_WAIT_L(0); PG8_MMA(0, 1, At, B1); PG8_BAR;
            PG8_LDA(At, 1, 1); PG8_STAGE(PG8_SA(1, 0), a3, voffA);
            PG8_BAR; PG8_WAIT_L(0); PG8_MMA(1, 0, At, B0); PG8_BAR; PG8_SCHED;
            PG8_STAGE(PG8_SB(1, 1), b3 + hstep, voffB);
            PG8_WAIT_V(6); PG8_BAR; PG8_MMA(1, 1, At, B1); PG8_BAR;
            }
        }
        if constexpr (ALIGN_EPI) { if (wr == 0) PG8_BAR; }
        if constexpr (!Epi::AFTER_DRAIN) { E(acc, cur, wr, wc, fr, fq); S.done(cur); }
        if (!has_next) break;
#pragma unroll
        for (int a = 0; a < 2; ++a)
#pragma unroll
            for (int b = 0; b < 2; ++b)
#pragma unroll
                for (int m = 0; m < 4; ++m)
#pragma unroll
                    for (int n = 0; n < 2; ++n) acc[a][b][m][n] = (f32x4){0.f, 0.f, 0.f, 0.f};
        cur = nxt; cA = nA; cB = nB; ++ui;
        if constexpr (ALIGN_EPI) { if (wr == 1) PG8_BAR; }
    }
    PG8_WAIT_V(0);
    if constexpr (!ALIGN_EPI) { if (wr == 0) PG8_BAR; }
    PG8_BAR;
    if constexpr (Epi::AFTER_DRAIN) { E.fused(acc, cur, wr, wc, fr, fq, lds, wid, lane); S.done(cur); }
#undef PG8_SA
#undef PG8_SB
#undef PG8_STAGE
#undef PG8_LDA
#undef PG8_LDB
#undef PG8_MMA
#undef PG8_WAIT_V
#undef PG8_WAIT_L
#undef PG8_BAR
#undef PG8_SCHED
}
}
#define GAS __attribute__((address_space(1)))
#define LAS __attribute__((address_space(3)))
typedef unsigned short bf16;
typedef unsigned v4u __attribute__((ext_vector_type(4)));
typedef float f32x4 __attribute__((ext_vector_type(4)));
typedef short bf16x8 __attribute__((ext_vector_type(8)));
typedef GAS unsigned gu32;
typedef GAS unsigned long long gu64;
#define RLX_AGENT __ATOMIC_RELAXED, __HIP_MEMORY_SCOPE_AGENT
#define LDS_WAIT() asm volatile("s_waitcnt lgkmcnt(0)" ::: "memory")
#define VM_WAIT() asm volatile("s_waitcnt vmcnt(0)" ::: "memory")
__device__ __forceinline__ unsigned long long rt() { return __builtin_amdgcn_s_memrealtime(); }
__device__ __forceinline__ unsigned f2bf(float f) { unsigned u = __builtin_bit_cast(unsigned, f); return (u + 0x7fffu + ((u >> 16) & 1u)) >> 16; }
__device__ __forceinline__ unsigned pk2(float lo, float hi) { return f2bf(lo) | (f2bf(hi) << 16); }
#define XB_TMO      128
#define XB_XCNT(j)  (256  + 64 * (j))
#define XB_XSUB(j)  (1280 + 64 * (j))
#define XB_XGEN(j)  (2304 + 64 * (j))
#define XB_TOP      3328
#define XB_TOPGEN   3392
#define XCD_BAR_WORDS 3456
#define XB_SPIN_CAP (1u << 18)

__device__ __forceinline__ unsigned xb_ld(unsigned* p)              { return __hip_atomic_load(p, __ATOMIC_RELAXED, __HIP_MEMORY_SCOPE_AGENT); }
__device__ __forceinline__ unsigned xb_add(unsigned* p, unsigned v) { return __hip_atomic_fetch_add(p, v, __ATOMIC_RELAXED, __HIP_MEMORY_SCOPE_AGENT); }
__device__ __forceinline__ unsigned xb_xcc_id() { return (unsigned)__builtin_amdgcn_s_getreg((3 << 11) | 20) & 0xFu; }
#define XB_SPIN(cond, bar) do { unsigned _sp = 0; while (cond) { __builtin_amdgcn_s_sleep(1); \
    if ((++_sp & 255u) == 0u) { if (xb_ld(&(bar)[XB_TMO])) break; if (_sp > XB_SPIN_CAP) { atomicAdd(&(bar)[XB_TMO], 1u); break; } } } } while (0)

struct XcdBarrier {
    unsigned* bar; unsigned x;
    volatile LAS unsigned* st;
};

__device__ __forceinline__ XcdBarrier xcd_barrier_post(unsigned* bar, volatile LAS unsigned* st) {
    XcdBarrier b; b.bar = bar; b.x = xb_xcc_id(); b.st = st;
    if (threadIdx.x == 0) (void)xb_add(&bar[XB_XCNT(b.x)], 1u);
    return b;
}
__device__ __forceinline__ void xcd_barrier_complete(unsigned* bar, unsigned x, unsigned& nloc, unsigned& nx) {
    const unsigned G = gridDim.x * gridDim.y * gridDim.z;
    unsigned sum, cnt, mine, sp = 0u;
    for (;;) {
        sum = 0u; cnt = 0u; mine = 0u;
#pragma unroll
        for (unsigned j = 0; j < 16; ++j) { const unsigned c = xb_ld(&bar[XB_XCNT(j)]); sum += c; cnt += (c > 0u) ? 1u : 0u; mine = (j == x) ? c : mine; }
        if (sum == G) break;
        __builtin_amdgcn_s_sleep(1);
        if ((++sp & 255u) == 0u) { if (xb_ld(&bar[XB_TMO])) break; if (sp > XB_SPIN_CAP) { atomicAdd(&bar[XB_TMO], 1u); break; } }
    }
    nloc = mine > 0u ? mine : 1u; nx = cnt > 0u ? cnt : 1u;
}

__device__ __forceinline__ void xcd_barrier(const XcdBarrier& b) {
    asm volatile("s_waitcnt vmcnt(0)" ::: "memory");
    __syncthreads();
    if (threadIdx.x == 0) {
        unsigned* bar = b.bar;
        __builtin_amdgcn_s_waitcnt(0);
        unsigned nloc = b.st[0], nx = b.st[1];
        if (nloc == 0u) { xcd_barrier_complete(bar, b.x, nloc, nx); b.st[0] = nloc; b.st[1] = nx; }
        const unsigned old = xb_add(&bar[XB_XSUB(b.x)], 1u);
        const unsigned gen = old / nloc;
        if (old + 1u == (gen + 1u) * nloc) {
            __builtin_amdgcn_fence(__ATOMIC_RELEASE, "agent");
            asm volatile("s_waitcnt vmcnt(0)" ::: "memory");
            const unsigned og = xb_add(&bar[XB_TOP], 1u);
            const unsigned tg = og / nx;
            if (og + 1u == (tg + 1u) * nx) xb_add(&bar[XB_TOPGEN], 1u);
            else XB_SPIN(xb_ld(&bar[XB_TOPGEN]) == tg, bar);
            __builtin_amdgcn_fence(__ATOMIC_ACQUIRE, "agent");
            xb_add(&bar[XB_XGEN(b.x)], 1u);
            asm volatile("s_waitcnt vmcnt(0)" ::: "memory");
        } else {
            XB_SPIN(xb_ld(&bar[XB_XGEN(b.x)]) == gen, bar);
            __builtin_amdgcn_fence(__ATOMIC_ACQUIRE, "agent");
            asm volatile("s_waitcnt vmcnt(0)" ::: "memory");
        }
    }
    __syncthreads();
}
namespace att {
typedef unsigned short bf16_t;
typedef short bf16x8 __attribute__((ext_vector_type(8)));
typedef short s16x4 __attribute__((ext_vector_type(4)));
typedef float f32x16 __attribute__((ext_vector_type(16)));
typedef float f32x4 __attribute__((ext_vector_type(4)));
typedef unsigned u32x4 __attribute__((ext_vector_type(4)));
constexpr int D = 128, NW = 8, QBLK = 32, KVBLK = 64, QB = NW * QBLK;
constexpr int SHM_V = KVBLK * D * 2, SHM_K = KVBLK * D * 2;
constexpr int OFF_WS = 2 * SHM_V + 2 * SHM_K, OFF_BIAS = OFF_WS + NW * 64 * 4, OFF_Q = OFF_BIAS + 2 * 64 * 4, ATT_LDS_BYTES = OFF_Q + NW * 8192;
#ifndef NQREG
#define NQREG 2
#endif
constexpr float SCALE = 0.08838834764831845f, INV_SCALE = 11.313708498984761f, THR = 8.f;
constexpr int WIN = 1 << 30;

#define KSWZ(row, colB) ((row) * 256 + ((colB) ^ (((row) & 7) << 4)))
#define SBAR() __builtin_amdgcn_sched_barrier(0)
__device__ __forceinline__ int v_st(int k, int c) { const int kk = (k & ~0xC) | ((k & 4) << 1) | ((k & 8) >> 1); return ((kk >> 3) * 4 + (c >> 5)) * 512 + ((kk & 7) * 32 + (c & 31)) * 2; }
__device__ __forceinline__ int v_rd_base(int lane) { return ((lane & 3) << 3) | (((lane >> 2) & 3) << 6) | (((lane >> 4) & 1) << 5) | (((lane >> 5) & 1) << 8); }
constexpr int v_rd_off(int d0, int ks, int half) { return d0 * 512 + ks * 4096 + half * 2048; }
__device__ __forceinline__ int crow(int r, int hi) { return (r & 3) + 8 * (r >> 2) + 4 * hi; }
__device__ __forceinline__ unsigned cvtpk(float lo, float hi) { unsigned r; asm volatile("v_cvt_pk_bf16_f32 %0, %1, %2" : "=v"(r) : "v"(lo), "v"(hi)); return r; }
__device__ __forceinline__ bf16x8 load8(const bf16_t* p) { return *reinterpret_cast<const bf16x8*>(p); }
__device__ __forceinline__ void mask_tile(f32x16& p0, f32x16& p1, int dq) {
    const float NEG = -__builtin_inff();
#pragma unroll
    for (int r = 0; r < 16; ++r) {
        const int c = (r & 3) + 8 * (r >> 2);
        if ((unsigned)(dq - c) >= (unsigned)WIN) p0[r] = NEG;
        if ((unsigned)(dq - c - 32) >= (unsigned)WIN) p1[r] = NEG;
    }
}
__device__ __forceinline__ void add_bias(f32x16& p0, f32x16& p1, const float* bl, int hi) {
#pragma unroll
    for (int g = 0; g < 4; ++g) { const f32x4 a = *(const f32x4*)(bl + 8 * g + 4 * hi), b = *(const f32x4*)(bl + 32 + 8 * g + 4 * hi);
#pragma unroll
        for (int i = 0; i < 4; ++i) { p0[4 * g + i] += a[i]; p1[4 * g + i] += b[i]; }
        asm volatile("" ::: "memory"); }
}
__device__ __forceinline__ void partialSM(f32x16& p0, f32x16& p1, float& m_reg, float& mn, float& alpha) {
    float pmax = p0[0]; for (int r = 1; r < 16; ++r) pmax = fmaxf(pmax, p0[r]); for (int r = 0; r < 16; ++r) pmax = fmaxf(pmax, p1[r]);
    { auto rr = __builtin_amdgcn_permlane32_swap(__float_as_uint(pmax), __float_as_uint(pmax), false, false);
      pmax = fmaxf(__uint_as_float(rr[0]), __uint_as_float(rr[1])); }
    constexpr float C2 = 1.4426950408889634f * SCALE;
    if (__builtin_expect(__all((pmax - m_reg) * SCALE <= THR), 1)) { mn = m_reg; alpha = 1.f; }
    else { mn = fmaxf(m_reg, pmax); alpha = __builtin_amdgcn_exp2f((m_reg - mn) * C2); m_reg = mn; }
    const float mnL = -mn * C2;
    for (int r = 0; r < 16; ++r) p0[r] = fmaf(p0[r], C2, mnL); for (int r = 0; r < 16; ++r) p1[r] = fmaf(p1[r], C2, mnL);
    for (int r = 0; r < 16; ++r) p0[r] = __builtin_amdgcn_exp2f(p0[r]);
}
__device__ __forceinline__ void finishSM(f32x16& p0, f32x16& p1, float alpha, float& l_reg, bf16x8& pa0, bf16x8& pa1, bf16x8& pa2, bf16x8& pa3) {
    for (int r = 0; r < 16; ++r) p1[r] = __builtin_amdgcn_exp2f(p1[r]);
    float ps = 0; for (int r = 0; r < 16; ++r) ps += p0[r]; for (int r = 0; r < 16; ++r) ps += p1[r];
    { auto rr = __builtin_amdgcn_permlane32_swap(__float_as_uint(ps), __float_as_uint(ps), false, false);
      ps = __uint_as_float(rr[0]) + __uint_as_float(rr[1]); }
    l_reg = l_reg * alpha + ps;
#define PK4(P, B_, OUT) do { unsigned a0 = cvtpk(P[B_+0], P[B_+1]), a1 = cvtpk(P[B_+2], P[B_+3]);                          \
        unsigned b0 = cvtpk(P[B_+4], P[B_+5]), b1 = cvtpk(P[B_+6], P[B_+7]);                                             \
        auto r0 = __builtin_amdgcn_permlane32_swap(a0, b0, false, false); auto r1 = __builtin_amdgcn_permlane32_swap(a1, b1, false, false); \
        u32x4 w = {r0[0], r1[0], r0[1], r1[1]}; OUT = *reinterpret_cast<bf16x8*>(&w); } while (0)
    PK4(p0, 0, pa0); PK4(p0, 8, pa1); PK4(p1, 0, pa2); PK4(p1, 8, pa3);
#undef PK4
}
template <int KB>
__device__ __forceinline__ void qkt(f32x16& p0, f32x16& p1, const char* K_lds, int r32, int hi, const bf16x8* qr, const char* qw) {
    p0 = f32x16{}; p1 = f32x16{};
    const char* kb[4];
#pragma unroll
    for (int dd = 0; dd < 4; ++dd) kb[dd] = K_lds + KB * SHM_K + KSWZ(r32, (dd * 16 + hi * 8) * 2);
#pragma unroll
    for (int d0 = 0; d0 < 8; ++d0) { const char* a = kb[d0 & 3] + (d0 >> 2) * 128;
        bf16x8 b0 = *reinterpret_cast<const bf16x8*>(a);
        bf16x8 b1 = *reinterpret_cast<const bf16x8*>(a + 32 * 256);
        bf16x8 qf; if (d0 < NQREG) qf = qr[d0]; else qf = *reinterpret_cast<const bf16x8*>(qw + d0 * 1024);
        p0 = __builtin_amdgcn_mfma_f32_32x32x16_bf16(b0, qf, p0, 0, 0, 0);
        p1 = __builtin_amdgcn_mfma_f32_32x32x16_bf16(b1, qf, p1, 0, 0, 0); }
}
template <int VB>
__device__ __forceinline__ void pv_tile(f32x16* o, int vb0, bf16x8 pa0, bf16x8 pa1, bf16x8 pa2, bf16x8 pa3) {
#define TRRD(dst, off) asm volatile("ds_read_b64_tr_b16 %0, %1 offset:%2" : "=&v"(dst) : "v"(vb0), "i"(off) : "memory")
#define PV_D0(d0) do { s16x4 l0, l1, l2, l3, h0, h1, h2, h3; constexpr int b_ = VB * SHM_V + v_rd_off(d0, 0, 0); \
        TRRD(l0, b_); TRRD(h0, b_ + 2048); TRRD(l1, b_ + 4096); TRRD(h1, b_ + 6144); TRRD(l2, b_ + 8192); TRRD(h2, b_ + 10240); TRRD(l3, b_ + 12288); TRRD(h3, b_ + 14336); \
        asm volatile("s_waitcnt lgkmcnt(0)" ::: "memory"); SBAR();   \
        o[d0] = __builtin_amdgcn_mfma_f32_32x32x16_bf16(pa0, (bf16x8){l0[0], l0[1], l0[2], l0[3], h0[0], h0[1], h0[2], h0[3]}, o[d0], 0, 0, 0);   \
        o[d0] = __builtin_amdgcn_mfma_f32_32x32x16_bf16(pa1, (bf16x8){l1[0], l1[1], l1[2], l1[3], h1[0], h1[1], h1[2], h1[3]}, o[d0], 0, 0, 0);   \
        o[d0] = __builtin_amdgcn_mfma_f32_32x32x16_bf16(pa2, (bf16x8){l2[0], l2[1], l2[2], l2[3], h2[0], h2[1], h2[2], h2[3]}, o[d0], 0, 0, 0);   \
        o[d0] = __builtin_amdgcn_mfma_f32_32x32x16_bf16(pa3, (bf16x8){l3[0], l3[1], l3[2], l3[3], h3[0], h3[1], h3[2], h3[3]}, o[d0], 0, 0, 0); } while (0)
    PV_D0(0); PV_D0(1); PV_D0(2); PV_D0(3);
#undef PV_D0
#undef TRRD
}
struct BlockRef { const bf16_t* Q; const bf16_t* K; const bf16_t* V; float* O; const float* cum; int P0, jlo; };
struct Seam { bf16x8 qr[8]; bf16x8 st_v0, st_v1, st_k0, st_k1; float st_b; };
#define ROW(p, k0, rr) ((p) + (size_t)((k0) + (rr)) * D + sc)
#define VMW() asm volatile("s_waitcnt vmcnt(0)" ::: "memory")
#define VMWN(n) asm volatile("s_waitcnt vmcnt(%0)" :: "i"(n) : "memory")
#define SLOAD_H(Kp, Vp, Cp, k0) do { S.st_v0 = load8(ROW(Vp, k0, sr)); S.st_v1 = load8(ROW(Vp, k0, 32 + sr));              \
                         S.st_k0 = load8(ROW(Kp, k0, sr)); S.st_k1 = load8(ROW(Kp, k0, 32 + sr)); if ((Cp) != nullptr && tid < 64) S.st_b = (Cp)[(k0) + tid]; } while (0)
#define SWRITE_HK(bf, Cp) do { *(bf16x8*)(K_lds + (bf) * SHM_K + kws) = S.st_k0; *(bf16x8*)(K_lds + (bf) * SHM_K + kws + 32 * 256) = S.st_k1; \
                         if ((Cp) != nullptr && tid < 64) bias_l[(bf) * 64 + tid] = -S.st_b * INV_SCALE; } while (0)
#define SWRITE_HV(bf) do { *(bf16x8*)(V_lds + (bf) * SHM_V + vst0) = S.st_v0; *(bf16x8*)(V_lds + (bf) * SHM_V + vst1) = S.st_v1; } while (0)
#define SWRITE_H(bf, Cp) do { SWRITE_HV(bf); SWRITE_HK(bf, Cp); } while (0)
__device__ __forceinline__ void attn_prime(const BlockRef& cur, char* lds, Seam& S, const int tid) {
    const int wid = __builtin_amdgcn_readfirstlane(tid >> 6), lane = tid & 63, r32 = lane & 31, hi = lane >> 5;
    const int sr = tid >> 4, sc = (tid & 15) * 8, kws = KSWZ(sr, sc * 2); char* K_lds = lds + 2 * SHM_V; float* bias_l = (float*)(lds + OFF_BIAS);
    for (int d0 = 0; d0 < 8; ++d0) S.qr[d0] = load8(cur.Q + (size_t)(wid * QBLK + r32) * D + d0 * 16 + hi * 8);
    SLOAD_H(cur.K, cur.V, cur.cum, cur.jlo * KVBLK); VMW(); SWRITE_HK(0, cur.cum);
    __syncthreads();
}
__device__ __forceinline__ void attn_block(const BlockRef& cur, const BlockRef& nxt, char* lds, Seam& S, const int tid) {
    const int wid = __builtin_amdgcn_readfirstlane(tid >> 6), lane = tid & 63, r32 = lane & 31, hi = lane >> 5;
    const int NT = (cur.P0 + QB) / KVBLK - cur.jlo;
    const int qlo = cur.P0 + wid * QBLK, qm = qlo + r32 - 4 * hi;
    char* V_lds = lds; char* K_lds = lds + 2 * SHM_V; float* bias_l = (float*)(lds + OFF_BIAS);
    float* ws = (float*)(lds + OFF_WS) + wid * 64; float* li_l = ws, * al_l = ws + 32;
    float m_reg = -1e30f, l_reg = 0; f32x16 o[4] = {};
    const int sr = tid >> 4, sc = (tid & 15) * 8, vst0 = v_st(sr, sc), vst1 = v_st(32 + sr, sc), kws = KSWZ(sr, sc * 2);
    const int vb0 = (int)(uintptr_t)V_lds + v_rd_base(lane);
    const bf16_t* Kh = cur.K; const bf16_t* Vh = cur.V; const float* Ch = cur.cum;
#define RESC(a) do { if (__any((a) < 1.f)) { if (hi == 0) al_l[r32] = (a); asm volatile("s_waitcnt lgkmcnt(0)" ::: "memory");              \
                     for (int d_ = 0; d_ < 4; ++d_) for (int r = 0; r < 16; ++r) o[d_][r] *= al_l[crow(r, hi)]; } } while (0)
#define KBASE(t) ((cur.jlo + (t)) * KVBLK)
#define MASKT(P0_, P1_, t) do { const int kb_ = KBASE(t); if (kb_ + KVBLK - 1 > qlo) mask_tile(P0_, P1_, qm - kb_); } while (0)
#define BIAST(P0_, P1_, bf) do { if (Ch != nullptr) add_bias(P0_, P1_, bias_l + (bf) * 64, hi); } while (0)
    constexpr int NQL = 8;
#define SEAM_K0() do { VMWN(NQL); SWRITE_HK(0, nxt.cum); SBAR(); } while (0)
    f32x16 pA0, pA1, pB0, pB1; float mnA, mnB, alA, alB; bf16x8 pa0, pa1, pa2, pa3;
    char* qw = lds + OFF_Q + wid * 8192 + lane * 16;
#pragma unroll
    for (int d0 = NQREG; d0 < 8; ++d0) *reinterpret_cast<bf16x8*>(qw + d0 * 1024) = S.qr[d0];
    SWRITE_HV(0); SBAR();
    if (NT > 1) SLOAD_H(Kh, Vh, Ch, KBASE(1));
    SBAR(); qkt<0>(pA0, pA1, K_lds, r32, hi, S.qr, qw);
    BIAST(pA0, pA1, 0); MASKT(pA0, pA1, 0); partialSM(pA0, pA1, m_reg, mnA, alA);
    if (NT > 1) { VMW(); SWRITE_H(1, Ch); }
    __syncthreads();
#define HALF_STEP(PX0, PX1, mnX, alX, PY0, PY1, alY, t, KB, VB, SB) do {                                                      \
        SBAR(); qkt<KB>(PX0, PX1, K_lds, r32, hi, S.qr, qw);                                                         \
        finishSM(PY0, PY1, alY, l_reg, pa0, pa1, pa2, pa3); SBAR();                                                           \
        if ((t) + 1 < NT) { SLOAD_H(Kh, Vh, Ch, KBASE((t) + 1)); SBAR(); }                                                    \
        pv_tile<VB>(o, vb0, pa0, pa1, pa2, pa3); BIAST(PX0, PX1, KB); MASKT(PX0, PX1, (t)); partialSM(PX0, PX1, m_reg, mnX, alX); \
        __syncthreads();                                                                                                      \
        if ((t) + 1 < NT) { VMW(); SWRITE_H(SB, Ch); }                                                                        \
        RESC(alX); __syncthreads(); } while (0)
    for (int t = 1; t + 1 < NT; t += 2) {
        HALF_STEP(pB0, pB1, mnB, alB, pA0, pA1, alA, t, 1, 0, 0);
        HALF_STEP(pA0, pA1, mnA, alA, pB0, pB1, alB, t + 1, 0, 1, 1);
    }
    const bool even = (NT & 1) == 0;
    if (even) { SBAR(); qkt<1>(pB0, pB1, K_lds, r32, hi, S.qr, qw); SBAR(); }
    SLOAD_H(nxt.K, nxt.V, nxt.cum, nxt.jlo * KVBLK); SBAR();
#pragma unroll
    for (int d0 = 0; d0 < 8; ++d0) S.qr[d0] = load8(nxt.Q + (size_t)(wid * QBLK + r32) * D + d0 * 16 + hi * 8);
    SBAR();
    finishSM(pA0, pA1, alA, l_reg, pa0, pa1, pa2, pa3); SBAR();
    pv_tile<0>(o, vb0, pa0, pa1, pa2, pa3);
    if (even) { BIAST(pB0, pB1, 1); MASKT(pB0, pB1, NT - 1); partialSM(pB0, pB1, m_reg, mnB, alB); __syncthreads(); RESC(alB);
        finishSM(pB0, pB1, alB, l_reg, pa0, pa1, pa2, pa3); SBAR(); pv_tile<1>(o, vb0, pa0, pa1, pa2, pa3); }
    SBAR(); SEAM_K0();
    if (hi == 0) li_l[r32] = l_reg; asm volatile("s_waitcnt lgkmcnt(0)" ::: "memory");
    float rli[16];
#pragma unroll
    for (int r = 0; r < 16; ++r) rli[r] = __builtin_amdgcn_rcpf(li_l[crow(r, hi)]);
    float* Ow = cur.O + (size_t)(wid * QBLK) * D;
#pragma unroll
    for (int r = 0; r < 16; ++r) { const int orow = crow(r, hi);
#pragma unroll
        for (int d0 = 0; d0 < 4; ++d0) Ow[(size_t)orow * D + d0 * 32 + r32] = o[d0][r] * rli[r]; }
    __syncthreads();
#undef RESC
#undef KBASE
#undef MASKT
#undef BIAST
#undef SEAM_K0
#undef HALF_STEP
}
#undef ROW
#undef VMW
#undef VMWN
#undef SLOAD_H
#undef SWRITE_HK
#undef SWRITE_HV
#undef SWRITE_H
struct Ref2 { const bf16_t* Q; const bf16_t* K; const bf16_t* V0; const bf16_t* V1; float* O0; float* O1; int P0; };
constexpr int A2_V = 0, A2_K = 65536, A2_WS = 98304, A2_Q = 100352, A2_NQ = 8, A2_LDS_BYTES = A2_Q + NW * (8 - A2_NQ) * 1024;
template <int KB>
__device__ __forceinline__ void qkt2(f32x16& p0, f32x16& p1, const char* K_lds, int r32, int hi, const bf16x8* qr, const char* qw) {
    p0 = f32x16{}; p1 = f32x16{};
    const char* kb[4];
#pragma unroll
    for (int dd = 0; dd < 4; ++dd) kb[dd] = K_lds + KB * SHM_K + KSWZ(r32, (dd * 16 + hi * 8) * 2);
#pragma unroll
    for (int d0 = 0; d0 < 8; ++d0) { const char* a = kb[d0 & 3] + (d0 >> 2) * 128;
        bf16x8 b0 = *reinterpret_cast<const bf16x8*>(a);
        bf16x8 b1 = *reinterpret_cast<const bf16x8*>(a + 32 * 256);
        bf16x8 qf; if (d0 < A2_NQ) qf = qr[d0]; else qf = *reinterpret_cast<const bf16x8*>(qw + (d0 - A2_NQ) * 1024);
        p0 = __builtin_amdgcn_mfma_f32_32x32x16_bf16(b0, qf, p0, 0, 0, 0);
        p1 = __builtin_amdgcn_mfma_f32_32x32x16_bf16(b1, qf, p1, 0, 0, 0); }
}
template <int VB, int E>
__device__ __forceinline__ void pv2(f32x16* o, int vb0, bf16x8 pa0, bf16x8 pa1, bf16x8 pa2, bf16x8 pa3) {
#define TRRD(dst, off) asm volatile("ds_read_b64_tr_b16 %0, %1 offset:%2" : "=&v"(dst) : "v"(vb0), "i"(off) : "memory")
#define PV_D0(d0) do { s16x4 l0, l1, l2, l3, h0, h1, h2, h3; constexpr int b_ = VB * 32768 + E * 16384 + v_rd_off(d0, 0, 0); \
        TRRD(l0, b_); TRRD(h0, b_ + 2048); TRRD(l1, b_ + 4096); TRRD(h1, b_ + 6144); TRRD(l2, b_ + 8192); TRRD(h2, b_ + 10240); TRRD(l3, b_ + 12288); TRRD(h3, b_ + 14336); \
        asm volatile("s_waitcnt lgkmcnt(0)" ::: "memory"); SBAR();   \
        o[d0] = __builtin_amdgcn_mfma_f32_32x32x16_bf16(pa0, (bf16x8){l0[0], l0[1], l0[2], l0[3], h0[0], h0[1], h0[2], h0[3]}, o[d0], 0, 0, 0);   \
        o[d0] = __builtin_amdgcn_mfma_f32_32x32x16_bf16(pa1, (bf16x8){l1[0], l1[1], l1[2], l1[3], h1[0], h1[1], h1[2], h1[3]}, o[d0], 0, 0, 0);   \
        o[d0] = __builtin_amdgcn_mfma_f32_32x32x16_bf16(pa2, (bf16x8){l2[0], l2[1], l2[2], l2[3], h2[0], h2[1], h2[2], h2[3]}, o[d0], 0, 0, 0);   \
        o[d0] = __builtin_amdgcn_mfma_f32_32x32x16_bf16(pa3, (bf16x8){l3[0], l3[1], l3[2], l3[3], h3[0], h3[1], h3[2], h3[3]}, o[d0], 0, 0, 0); } while (0)
    PV_D0(0); PV_D0(1); PV_D0(2); PV_D0(3);
#undef PV_D0
#undef TRRD
}
__device__ __forceinline__ void attn2_item(const Ref2& R, char* lds, const int tid_in) {
    int tid = tid_in; asm volatile("" : "+v"(tid));
    const int wid = __builtin_amdgcn_readfirstlane(tid >> 6), lane = tid & 63, r32 = lane & 31, hi = lane >> 5;
    const int NT = (R.P0 + QB) / KVBLK;
    const int qlo = R.P0 + wid * QBLK, qm = qlo + r32 - 4 * hi;
    char* V_lds = lds + A2_V; char* K_lds = lds + A2_K;
    float* ws = (float*)(lds + A2_WS) + wid * 64; float* li_l = ws, * al_l = ws + 32;
    char* qw = lds + A2_Q + wid * ((8 - A2_NQ) * 1024) + lane * 16;
    const int vb0 = (int)(uintptr_t)V_lds + v_rd_base(lane);
    unsigned koff[2], voff[2];
#pragma unroll
    for (int i = 0; i < 2; ++i) {
        { const int row = 8 * wid + 4 * i + (lane >> 4), c = (lane & 15) ^ (row & 7); koff[i] = (unsigned)(row * 256 + c * 16); }
        { const int p = 2 * wid + i, st = 2 * p + (lane >> 5), ch = lane & 31, kk = (st >> 2) * 8 + (ch >> 2), c8 = (st & 3) * 4 + (ch & 3);
          const int k = (kk & ~0xC) | ((kk & 4) << 1) | ((kk & 8) >> 1); voff[i] = (unsigned)(k * 256 + c8 * 16); } }
#define DMA2(gbase, k0, ldsbase, off) do { _Pragma("unroll") for (int i_ = 0; i_ < 2; ++i_) \
        __builtin_amdgcn_global_load_lds((const unsigned*)((const char*)(gbase) + (size_t)(k0) * 256 + (off)[i_]), (__attribute__((address_space(3))) unsigned*)((ldsbase) + (2 * wid + i_) * 1024), 16, 0, 0); } while (0)
#define STAGE2(k0, B) do { DMA2(R.K, k0, K_lds + (B) * SHM_K, koff); DMA2(R.V0, k0, V_lds + (B) * 32768, voff); DMA2(R.V1, k0, V_lds + (B) * 32768 + 16384, voff); } while (0)
    bf16x8 qr[A2_NQ];
    STAGE2(0, 0);
#pragma unroll
    for (int d0 = 0; d0 < 8; ++d0) { const bf16x8 qf = load8(R.Q + (size_t)(wid * QBLK + r32) * D + d0 * 16 + hi * 8);
        if (d0 < A2_NQ) qr[d0] = qf; else *reinterpret_cast<bf16x8*>(qw + (d0 - A2_NQ) * 1024) = qf; }
    asm volatile("s_waitcnt vmcnt(0)" ::: "memory");
    __syncthreads();
    float m_reg = -1e30f, l_reg = 0; f32x16 o[8] = {};
#define RESC2(a) do { if (__any((a) < 1.f)) { if (hi == 0) al_l[r32] = (a); asm volatile("s_waitcnt lgkmcnt(0)" ::: "memory");              \
                     for (int d_ = 0; d_ < 8; ++d_) for (int r = 0; r < 16; ++r) o[d_][r] *= al_l[crow(r, hi)]; } } while (0)
#define STEP2(t, B) do { if ((t) + 1 < NT) STAGE2(((t) + 1) * KVBLK, 1 - B);               \
        SBAR(); f32x16 p0, p1; qkt2<B>(p0, p1, K_lds, r32, hi, qr, qw);                                                                \
        { const int kb_ = (t) * KVBLK; if (kb_ + KVBLK - 1 > qlo) mask_tile(p0, p1, qm - kb_); }                                         \
        float mn_, al_; bf16x8 pa0, pa1, pa2, pa3;                                                                                     \
        partialSM(p0, p1, m_reg, mn_, al_); finishSM(p0, p1, al_, l_reg, pa0, pa1, pa2, pa3); RESC2(al_); SBAR();                      \
        pv2<B, 0>(o, vb0, pa0, pa1, pa2, pa3); pv2<B, 1>(o + 4, vb0, pa0, pa1, pa2, pa3);                                                \
        asm volatile("s_waitcnt vmcnt(0)" ::: "memory"); __syncthreads(); } while (0)
    for (int t = 0; t < NT; t += 2) { STEP2(t, 0); STEP2(t + 1, 1); }
    if (hi == 0) li_l[r32] = l_reg; asm volatile("s_waitcnt lgkmcnt(0)" ::: "memory");
    float rli[16];
#pragma unroll
    for (int r = 0; r < 16; ++r) rli[r] = __builtin_amdgcn_rcpf(li_l[crow(r, hi)]);
    float* Ow0 = R.O0 + (size_t)(wid * QBLK) * D; float* Ow1 = R.O1 + (size_t)(wid * QBLK) * D;
#pragma unroll
    for (int r = 0; r < 16; ++r) { const int orow = crow(r, hi);
#pragma unroll
        for (int d0 = 0; d0 < 4; ++d0) { Ow0[(size_t)orow * D + d0 * 32 + r32] = o[d0][r] * rli[r]; Ow1[(size_t)orow * D + d0 * 32 + r32] = o[4 + d0][r] * rli[r]; } }
    asm volatile("s_waitcnt vmcnt(0)" ::: "memory");
    __syncthreads();
#undef STEP2
#undef RESC2
#undef STAGE2
#undef DMA2
}
}

constexpr size_t MiB = 1u << 20;
constexpr size_t WS_CTL = 0, CTL_ZERO_BYTES = 1 * MiB;
constexpr size_t SZ_WIN = (size_t)DIN_PAD * DM * 2, SZ_WOUT = (size_t)DM * DM * 2, SZ_WFF = (size_t)DFF * DM * 2;
constexpr size_t WS_WIN = 1 * MiB, WS_WOUT = WS_WIN + SZ_WIN, WS_WG = WS_WOUT + SZ_WOUT, WS_WU = WS_WG + SZ_WFF, WS_WD = WS_WU + SZ_WFF;
constexpr size_t WS_H = WS_WD + SZ_WFF;
constexpr size_t WS_P = WS_H + (size_t)M * DM * 2;
constexpr size_t SZ_P = (size_t)NSLAB * M * 128 * 2;
constexpr size_t WS_PS = WS_P + SZ_P;
constexpr size_t WS_Y = WS_PS + (size_t)M * 32 * 4;
constexpr size_t WS_X = WS_Y + (size_t)M * DM * 2;
constexpr size_t WS_OB = WS_X;
constexpr int REC_W = 0, REC_QG = 16384, REC_AQK = 32768, REC_KD = 40960, REC_DMA = 57344, REC_U = 57344, REC_BYTES = 90112;
constexpr size_t WS_DREC = WS_OB + (size_t)24 * M * 128 * 4;
constexpr size_t WS_DL = WS_DREC + (size_t)2048 * REC_BYTES;
constexpr size_t WS_DO = WS_DL + (size_t)2048 * 4;
constexpr size_t WS_CUM = WS_DO + (size_t)M * 8 * 128 * 4;
constexpr size_t WS_XEND = WS_CUM + (size_t)16 * T * 4;
constexpr size_t WS_XB = (WS_XEND + 255) / 256 * 256;
constexpr size_t WS_END = WS_XB + (size_t)M * DM * 2;
static_assert(SZ_P >= (size_t)M * DFF * 2, "gate overlays P");
static_assert(WS_XEND - WS_X >= (size_t)M * DFF * 2, "act overlays region X");
static_assert(WS_WIN % 256 == 0 && WS_H % 256 == 0 && WS_P % 256 == 0 && WS_Y % 256 == 0 && WS_X % 256 == 0, "alignment");
constexpr int CW_BAR = 4096, CW_Q = 8192, CW_NRM = 32768, CW_CV = 16384;
constexpr int LDS_BYTES = 163840, MISC_OFF = LDS_BYTES - 512;
static_assert(att::A2_LDS_BYTES <= MISC_OFF - 2048 && att::ATT_LDS_BYTES <= MISC_OFF - 2048, "attention LDS maps");
constexpr int NWAVES = 8;
typedef unsigned short bf16_t;
typedef unsigned u32x4 __attribute__((ext_vector_type(4)));
typedef unsigned u32x2 __attribute__((ext_vector_type(2)));
typedef float f32x2 __attribute__((ext_vector_type(2)));

struct Args { const float* in[21]; float* out; unsigned char* ws; int ph_lo, ph_hi; };
#define CAS __attribute__((address_space(4)))
typedef const CAS Args* ArgP;
enum { I_X = 0, I_ATTN_NORM, I_W_IN, I_SC_CONV, I_LQ1, I_LK1, I_LQ2, I_LK2, I_DIFF_NORM, I_DN_CONV, I_DN_ALOG, I_DN_DTB, I_DN_NORM, I_FOX_BIAS, I_W_OUT, I_FFN_NORM, I_W_GATE, I_W_UP, I_FFN_CONV, I_W_DOWN, I_FINAL_NORM };

__device__ __forceinline__ float shx(float v, int o, int lane) { return __int_as_float(__builtin_amdgcn_ds_bpermute((lane ^ o) << 2, __float_as_int(v))); }
__device__ __forceinline__ float shup(float v, int o, int lane) { return __int_as_float(__builtin_amdgcn_ds_bpermute(((lane - o) & 63) << 2, __float_as_int(v))); }
__device__ __forceinline__ float shlane(float v, int src) { return __int_as_float(__builtin_amdgcn_ds_bpermute(src << 2, __float_as_int(v))); }
__device__ __forceinline__ float wave_sum(float v, int lane) {
#pragma unroll
    for (int o = 1; o < 64; o <<= 1) v += shx(v, o, lane);
    return v;
}
__device__ __forceinline__ float silu_f(float x) { return x / (1.0f + __expf(-x)); }
__device__ __forceinline__ unsigned pkbf(float lo, float hi) { return pg8::cvt_pk_bf16(lo, hi); }

__host__ __device__ __forceinline__ int win_src(int n) {
    if (n < 10240) return n;
    if (n < 13312) return n + 16;
    const int j = n - 13312;
    if (j < 16) return 10240 + j;
    if (j < 24) return 13328 + (j - 16);
    return -1;
}
constexpr int NI_IN = (DM / 64) * (DIN_PAD / 64), NI_OUT = (DM / 64) * (DM / 64), NI_FF = (DM / 64) * (DFF / 64);
constexpr int CV_TOTAL0 = NI_IN, CV_TOTAL1 = NI_OUT + 3 * NI_FF + NI_IN, CV_TOTAL2 = NI_OUT + 3 * NI_FF;
constexpr int CV_SCR = 64 * 68 * 4;
struct CvItem { const float* W; bf16_t* WT; int Nsrc, K, k0, n0, remap; };
__device__ __forceinline__ CvItem cv_decode(ArgP A, int sel, int r) {
    unsigned char* ws = A->ws; const int l = sel == 2 ? 1 : 0; CvItem it;
    if (sel == 0) { it.W = A->in[I_W_IN]; it.WT = (bf16_t*)(ws + WS_WIN); it.Nsrc = DIN_SRC; it.K = DM; it.k0 = 64 * (r / (DIN_PAD / 64)); it.n0 = 64 * (r % (DIN_PAD / 64)); it.remap = 1; return it; }
    if (r < NI_OUT) { it.W = A->in[I_W_OUT] + (size_t)l * DM * DM; it.WT = (bf16_t*)(ws + WS_WOUT); it.Nsrc = DM; it.K = DM; it.k0 = 64 * (r / (DM / 64)); it.n0 = 64 * (r % (DM / 64)); it.remap = 0; return it; } r -= NI_OUT;
    if (r < NI_FF) { it.W = A->in[I_W_GATE] + (size_t)l * DM * DFF; it.WT = (bf16_t*)(ws + WS_WG); it.Nsrc = DFF; it.K = DM; it.k0 = 64 * (r / (DFF / 64)); it.n0 = 64 * (r % (DFF / 64)); it.remap = 0; return it; } r -= NI_FF;
    if (r < NI_FF) { it.W = A->in[I_W_UP] + (size_t)l * DM * DFF; it.WT = (bf16_t*)(ws + WS_WU); it.Nsrc = DFF; it.K = DM; it.k0 = 64 * (r / (DFF / 64)); it.n0 = 64 * (r % (DFF / 64)); it.remap = 0; return it; } r -= NI_FF;
    if (r < NI_FF) { it.W = A->in[I_W_DOWN] + (size_t)l * DFF * DM; it.WT = (bf16_t*)(ws + WS_WD); it.Nsrc = DM; it.K = DFF; it.k0 = 64 * (r / (DM / 64)); it.n0 = 64 * (r % (DM / 64)); it.remap = 0; return it; } r -= NI_FF;
    it.W = A->in[I_W_IN] + (size_t)DM * DIN_SRC; it.WT = (bf16_t*)(ws + WS_WIN); it.Nsrc = DIN_SRC; it.K = DM; it.k0 = 64 * (r / (DIN_PAD / 64)); it.n0 = 64 * (r % (DIN_PAD / 64)); it.remap = 1; return it;
}
__device__ __forceinline__ void cv_load(const CvItem& it, int lane, f32x4 (&v)[16]) {
    const int nl = 4 * (lane & 15), kr = lane >> 4;
    int sc = it.n0 + nl; if (it.remap) sc = win_src(it.n0 + nl);
#pragma unroll
    for (int i = 0; i < 16; ++i) { v[i] = (f32x4){0.f, 0.f, 0.f, 0.f}; if (sc >= 0) v[i] = *(const f32x4*)(it.W + (size_t)(it.k0 + 4 * i + kr) * it.Nsrc + sc); }
}
__device__ __forceinline__ void cv_store(const CvItem& it, LAS float* scr, int lane, const f32x4 (&v)[16]) {
    const int c4 = lane & 15, kr = lane >> 4;
#pragma unroll
    for (int i = 0; i < 16; ++i) *(LAS f32x4*)(scr + (4 * i + kr) * 68 + 4 * (c4 ^ (i >> 1))) = v[i];
    LDS_WAIT(); asm volatile("" ::: "memory");
    const int kc = lane & 7, nn = lane >> 3;
#pragma unroll
    for (int j = 0; j < 8; ++j) { const int n = nn + 8 * j; const LAS float* s = scr + (8 * kc) * 68 + 4 * ((n >> 2) ^ kc) + (n & 3);
        u32x4 o; o.x = pkbf(s[0 * 68], s[1 * 68]); o.y = pkbf(s[2 * 68], s[3 * 68]); o.z = pkbf(s[4 * 68], s[5 * 68]); o.w = pkbf(s[6 * 68], s[7 * 68]);
        *(u32x4*)(it.WT + (size_t)(it.n0 + n) * it.K + it.k0 + 8 * kc) = o; }
    LDS_WAIT(); asm volatile("" ::: "memory");
}
__device__ __forceinline__ void cv_run(ArgP A, int sel, int first, int n, int stride, LAS float* scr, int lane) {
    if (n <= 0) return;
    f32x4 va[16], vb[16];
    CvItem ia = cv_decode(A, sel, first), ib = ia;
    cv_load(ia, lane, va);
    for (int i = 0; i < n; i += 2) {
        if (i + 1 < n) { ib = cv_decode(A, sel, first + (i + 1) * stride); cv_load(ib, lane, vb); }
        cv_store(ia, scr, lane, va);
        if (i + 1 < n) {
            if (i + 2 < n) { ia = cv_decode(A, sel, first + (i + 2) * stride); cv_load(ia, lane, va); }
            cv_store(ib, scr, lane, vb); }
    }
}
__device__ __forceinline__ void phase_convert(ArgP A, LAS unsigned char* lds, int gw, int NGW, int wave, int lane) {
    LAS float* scr = (LAS float*)(lds + wave * CV_SCR);
    const int n = gw < CV_TOTAL0 ? (CV_TOTAL0 - gw + NGW - 1) / NGW : 0;
    cv_run(A, 0, gw, n, NGW, scr, lane);
}
__device__ __forceinline__ void conv_burst(ArgP A, int sel, unsigned* head, LAS unsigned char* lds, const int tid_in, int nchunks) {
    int tid = tid_in; asm volatile("" : "+v"(tid));
    const int lane = tid & 63, wave = __builtin_amdgcn_readfirstlane(tid >> 6), total = sel == 1 ? CV_TOTAL1 : CV_TOTAL2;
    LAS float* scr = (LAS float*)(lds + wave * CV_SCR);
    __syncthreads();
    for (int c = 0; c < nchunks; ++c) {
        int base = 0; if (lane == 0) base = (int)__hip_atomic_fetch_add(head, 8u, __ATOMIC_RELAXED, __HIP_MEMORY_SCOPE_AGENT);
        base = __builtin_amdgcn_readfirstlane(base);
        if (base >= total) break;
        cv_run(A, sel, base, total - base < 8 ? total - base : 8, 1, scr, lane);
    }
    asm volatile("s_waitcnt vmcnt(0)" ::: "memory");
    __syncthreads();
}
__device__ __forceinline__ void phase_norm(const float* x, const float* g, bf16_t* h, int gw, int NGW, int lane) {
    f32x4 gv[16];
#pragma unroll
    for (int j = 0; j < 16; ++j) gv[j] = *((const f32x4*)g + lane + 64 * j);
    for (int m = gw; m < M; m += NGW) {
        const f32x4* xr = (const f32x4*)(x + (size_t)m * DM) + lane;
        f32x4 v[16]; float s = 0.f;
#pragma unroll
        for (int j = 0; j < 16; ++j) { v[j] = xr[64 * j]; s += (v[j][0] * v[j][0] + v[j][1] * v[j][1]) + (v[j][2] * v[j][2] + v[j][3] * v[j][3]); }
        const float rs = rsqrtf(wave_sum(s, lane) * (1.0f / DM) + EPS);
        u32x2* o = (u32x2*)(h + (size_t)m * DM) + lane;
#pragma unroll
        for (int j = 0; j < 16; ++j) { u32x2 w; w.x = pkbf(v[j][0] * rs * gv[j][0], v[j][1] * rs * gv[j][1]); w.y = pkbf(v[j][2] * rs * gv[j][2], v[j][3] * rs * gv[j][3]); o[64 * j] = w; }
    }
}
__device__ __forceinline__ void phase_norm_b(const bf16_t* x, const float* g, bf16_t* h, int gw, int NGW, int lane) {
    for (int m = gw; m < M; m += NGW) {
        const u32x4* xr = (const u32x4*)(x + (size_t)m * DM) + lane;
        u32x4 w[8]; float s = 0.f;
#pragma unroll
        for (int j = 0; j < 8; ++j) w[j] = xr[64 * j];
#pragma unroll
        for (int j = 0; j < 8; ++j)
#pragma unroll
            for (int q = 0; q < 4; ++q) { const float a = pg8::bf_lo(w[j][q]), b = pg8::bf_hi(w[j][q]); s += a * a + b * b; }
        const float rs = rsqrtf(wave_sum(s, lane) * (1.0f / DM) + EPS);
        u32x4* o = (u32x4*)(h + (size_t)m * DM) + lane;
#pragma unroll
        for (int j = 0; j < 8; ++j) { const f32x4 g0 = *((const f32x4*)g + 2 * (lane + 64 * j)), g1 = *((const f32x4*)g + 2 * (lane + 64 * j) + 1); u32x4 r;
            r.x = pkbf(pg8::bf_lo(w[j].x) * rs * g0[0], pg8::bf_hi(w[j].x) * rs * g0[1]); r.y = pkbf(pg8::bf_lo(w[j].y) * rs * g0[2], pg8::bf_hi(w[j].y) * rs * g0[3]);
            r.z = pkbf(pg8::bf_lo(w[j].z) * rs * g1[0], pg8::bf_hi(w[j].z) * rs * g1[1]); r.w = pkbf(pg8::bf_lo(w[j].w) * rs * g1[2], pg8::bf_hi(w[j].w) * rs * g1[3]);
            o[64 * j] = r; }
    }
}
__device__ __forceinline__ void phase_final_norm_b(const bf16_t* x, float* out, const float* g, int gw, int NGW, int lane) {
    for (int m = gw; m < M; m += NGW) {
        const u32x4* xr = (const u32x4*)(x + (size_t)m * DM) + lane;
        u32x4 w[8]; float s = 0.f;
#pragma unroll
        for (int j = 0; j < 8; ++j) w[j] = xr[64 * j];
#pragma unroll
        for (int j = 0; j < 8; ++j)
#pragma unroll
            for (int q = 0; q < 4; ++q) { const float a = pg8::bf_lo(w[j][q]), b = pg8::bf_hi(w[j][q]); s += a * a + b * b; }
        const float rs = rsqrtf(wave_sum(s, lane) * (1.0f / DM) + EPS);
        f32x4* o = (f32x4*)(out + (size_t)m * DM) + 2 * lane;
#pragma unroll
        for (int j = 0; j < 8; ++j) { const f32x4 g0 = *((const f32x4*)g + 2 * (lane + 64 * j)), g1 = *((const f32x4*)g + 2 * (lane + 64 * j) + 1);
            o[128 * j] = (f32x4){pg8::bf_lo(w[j].x) * rs * g0[0], pg8::bf_hi(w[j].x) * rs * g0[1], pg8::bf_lo(w[j].y) * rs * g0[2], pg8::bf_hi(w[j].y) * rs * g0[3]};
            o[128 * j + 1] = (f32x4){pg8::bf_lo(w[j].z) * rs * g1[0], pg8::bf_hi(w[j].z) * rs * g1[1], pg8::bf_lo(w[j].w) * rs * g1[2], pg8::bf_hi(w[j].w) * rs * g1[3]}; }
    }
}
__device__ __forceinline__ void phase_final_norm(float* x, const float* g, int gw, int NGW, int lane) {
    f32x4 gv[16];
#pragma unroll
    for (int j = 0; j < 16; ++j) gv[j] = *((const f32x4*)g + lane + 64 * j);
    for (int m = gw; m < M; m += NGW) {
        f32x4* xr = (f32x4*)(x + (size_t)m * DM) + lane;
        f32x4 v[16]; float s = 0.f;
#pragma unroll
        for (int j = 0; j < 16; ++j) { v[j] = xr[64 * j]; s += (v[j][0] * v[j][0] + v[j][1] * v[j][1]) + (v[j][2] * v[j][2] + v[j][3] * v[j][3]); }
        const float rs = rsqrtf(wave_sum(s, lane) * (1.0f / DM) + EPS);
#pragma unroll
        for (int j = 0; j < 16; ++j) xr[64 * j] = v[j] * rs * gv[j];
    }
}
__device__ __forceinline__ void small_gemm(const bf16_t* H, const bf16_t* WT, float* psmall, LAS unsigned char* lds, int bid, const int tid_in) {
    for (int rb = bid; rb < M / 64; rb += (int)gridDim.x) {
    int tid = tid_in; asm volatile("" : "+v"(tid));
    const int lane = tid & 63, wave = __builtin_amdgcn_readfirstlane(tid >> 6), fr = lane & 15, fq = lane >> 4;
    const bf16_t* ap = H + (size_t)(rb * 64 + fr) * DM + wave * 512 + 8 * fq;
    const bf16_t* bp = WT + (size_t)(13312 + fr) * DM + wave * 512 + 8 * fq;
    f32x4 acc[4][2];
#pragma unroll
    for (int m = 0; m < 4; ++m) { acc[m][0] = (f32x4){0.f, 0.f, 0.f, 0.f}; acc[m][1] = (f32x4){0.f, 0.f, 0.f, 0.f}; }
#pragma unroll 1
    for (int kb = 0; kb < 512; kb += 128) {
        bf16x8 a[4][4], b[4][2];
#pragma unroll
        for (int j = 0; j < 4; ++j) {
#pragma unroll
            for (int m = 0; m < 4; ++m) a[j][m] = *(const bf16x8*)(ap + (size_t)(16 * m) * DM + kb + 32 * j);
            b[j][0] = *(const bf16x8*)(bp + kb + 32 * j); b[j][1] = *(const bf16x8*)(bp + (size_t)16 * DM + kb + 32 * j); }
#pragma unroll
        for (int j = 0; j < 4; ++j)
#pragma unroll
            for (int m = 0; m < 4; ++m) { acc[m][0] = __builtin_amdgcn_mfma_f32_16x16x32_bf16(a[j][m], b[j][0], acc[m][0], 0, 0, 0); acc[m][1] = __builtin_amdgcn_mfma_f32_16x16x32_bf16(a[j][m], b[j][1], acc[m][1], 0, 0, 0); }
    }
    LAS float* red = (LAS float*)lds;
    __syncthreads();
#pragma unroll
    for (int m = 0; m < 4; ++m)
#pragma unroll
        for (int c = 0; c < 2; ++c)
#pragma unroll
            for (int i = 0; i < 4; ++i) red[(wave * 64 + 16 * m + 4 * fq + i) * 32 + 16 * c + fr] = acc[m][c][i];
    __syncthreads();
    { const int row = tid >> 3, c4 = 4 * (tid & 7); f32x4 s = *(const LAS f32x4*)(red + row * 32 + c4);
#pragma unroll
      for (int w = 1; w < 8; ++w) { const f32x4 t = *(const LAS f32x4*)(red + (w * 64 + row) * 32 + c4); s[0] += t[0]; s[1] += t[1]; s[2] += t[2]; s[3] += t[3]; }
      *(f32x4*)(psmall + (size_t)(rb * 64 + row) * 32 + c4) = s; }
    __syncthreads();
    }
}
__device__ __forceinline__ void unpack8(const u32x4 w, float* f) {
#pragma unroll
    for (int q = 0; q < 4; ++q) { f[2 * q] = pg8::bf_lo(w[q]); f[2 * q + 1] = pg8::bf_hi(w[q]); }
}
__device__ __forceinline__ void phase_prep(ArgP A, int l, LAS float* red, int gtid, int NGT, int gw, int NGW, int lane) {
    unsigned char* ws = A->ws;
    const bf16_t* P = (const bf16_t*)(ws + WS_P); const float* PS = (const float*)(ws + WS_PS); bf16_t* Y = (bf16_t*)(ws + WS_Y);
    { const float* cw = A->in[I_SC_CONV] + (size_t)l * 3 * 1024;
      for (int it = gtid; it < (M / 16) * 128; it += NGT) {
          const int c8 = (it & 127) * 8, slab = c8 >> 7, cc = c8 & 127, m0 = (it >> 7) * 16;
          const bf16_t* ph = P + ((size_t)(0 + slab) * M + m0) * 128 + cc; const bf16_t* pc = P + ((size_t)(8 + slab) * M + m0) * 128 + cc; const bf16_t* pb = P + ((size_t)(16 + slab) * M + m0) * 128 + cc;
          float w[3][8];
#pragma unroll
          for (int j = 0; j < 3; ++j) { const f32x4 wa = *(const f32x4*)(cw + j * 1024 + c8), wb = *(const f32x4*)(cw + j * 1024 + c8 + 4);
#pragma unroll
              for (int i = 0; i < 4; ++i) { w[j][i] = wa[i]; w[j][4 + i] = wb[i]; } }
          float p0[8], p1[8];
          u32x4 H[4], C[4], B[4], h0 = {0u, 0u, 0u, 0u}, c0 = h0, h1 = h0, c1 = h0;
          if ((m0 & (T - 1)) != 0) { h0 = *(const u32x4*)(ph - 256); c0 = *(const u32x4*)(pc - 256); h1 = *(const u32x4*)(ph - 128); c1 = *(const u32x4*)(pc - 128); }
#pragma unroll
          for (int r = 0; r < 4; ++r) { H[r] = *(const u32x4*)(ph + r * 128); C[r] = *(const u32x4*)(pc + r * 128); B[r] = *(const u32x4*)(pb + r * 128); }
          { float a[8], b[8]; unpack8(h0, a); unpack8(c0, b);
#pragma unroll
            for (int i = 0; i < 8; ++i) p0[i] = a[i] * b[i];
            unpack8(h1, a); unpack8(c1, b);
#pragma unroll
            for (int i = 0; i < 8; ++i) p1[i] = a[i] * b[i]; }
#pragma unroll
          for (int rb = 0; rb < 16; rb += 4) {
              u32x4 Hn[4], Cn[4], Bn[4];
              if (rb < 12) {
#pragma unroll
                  for (int r = 0; r < 4; ++r) { Hn[r] = *(const u32x4*)(ph + (rb + 4 + r) * 128); Cn[r] = *(const u32x4*)(pc + (rb + 4 + r) * 128); Bn[r] = *(const u32x4*)(pb + (rb + 4 + r) * 128); } }
#pragma unroll
              for (int r = 0; r < 4; ++r) { float a[8], b[8], bb[8], p2[8], o[8]; unpack8(H[r], a); unpack8(C[r], b); unpack8(B[r], bb);
#pragma unroll
                  for (int i = 0; i < 8; ++i) { p2[i] = a[i] * b[i]; o[i] = bb[i] * (w[0][i] * p0[i] + w[1][i] * p1[i] + w[2][i] * p2[i]); p0[i] = p1[i]; p1[i] = p2[i]; }
                  u32x4 wv; wv.x = pkbf(o[0], o[1]); wv.y = pkbf(o[2], o[3]); wv.z = pkbf(o[4], o[5]); wv.w = pkbf(o[6], o[7]);
                  *(u32x4*)(Y + (size_t)(m0 + rb + r) * DM + c8) = wv; }
              if (rb < 12) {
#pragma unroll
                  for (int r = 0; r < 4; ++r) { H[r] = Hn[r]; C[r] = Cn[r]; B[r] = Bn[r]; } }
          } } }
    { float* NRMP = (float*)(ws + WS_CTL) + CW_NRM + 32768 * l;
      LAS float* wmax = red - 32 - 256;
      float mx0 = 0.f, mx1 = 0.f;
      const bool h5 = (lane & 32) != 0, h4 = (lane & 16) != 0, h3 = (lane & 8) != 0, h2 = (lane & 4) != 0;
      const int myi = (h5 ? 8 : 0) + (h4 ? 4 : 0) + (h3 ? 2 : 0) + (h2 ? 1 : 0);
      for (int mb = gw; mb < M; mb += 4 * NGW) { unsigned raw[4][16];
#pragma unroll
        for (int k = 0; k < 4; ++k) { const int m = mb + k * NGW;
#pragma unroll
          for (int i = 0; i < 16; ++i) raw[k][i] = m < M ? *(const unsigned*)(P + ((size_t)(80 + i) * M + m) * 128 + 2 * lane) : 0u; }
#pragma unroll
        for (int k = 0; k < 4; ++k) { const int m = mb + k * NGW; float s[16];
#pragma unroll
          for (int i = 0; i < 16; ++i) { const unsigned w = raw[k][i]; const float x0 = pg8::bf_lo(w), x1 = pg8::bf_hi(w); s[i] = x0 * x0 + x1 * x1; }
          float v8[8], v4[4], v2[2];
#pragma unroll
          for (int i = 0; i < 8; ++i) v8[i] = (h5 ? s[i + 8] : s[i]) + shx(h5 ? s[i] : s[i + 8], 32, lane);
#pragma unroll
          for (int i = 0; i < 4; ++i) v4[i] = (h4 ? v8[i + 4] : v8[i]) + shx(h4 ? v8[i] : v8[i + 4], 16, lane);
#pragma unroll
          for (int i = 0; i < 2; ++i) v2[i] = (h3 ? v4[i + 2] : v4[i]) + shx(h3 ? v4[i] : v4[i + 2], 8, lane);
          float v1 = (h2 ? v2[1] : v2[0]) + shx(h2 ? v2[0] : v2[1], 4, lane);
          v1 += shx(v1, 2, lane); v1 += shx(v1, 1, lane);
          if (m < M) { if ((m >> 13) == 0) mx0 = fmaxf(mx0, v1); else mx1 = fmaxf(mx1, v1); } } }
      const int wave = gw & 7, bid = gw >> 3;
      if ((lane & 3) == 0) { wmax[wave * 32 + myi] = mx0; wmax[wave * 32 + 16 + myi] = mx1; }
      __syncthreads();
      if (wave == 0 && lane < 32) { float v = wmax[lane];
#pragma unroll
          for (int w2 = 1; w2 < 8; ++w2) v = fmaxf(v, wmax[w2 * 32 + lane]);
          NRMP[bid * 32 + lane] = v; }
      __syncthreads(); }
    { const float* fb = A->in[I_FOX_BIAS] + l * 8; float* CUM = (float*)(ws + WS_CUM);
      const int bid = gw >> 3, tid = gtid & 511, wave = gw & 7;
      if (bid < 16) { const int b = bid >> 3, h = bid & 7; const float bias = fb[h];
          const float* src = PS + (size_t)(b * T + tid * 16) * 32 + 16 + h;
          float v[16]; float tot = 0.f;
#pragma unroll
          for (int i = 0; i < 16; ++i) v[i] = src[(size_t)i * 32];
#pragma unroll
          for (int i = 0; i < 16; ++i) { const float x = v[i] + bias; tot += fminf(x, 0.f) - log1pf(expf(-fabsf(x))); v[i] = tot; }
          float incl = tot;
#pragma unroll
          for (int o = 1; o < 64; o <<= 1) { const float u = shup(incl, o, lane); if (lane >= o) incl += u; }
          if (lane == 63) red[wave] = incl;
          __syncthreads();
          float base = incl - tot;
          for (int w2 = 0; w2 < wave; ++w2) base += red[w2];
          float* dst = CUM + (size_t)bid * T + tid * 16;
#pragma unroll
          for (int q4 = 0; q4 < 4; ++q4) *(f32x4*)(dst + 4 * q4) = (f32x4){v[4 * q4] + base, v[4 * q4 + 1] + base, v[4 * q4 + 2] + base, v[4 * q4 + 3] + base};
          __syncthreads(); } }
}
typedef float f32x16 __attribute__((ext_vector_type(16)));
typedef __bf16 bf16x2n __attribute__((ext_vector_type(2)));
__device__ __forceinline__ unsigned pk_native(float lo, float hi) { const f32x2 v = {lo, hi}; return __builtin_bit_cast(unsigned, __builtin_convertvector(v, bf16x2n)); }
__device__ __forceinline__ bf16_t bf1(float x) { return (bf16_t)(pk_native(x, x) & 0xffffu); }
__device__ __forceinline__ float bf2f(bf16_t x) { return __uint_as_float(((unsigned)x) << 16); }
__device__ __forceinline__ int crow32(int r, int hh) { return (r & 3) + 8 * (r >> 2) + 4 * hh; }
constexpr int DP_KB = 0, DP_QB = 17408, DP_VF = 34816, DP_AM = 68608, DP_AQ = 84992, DP_WB = 94208, DP_GC = 111616;
constexpr int DP_RAWQ = 112640, DP_RAWK = DP_RAWQ + 17152, DP_RAWV = DP_AM;
static_assert(DP_RAWK + 17152 <= MISC_OFF && DP_AM + 17152 <= DP_WB, "raw tiles");
__device__ __forceinline__ void phase_dnprep(ArgP A, int l, LAS unsigned char* lds, int G, int bid, const int tid_in) {
    unsigned char* ws = A->ws;
    const bf16_t* P = (const bf16_t*)(ws + WS_P); const float* PS = (const float*)(ws + WS_PS);
    const float* cw = A->in[I_DN_CONV] + (size_t)l * 4 * 3072; const float* alog = A->in[I_DN_ALOG] + l * 8; const float* dtb = A->in[I_DN_DTB] + l * 8;
    float* DL = (float*)(ws + WS_DL);
    const int tid0 = tid_in;
    LAS bf16_t* KB = (LAS bf16_t*)(lds + DP_KB); LAS bf16_t* QB = (LAS bf16_t*)(lds + DP_QB); LAS float* VF = (LAS float*)(lds + DP_VF);
    LAS float* AM = (LAS float*)(lds + DP_AM); LAS bf16_t* AQ = (LAS bf16_t*)(lds + DP_AQ); LAS bf16_t* WB = (LAS bf16_t*)(lds + DP_WB); LAS float* GC = (LAS float*)(lds + DP_GC);
    for (int it = bid; it < 2048; it += G) {
        int tid = tid0; asm volatile("" : "+v"(tid));
        const int lane = tid & 63, wave = __builtin_amdgcn_readfirstlane(tid >> 6);
        const int bh = it >> 7, n = it & 127, b = bh >> 3, h = bh & 7, t0 = n * 64, m0 = b * T + t0;
        unsigned char* rec = ws + WS_DREC + (size_t)it * REC_BYTES;
        { int tid_s = tid0; asm volatile("" : "+v"(tid_s)); const int tid = tid_s, lane = tid_s & 63; (void)tid; (void)lane; const int tok = tid >> 3, part = tid & 7, c0 = 16 * part, t = t0 + tok, mrow = m0 + tok;
          float r[3][16];
          u32x4 raw[3][4][2];
#pragma unroll
          for (int s = 0; s < 3; ++s)
#pragma unroll
              for (int j = 0; j < 4; ++j) { const int dt = 3 - j; const bf16_t* xp = P + ((size_t)(48 + 8 * s + h) * M + (t >= dt ? mrow - dt : mrow)) * 128 + c0; raw[s][j][0] = *(const u32x4*)xp; raw[s][j][1] = *(const u32x4*)(xp + 8); }
#pragma unroll
          for (int s = 0; s < 3; ++s) {
#pragma unroll
              for (int i = 0; i < 16; ++i) r[s][i] = 0.f;
#pragma unroll
              for (int j = 0; j < 4; ++j) { const int dt = 3 - j;
                  if (t >= dt) { float xx[16]; unpack8(raw[s][j][0], xx); unpack8(raw[s][j][1], xx + 8);
                      const float* wp = cw + j * 3072 + s * 1024 + h * 128 + c0;
#pragma unroll
                      for (int q4 = 0; q4 < 4; ++q4) { const f32x4 wv = *(const f32x4*)(wp + 4 * q4);
#pragma unroll
                          for (int i = 0; i < 4; ++i) r[s][4 * q4 + i] += wv[i] * xx[4 * q4 + i]; } } }
#pragma unroll
              for (int i = 0; i < 16; ++i) r[s][i] = silu_f(r[s][i]);
          }
          float sq = 0.f, sk = 0.f;
#pragma unroll
          for (int i = 0; i < 16; ++i) { sq += r[0][i] * r[0][i]; sk += r[1][i] * r[1][i]; }
#pragma unroll
          for (int o = 1; o < 8; o <<= 1) { sq += shx(sq, o, lane); sk += shx(sk, o, lane); }
          const float rq = rsqrtf(sq + EPS) * 0.08838834764831845f, rk = rsqrtf(sk + EPS);
          u32x4 w0, w1;
#pragma unroll
          for (int i = 0; i < 4; ++i) { w0[i] = pk_native(r[0][2 * i] * rq, r[0][2 * i + 1] * rq); w1[i] = pk_native(r[0][8 + 2 * i] * rq, r[0][9 + 2 * i] * rq); }
          *(LAS u32x4*)(QB + tok * 136 + c0) = w0; *(LAS u32x4*)(QB + tok * 136 + c0 + 8) = w1;
#pragma unroll
          for (int i = 0; i < 4; ++i) { w0[i] = pk_native(r[1][2 * i] * rk, r[1][2 * i + 1] * rk); w1[i] = pk_native(r[1][8 + 2 * i] * rk, r[1][9 + 2 * i] * rk); }
          *(LAS u32x4*)(KB + tok * 136 + c0) = w0; *(LAS u32x4*)(KB + tok * 136 + c0 + 8) = w1;
#pragma unroll
          for (int q4 = 0; q4 < 4; ++q4) *(LAS f32x4*)(VF + tok * 132 + c0 + 4 * q4) = (f32x4){r[2][4 * q4], r[2][4 * q4 + 1], r[2][4 * q4 + 2], r[2][4 * q4 + 3]};
          if (part == 0) { const float a = PS[(size_t)mrow * 32 + h] + dtb[h], bi = PS[(size_t)mrow * 32 + 8 + h];
              GC[tok] = -expf(alog[h]) * (fmaxf(a, 0.f) + log1pf(expf(-fabsf(a)))); GC[64 + tok] = 1.0f / (1.0f + expf(-bi)); } }
        __syncthreads();
        if (wave == 0) { int tid_s = tid0; asm volatile("" : "+v"(tid_s)); const int tid = tid_s, lane = tid_s & 63; (void)tid; (void)lane; float inc = GC[lane];
#pragma unroll
            for (int o = 1; o < 64; o <<= 1) { const float u = shup(inc, o, lane); if (lane >= o) inc += u; }
            const float glast = shlane(inc, 63);
            GC[lane] = inc; GC[128 + lane] = __expf(inc); GC[192 + lane] = __expf(glast - inc);
            if (lane == 63) DL[it] = __expf(inc); }
        __syncthreads();
        if (wave < 6) { int tid_s = tid0; asm volatile("" : "+v"(tid_s)); const int tid = tid_s, lane = tid_s & 63; (void)tid; (void)lane; const int kind = wave >= 3 ? 1 : 0, tl = wave - 3 * kind, itile = tl ? 1 : 0, jtile = tl == 2 ? 1 : 0, c = lane & 31, hh = lane >> 5;
            const LAS bf16_t* XA = kind ? QB : KB;
            f32x16 d = {};
#pragma unroll
            for (int s = 0; s < 8; ++s) { const att::bf16x8 av = *(const LAS att::bf16x8*)(XA + (32 * itile + c) * 136 + 16 * s + 8 * hh), bv = *(const LAS att::bf16x8*)(KB + (32 * jtile + c) * 136 + 16 * s + 8 * hh);
                d = __builtin_amdgcn_mfma_f32_32x32x16_bf16(av, bv, d, 0, 0, 0); }
            const int j = 32 * jtile + c; const float gcj = GC[j];
#pragma unroll
            for (int r = 0; r < 16; ++r) { const int i = 32 * itile + crow32(r, hh); const float e = __expf(fminf(GC[i] - gcj, 0.f));
                if (kind == 0) AM[i * 64 + j] = (i > j) ? GC[64 + i] * d[r] * e : 0.f;
                else AQ[i * 72 + j] = bf1((i >= j) ? d[r] * e : 0.f); } }
        else if (wave == 6) { int tid_s = tid0; asm volatile("" : "+v"(tid_s)); const int tid = tid_s, lane = tid_s & 63; (void)tid; (void)lane; for (int q = lane; q < 1024; q += 64) AM[(q >> 5) * 64 + 32 + (q & 31)] = 0.f; }
        else { int tid_s = tid0; asm volatile("" : "+v"(tid_s)); const int tid = tid_s, lane = tid_s & 63; (void)tid; (void)lane; for (int q = lane; q < 1024; q += 64) AQ[(q >> 5) * 72 + 32 + (q & 31)] = 0; }
        __syncthreads();
        if (wave < 4) { int tid_s = tid0; asm volatile("" : "+v"(tid_s)); const int tid = tid_s, lane = tid_s & 63; (void)tid; (void)lane; const int cc = tid & 127; const bool isW = wave < 2;
            int vz = 0; asm volatile("" : "+v"(vz));
            const LAS float* AMv = AM + vz;
            float x[64];
            if (isW) {
#pragma unroll
                for (int i = 0; i < 64; ++i) x[i] = bf2f(KB[i * 136 + cc]) * (GC[64 + i] * GC[128 + i]); }
            else {
#pragma unroll
                for (int i = 0; i < 64; ++i) x[i] = VF[i * 132 + cc] * GC[64 + i]; }
            __builtin_amdgcn_sched_barrier(0);
#pragma unroll
            for (int i = 1; i < 64; ++i) {
                float s0 = x[i], s1 = 0.f, s2 = 0.f, s3 = 0.f;
#pragma unroll
                for (int j4 = 0; j4 < (i + 3) / 4; ++j4) { const f32x4 a = *(const LAS f32x4*)(AMv + i * 64 + 4 * j4);
                    s0 -= a[0] * x[4 * j4];
                    if (4 * j4 + 1 < i) s1 -= a[1] * x[4 * j4 + 1];
                    if (4 * j4 + 2 < i) s2 -= a[2] * x[4 * j4 + 2];
                    if (4 * j4 + 3 < i) s3 -= a[3] * x[4 * j4 + 3]; }
                x[i] = (s0 + s1) + (s2 + s3); if (i & 1) __builtin_amdgcn_sched_barrier(0); }
            if (isW) {
#pragma unroll
                for (int i = 0; i < 64; ++i) WB[i * 136 + cc] = bf1(-x[i]); }
            else {
#pragma unroll
                for (int i = 0; i < 64; ++i) VF[i * 132 + cc] = x[i]; } }
        else { int tid_s = tid0; asm volatile("" : "+v"(tid_s)); const int tid = tid_s, lane = tid_s & 63; (void)tid; (void)lane; const int lw = wave - 4, c = lane & 31, hh = lane >> 5;
            for (int q = 0; q < 10; ++q) { const int f = lw * 10 + q;
                if (f < 16) { const int mt = f >> 3, ks = f & 7, i = 32 * mt + c; const LAS bf16_t* rp = QB + i * 136 + 16 * ks + 4 * hh; const float e = GC[128 + i];
                    const u32x2 lo = *(const LAS u32x2*)rp, hi2 = *(const LAS u32x2*)(rp + 8);
                    u32x4 w; w.x = pk_native(pg8::bf_lo(lo.x) * e, pg8::bf_hi(lo.x) * e); w.y = pk_native(pg8::bf_lo(lo.y) * e, pg8::bf_hi(lo.y) * e);
                    w.z = pk_native(pg8::bf_lo(hi2.x) * e, pg8::bf_hi(hi2.x) * e); w.w = pk_native(pg8::bf_lo(hi2.y) * e, pg8::bf_hi(hi2.y) * e);
                    *(u32x4*)(rec + REC_QG + f * 1024 + lane * 16) = w; }
                else if (f < 32) { const int g2 = f - 16, mt = g2 >> 2, ks = g2 & 3; float v[8];
#pragma unroll
                    for (int jj = 0; jj < 8; ++jj) { const int row = 16 * ks + 8 * (jj >> 2) + 4 * hh + (jj & 3); v[jj] = bf2f(KB[row * 136 + 32 * mt + c]) * GC[192 + row]; }
                    u32x4 w; w.x = pk_native(v[0], v[1]); w.y = pk_native(v[2], v[3]); w.z = pk_native(v[4], v[5]); w.w = pk_native(v[6], v[7]);
                    *(u32x4*)(rec + REC_KD + g2 * 1024 + lane * 16) = w; }
                else { const int g2 = f - 32, mt = g2 >> 2, ks = g2 & 3; const LAS bf16_t* rp = AQ + (32 * mt + c) * 72 + 16 * ks + 4 * hh;
                    const u32x2 lo = *(const LAS u32x2*)rp, hi2 = *(const LAS u32x2*)(rp + 8);
                    *(u32x4*)(rec + REC_AQK + g2 * 1024 + lane * 16) = (u32x4){lo.x, lo.y, hi2.x, hi2.y}; } } }
        __syncthreads();
        { int tid_s = tid0; asm volatile("" : "+v"(tid_s)); const int tid = tid_s, lane = tid_s & 63; (void)tid; (void)lane; const int c = lane & 31, hh = lane >> 5;
#pragma unroll
          for (int q = 0; q < 2; ++q) { const int f = wave * 2 + q, mt = f >> 3, ks = f & 7; const LAS bf16_t* rp = WB + (32 * mt + c) * 136 + 16 * ks + 4 * hh;
              const u32x2 lo = *(const LAS u32x2*)rp, hi2 = *(const LAS u32x2*)(rp + 8);
              *(u32x4*)(rec + REC_W + f * 1024 + lane * 16) = (u32x4){lo.x, lo.y, hi2.x, hi2.y}; }
          float* U = (float*)(rec + REC_U);
#pragma unroll
          for (int q = 0; q < 4; ++q) { const int idx = tid + 512 * q, row = idx >> 5, c4 = (idx & 31) * 4; *(f32x4*)(U + row * 128 + c4) = *(const LAS f32x4*)(VF + row * 132 + c4); } }
        __syncthreads();
    }
}
__device__ __forceinline__ att::bf16x8 pack_half(const f32x16& x, const int s) {
    u32x4 p; p.x = pk_native(x[8 * s], x[8 * s + 1]); p.y = pk_native(x[8 * s + 2], x[8 * s + 3]); p.z = pk_native(x[8 * s + 4], x[8 * s + 5]); p.w = pk_native(x[8 * s + 6], x[8 * s + 7]);
    return __builtin_bit_cast(att::bf16x8, p);
}
#define DN_BAR() do { asm volatile("s_waitcnt lgkmcnt(0)" ::: "memory"); __builtin_amdgcn_s_barrier(); asm volatile("" ::: "memory"); } while (0)
__device__ __forceinline__ void phase_scan(unsigned char* ws, LAS unsigned char* lds, int bh, int tid) {
    const int lane = tid & 63, wave = __builtin_amdgcn_readfirstlane(tid >> 6);
    const unsigned char* rec0 = ws + WS_DREC + (size_t)bh * 128 * REC_BYTES;
    if (wave >= 4) {
        const int lw = wave - 4;
#pragma unroll
        for (int f = 0; f < 14; ++f) { const int fi = lw * 14 + f;
            __builtin_amdgcn_global_load_lds((const unsigned*)(rec0 + fi * 1024 + lane * 16), (LAS unsigned*)(lds + fi * 1024), 16, 0, 0); }
        asm volatile("s_waitcnt vmcnt(0)" ::: "memory"); DN_BAR();
        for (int n = 0; n < 128; ++n) {
            if (n + 1 < 128) { const unsigned char* rn = rec0 + (size_t)(n + 1) * REC_BYTES; LAS unsigned char* bn = lds + ((n + 1) & 1) * REC_DMA;
#pragma unroll
                for (int f = 0; f < 14; ++f) { const int fi = lw * 14 + f;
                    __builtin_amdgcn_global_load_lds((const unsigned*)(rn + fi * 1024 + lane * 16), (LAS unsigned*)(bn + fi * 1024), 16, 0, 0); } }
            asm volatile("s_waitcnt vmcnt(0)" ::: "memory"); DN_BAR();
        }
    } else {
        const int w = wave, c = lane & 31, hh = lane >> 5, b = bh >> 3, h = bh & 7;
        f32x16 st[4] = {}; f32x16 vn[2];
        { const float* U0 = (const float*)(rec0 + REC_U);
#pragma unroll
          for (int mt = 0; mt < 2; ++mt)
#pragma unroll
              for (int r = 0; r < 16; ++r) vn[mt][r] = U0[(32 * mt + crow32(r, hh)) * 128 + 32 * w + c]; }
        float* DO = (float*)(ws + WS_DO); const float* DL = (const float*)(ws + WS_DL) + bh * 128;
        DN_BAR();
        for (int n = 0; n < 128; ++n) {
            const LAS unsigned char* buf = lds + (n & 1) * REC_DMA + lane * 16;
            const float dl = DL[n];
            att::bf16x8 sb[8];
#pragma unroll
            for (int ks = 0; ks < 8; ++ks) sb[ks] = pack_half(st[ks >> 1], ks & 1);
            f32x16 o[2] = {};
#pragma unroll
            for (int ks = 0; ks < 8; ++ks)
#pragma unroll
                for (int mt = 0; mt < 2; ++mt) {
                    const att::bf16x8 aw = *(const LAS att::bf16x8*)(buf + REC_W + (mt * 8 + ks) * 1024), aq = *(const LAS att::bf16x8*)(buf + REC_QG + (mt * 8 + ks) * 1024);
                    vn[mt] = __builtin_amdgcn_mfma_f32_32x32x16_bf16(aw, sb[ks], vn[mt], 0, 0, 0);
                    o[mt] = __builtin_amdgcn_mfma_f32_32x32x16_bf16(aq, sb[ks], o[mt], 0, 0, 0); }
            att::bf16x8 vb[4];
#pragma unroll
            for (int k4 = 0; k4 < 4; ++k4) vb[k4] = pack_half(vn[k4 >> 1], k4 & 1);
            if (n + 1 < 128) { const float* Un = (const float*)(rec0 + (size_t)(n + 1) * REC_BYTES + REC_U);
#pragma unroll
                for (int mt = 0; mt < 2; ++mt)
#pragma unroll
                    for (int r = 0; r < 16; ++r) vn[mt][r] = Un[(32 * mt + crow32(r, hh)) * 128 + 32 * w + c]; }
#pragma unroll
            for (int k4 = 0; k4 < 4; ++k4)
#pragma unroll
                for (int mt = 0; mt < 2; ++mt) { const att::bf16x8 aa = *(const LAS att::bf16x8*)(buf + REC_AQK + (mt * 4 + k4) * 1024);
                    o[mt] = __builtin_amdgcn_mfma_f32_32x32x16_bf16(aa, vb[k4], o[mt], 0, 0, 0); }
#pragma unroll
            for (int ti = 0; ti < 4; ++ti) { st[ti] = st[ti] * dl;
#pragma unroll
                for (int k4 = 0; k4 < 4; ++k4) { const att::bf16x8 ak = *(const LAS att::bf16x8*)(buf + REC_KD + (ti * 4 + k4) * 1024);
                    st[ti] = __builtin_amdgcn_mfma_f32_32x32x16_bf16(ak, vb[k4], st[ti], 0, 0, 0); } }
#pragma unroll
            for (int mt = 0; mt < 2; ++mt)
#pragma unroll
                for (int r = 0; r < 16; ++r) DO[((size_t)(b * T + 64 * n + 32 * mt + crow32(r, hh)) * 8 + h) * 128 + 32 * w + c] = o[mt][r];
            DN_BAR();
        }
    }
}
constexpr int Q_ITEMS = 64, Q_N = 8;
__device__ __forceinline__ att::Ref2 attn_ref2(unsigned char* ws, int qx, int L) {
    const int sr = L >> 1, mm = L & 1, b = qx >> 2, h = qx & 3, qb = 31 - sr;
    const bf16_t* P = (const bf16_t*)(ws + WS_P);
    att::Ref2 R;
    R.Q = P + ((size_t)(24 + 2 * h + mm) * M + (size_t)b * T + (size_t)qb * 256) * 128;
    R.K = P + ((size_t)(32 + 2 * h + mm) * M + (size_t)b * T) * 128;
    R.V0 = P + ((size_t)(40 + 2 * h) * M + (size_t)b * T) * 128; R.V1 = P + ((size_t)(41 + 2 * h) * M + (size_t)b * T) * 128;
    R.O0 = (float*)(ws + WS_OB) + ((size_t)(4 * h + 2 * mm) * M + (size_t)b * T + (size_t)qb * 256) * 128;
    R.O1 = (float*)(ws + WS_OB) + ((size_t)(4 * h + 2 * mm + 1) * M + (size_t)b * T + (size_t)qb * 256) * 128;
    R.P0 = qb * 256;
    return R;
}
__device__ __forceinline__ att::BlockRef attn_ref(unsigned char* ws, const volatile LAS float* nrm, int qx, int L, int lane) {
    const int sr = L >> 1, ci = L & 1, b = qx >> 2, qb = 31 - sr;
    const int vh = 16 + 2 * (qx & 3) + ci;
    const int h = vh - 16; const int sq = 80 + h, sk = 88 + h, sv = 96 + h; const float* cum = (const float*)(ws + WS_CUM) + (size_t)(b * 8 + h) * T;
    const bf16_t* P = (const bf16_t*)(ws + WS_P);
    att::BlockRef R;
    R.Q = P + ((size_t)sq * M + (size_t)b * T + (size_t)qb * 256) * 128;
    R.K = P + ((size_t)sk * M + (size_t)b * T) * 128;
    R.V = P + ((size_t)sv * M + (size_t)b * T) * 128;
    R.O = (float*)(ws + WS_OB) + ((size_t)vh * M + (size_t)b * T + (size_t)qb * 256) * 128;
    R.cum = cum; R.P0 = qb * 256; R.jlo = 0;
    if (qb > 0) {
        const float q2 = nrm[(qx >> 2) * 16 + (vh - 16)], k2 = nrm[(qx >> 2) * 16 + 8 + (vh - 16)];
        const float thresh = 2.0f * sqrtf(q2 * k2) * att::SCALE + 70.0f, c0 = cum[R.P0];
        const int ntp = 4 * qb;
        const bool s0 = lane < ntp && (cum[64 * lane + 63] - c0 >= thresh), s1 = lane + 64 < ntp && (cum[64 * (lane + 64) + 63] - c0 >= thresh);
        const unsigned long long b0 = __ballot(s0), b1 = __ballot(s1);
        int j = b0 == ~0ull ? 64 + (b1 == ~0ull ? 64 : __builtin_ctzll(~b1)) : __builtin_ctzll(~b0);
        R.jlo = __builtin_amdgcn_readfirstlane(j < ntp ? j : ntp);
    }
    return R;
}
__device__ __forceinline__ int queue_pop(unsigned* heads, int x0, int& k0, int& qx, volatile LAS unsigned* slot, int tid) {
    if (tid == 0) { int k = k0, v = -1;
        for (; k < Q_N; ++k) { const unsigned got = __hip_atomic_fetch_add(heads + 64 * ((x0 + k) & (Q_N - 1)), 1u, __ATOMIC_RELAXED, __HIP_MEMORY_SCOPE_AGENT); if (got < (unsigned)Q_ITEMS) { v = (int)got; break; } }
        slot[0] = (unsigned)v; slot[1] = (unsigned)k; }
    __syncthreads();
    const int v = __builtin_amdgcn_readfirstlane((int)slot[0]); k0 = __builtin_amdgcn_readfirstlane((int)slot[1]); qx = (x0 + k0) & (Q_N - 1);
    __syncthreads();
    return v;
}
__device__ __forceinline__ void phase_mix(ArgP A, unsigned char* ws, unsigned char* lds, int qid, int bid, const int tid) {
    const int lane = tid & 63;
    volatile LAS float* nrm = (volatile LAS float*)((LAS unsigned char*)lds + MISC_OFF + 256);
    { const float* NRMP = (const float*)(ws + WS_CTL) + CW_NRM + 32768 * (qid >> 1); volatile LAS float* part = (volatile LAS float*)((LAS unsigned char*)lds + MISC_OFF - 2048);
      const int G = gridDim.x; float v = 0.f;
      for (int b2 = tid >> 5; b2 < G; b2 += 16) v = fmaxf(v, NRMP[b2 * 32 + (tid & 31)]);
      part[tid] = v;
      __syncthreads();
      if (tid < 32) { float r = part[tid];
#pragma unroll
          for (int k = 1; k < 16; ++k) r = fmaxf(r, part[k * 32 + tid]);
          nrm[tid] = r; }
      __syncthreads(); }
    if (bid < 16) { phase_scan(ws, (LAS unsigned char*)lds, bid, tid); __syncthreads(); }
    unsigned* heads = (unsigned*)(ws + WS_CTL) + CW_Q + 1024 * qid;
    volatile LAS unsigned* slot = (volatile LAS unsigned*)((LAS unsigned char*)lds + MISC_OFF) + 16;
    const int x0 = (int)(xb_xcc_id() & 7u);
    int k0 = 0, qx = 0;
    const int csel = (qid >> 1) == 0 ? 1 : 2; unsigned* chead = (unsigned*)(ws + WS_CTL) + CW_CV + 64 * qid;
    if (bid & 1) conv_burst(A, csel, chead, (LAS unsigned char*)lds, tid, 2);
    { int tv = tid; asm volatile("" : "+v"(tv));
      for (;;) { const int L = queue_pop(heads, x0, k0, qx, slot, tv); if (L < 0) break;
          const att::Ref2 R = attn_ref2(ws, qx, L); att::attn2_item(R, (char*)lds, tv);
          conv_burst(A, csel, chead, (LAS unsigned char*)lds, tv, 1); } }
    { int tv = tid; asm volatile("" : "+v"(tv)); const int lane2 = tv & 63; int k1 = 0;
      for (;;) { const int L = queue_pop(heads + 8 * 64, x0, k1, qx, slot, tv); if (L < 0) break;
          const att::BlockRef cur = attn_ref(ws, nrm, qx, L, lane2); att::Seam S; att::attn_prime(cur, (char*)lds, S, tv); att::attn_block(cur, cur, (char*)lds, S, tv);
          conv_burst(A, csel, chead, (LAS unsigned char*)lds, tv, 1); } }
    conv_burst(A, csel, chead, (LAS unsigned char*)lds, tid, 1 << 30);
}
__device__ __forceinline__ void phase_post(ArgP A, int l, int gw, int NGW, int lane) {
    unsigned char* ws = A->ws;
    const float* OB = (const float*)(ws + WS_OB); const float* DO = (const float*)(ws + WS_DO); const bf16_t* P = (const bf16_t*)(ws + WS_P); bf16_t* Y = (bf16_t*)(ws + WS_Y);
    const float lam_init = 0.8f - 0.6f * expf(-0.3f * (float)l);
    float lam;
    { const float* q1 = A->in[I_LQ1] + l * 128; const float* k1 = A->in[I_LK1] + l * 128; const float* q2 = A->in[I_LQ2] + l * 128; const float* k2 = A->in[I_LK2] + l * 128;
      const float d1 = wave_sum(q1[lane] * k1[lane] + q1[lane + 64] * k1[lane + 64], lane), d2 = wave_sum(q2[lane] * k2[lane] + q2[lane + 64] * k2[lane + 64], lane);
      lam = expf(d1) - expf(d2) + lam_init; }
    const float* dng = A->in[I_DIFF_NORM] + l * 256; const f32x4 gd = *(const f32x4*)(dng + 4 * lane);
    const float* nng = A->in[I_DN_NORM] + l * 128; const f32x2 gn = *(const f32x2*)(nng + 2 * lane);
    const float post = 1.0f - lam_init;
    const int eh = lane >> 5, ec = (4 * lane) & 127;
    for (int m = gw; m < M; m += NGW) {
        f32x4 o1[4], o2[4]; f32x2 od[8]; unsigned zz[8]; f32x2 of[8];
#pragma unroll
        for (int h = 0; h < 4; ++h) { o1[h] = *(const f32x4*)(OB + ((size_t)(4 * h + 0 + eh) * M + m) * 128 + ec); o2[h] = *(const f32x4*)(OB + ((size_t)(4 * h + 2 + eh) * M + m) * 128 + ec); }
#pragma unroll
        for (int h = 0; h < 8; ++h) { od[h] = *(const f32x2*)(DO + ((size_t)m * 8 + h) * 128 + 2 * lane); zz[h] = *(const unsigned*)(P + ((size_t)(72 + h) * M + m) * 128 + 2 * lane);
            of[h] = *(const f32x2*)(OB + ((size_t)(16 + h) * M + m) * 128 + 2 * lane); }
        bf16_t* yr = Y + (size_t)m * DM;
        float sd[4], sn[8];
#pragma unroll
        for (int h = 0; h < 4; ++h) { o1[h] = o1[h] - lam * o2[h]; sd[h] = (o1[h][0] * o1[h][0] + o1[h][1] * o1[h][1]) + (o1[h][2] * o1[h][2] + o1[h][3] * o1[h][3]); }
#pragma unroll
        for (int h = 0; h < 8; ++h) sn[h] = od[h][0] * od[h][0] + od[h][1] * od[h][1];
#pragma unroll
        for (int o = 1; o < 64; o <<= 1) {
#pragma unroll
            for (int h = 0; h < 4; ++h) sd[h] += shx(sd[h], o, lane);
#pragma unroll
            for (int h = 0; h < 8; ++h) sn[h] += shx(sn[h], o, lane); }
#pragma unroll
        for (int h = 0; h < 4; ++h) { const float rs = rsqrtf(sd[h] * (1.0f / 256.0f) + EPS) * post;
            u32x2 w; w.x = pkbf(o1[h][0] * rs * gd[0], o1[h][1] * rs * gd[1]); w.y = pkbf(o1[h][2] * rs * gd[2], o1[h][3] * rs * gd[3]);
            *(u32x2*)(yr + 1024 + h * 256 + 4 * lane) = w; }
#pragma unroll
        for (int h = 0; h < 8; ++h) { const float rs = rsqrtf(sn[h] * (1.0f / 128.0f) + EPS); const float z0 = pg8::bf_lo(zz[h]), z1 = pg8::bf_hi(zz[h]);
            *(unsigned*)(yr + 2048 + h * 128 + 2 * lane) = pkbf(od[h][0] * rs * gn[0] * silu_f(z0), od[h][1] * rs * gn[1] * silu_f(z1));
            *(unsigned*)(yr + 3072 + h * 128 + 2 * lane) = pkbf(of[h][0], of[h][1]); }
    }
}

constexpr int PH_PER_LAYER = 10, PH_FINAL = NLAYER * PH_PER_LAYER, PH_TOTAL = PH_FINAL + 1;
__global__ void __launch_bounds__(NWAVES * 64, 2) mega(Args args) {
    extern __shared__ __attribute__((aligned(16))) unsigned char lds[];
    LAS unsigned char* ldsl = (LAS unsigned char*)lds;
    const int G = gridDim.x, bid = blockIdx.x;
    const int NGW = G * NWAVES, NGT = G * NWAVES * 64;
    volatile LAS unsigned* MISC = (volatile LAS unsigned*)(ldsl + MISC_OFF);
    if (threadIdx.x < 32) MISC[threadIdx.x] = 0u;
    const int wv0 = __builtin_amdgcn_readfirstlane(threadIdx.x >> 6);
    __syncthreads();
    const int lo = args.ph_lo, hi = args.ph_hi;
    XcdBarrier bar; bar.bar = (unsigned*)(args.ws + WS_CTL) + CW_BAR; bar.x = 0; bar.st = nullptr;
    if (hi - lo > 1) bar = xcd_barrier_post((unsigned*)(args.ws + WS_CTL) + CW_BAR, MISC + 8);
#ifndef ONLY_J
#define ONLY_J -1
#endif
#define IN(k) (lo <= (k) && (k) < hi)
#define INJ(j) ((ONLY_J < 0 || ONLY_J == (j)) && IN(pb + (j)))
#define SEAM(k) do { if (IN(k) && IN((k) + 1)) xcd_barrier(bar); } while (0)
#ifndef DUP_SITE
#define DUP_SITE -1
#endif
#define NREP(j) ((DUP_SITE == (j)) ? 2 : 1)
#define SITE() ArgP A = (ArgP)__builtin_amdgcn_kernarg_segment_ptr(); asm volatile("" : "+s"(A)); unsigned char* ws = A->ws; int tid; asm volatile("v_mbcnt_lo_u32_b32 %0, -1, 0\n\tv_mbcnt_hi_u32_b32 %0, -1, %0" : "=v"(tid)); tid += wv0 * 64; \
    const int lane = tid & 63, wave = __builtin_amdgcn_readfirstlane(tid >> 6), gw = bid * NWAVES + wave, gtid = bid * (NWAVES * 64) + tid; (void)lane; (void)wave; (void)gw; (void)gtid; (void)ws
    for (int l = 0; l < NLAYER; ++l) {
        const int pb = l * PH_PER_LAYER;
        for (int rep = 0; rep < NREP(0); ++rep) { if (rep) xcd_barrier(bar);
        if (INJ(0)) { SITE(); if (l == 0) phase_convert(A, ldsl, gw, NGW, wave, lane); if (l == 0) phase_norm(A->in[I_X], A->in[I_ATTN_NORM], (bf16_t*)(ws + WS_H), gw, NGW, lane); else phase_norm_b((const bf16_t*)(ws + WS_XB), A->in[I_ATTN_NORM] + DM, (bf16_t*)(ws + WS_H), gw, NGW, lane); }
        }
        SEAM(pb + 0);
        for (int rep = 0; rep < NREP(1); ++rep) { if (rep) xcd_barrier(bar);
        if (INJ(1)) { SITE(); pg8::Gemm g{(const bf16_t*)(ws + WS_H), (const bf16_t*)(ws + WS_WIN), M, 13312, DM}; pg8::StaticOrder S; S.init(M, 13312, G, bid);
            pg8::EpiSlab E{(bf16_t*)(ws + WS_P), (float*)(ws + WS_PS)};
            pg8::gemm_phase<pg8::EpiSlab, pg8::StaticOrder, true, true>(ldsl, g, S, E, tid);
            small_gemm((const bf16_t*)(ws + WS_H), (const bf16_t*)(ws + WS_WIN), (float*)(ws + WS_PS), ldsl, bid, tid); }
        }
        SEAM(pb + 1);
        for (int rep = 0; rep < NREP(2); ++rep) { if (rep) xcd_barrier(bar);
        if (INJ(2)) { SITE(); phase_prep(A, l, (LAS float*)(ldsl + MISC_OFF + 128), gtid, NGT, gw, NGW, lane); phase_dnprep(A, l, ldsl, G, bid, tid); }
        }
        SEAM(pb + 2);
        for (int rep = 0; rep < NREP(3); ++rep) { if (rep) xcd_barrier(bar);
        if (INJ(3)) { SITE(); phase_mix(A, ws, lds, 2 * l + rep, bid, tid); }
        }
        SEAM(pb + 3);
        for (int rep = 0; rep < NREP(4); ++rep) { if (rep) xcd_barrier(bar);
        if (INJ(4)) { SITE(); phase_post(A, l, gw, NGW, lane); }
        }
        SEAM(pb + 4);
        if (INJ(5)) { SITE(); pg8::Gemm g{(const bf16_t*)(ws + WS_Y), (const bf16_t*)(ws + WS_WOUT), M, DM, DM}; pg8::StaticOrder S; S.init(M, DM, G, bid);
            if (l == 0) { pg8::EpiResidB<true> E{(const void*)A->in[I_X], (bf16_t*)(ws + WS_XB)}; pg8::gemm_phase<pg8::EpiResidB<true>, pg8::StaticOrder, true, true>(ldsl, g, S, E, tid); }
            else { pg8::EpiResidB<false> E{(const void*)(ws + WS_XB), (bf16_t*)(ws + WS_XB)}; pg8::gemm_phase<pg8::EpiResidB<false>, pg8::StaticOrder, true, true>(ldsl, g, S, E, tid); } }
        SEAM(pb + 5);
        for (int rep = 0; rep < NREP(6); ++rep) { if (rep) xcd_barrier(bar);
        if (INJ(6)) { SITE(); phase_norm_b((const bf16_t*)(ws + WS_XB), A->in[I_FFN_NORM] + (size_t)l * DM, (bf16_t*)(ws + WS_H), gw, NGW, lane); }
        }
        SEAM(pb + 6);
        for (int rep = 0; rep < NREP(7); ++rep) { if (rep) xcd_barrier(bar);
        if (INJ(7)) { SITE(); pg8::Gemm g{(const bf16_t*)(ws + WS_H), (const bf16_t*)(ws + WS_WG), M, DFF, DM}; pg8::StaticOrder S; S.init(M, DFF, G, bid);
            pg8::EpiPlain E{(bf16_t*)(ws + WS_P), DFF};
            pg8::gemm_phase<pg8::EpiPlain, pg8::StaticOrder, true, true>(ldsl, g, S, E, tid); }
        }
        SEAM(pb + 7);
        for (int rep = 0; rep < NREP(8); ++rep) { if (rep) xcd_barrier(bar);
        if (INJ(8)) { SITE(); pg8::Gemm g{(const bf16_t*)(ws + WS_H), (const bf16_t*)(ws + WS_WU), M, DFF, DM}; pg8::RevOrder S; S.init(M, DFF, G, bid);
            pg8::EpiAct E{(const bf16_t*)(ws + WS_P), A->in[I_FFN_CONV] + (size_t)l * 3 * DFF, (bf16_t*)(ws + WS_X)};
            pg8::gemm_phase<pg8::EpiAct, pg8::RevOrder, true, true>(ldsl, g, S, E, tid); }
        }
        SEAM(pb + 8);
        if (INJ(9)) { SITE(); pg8::Gemm g{(const bf16_t*)(ws + WS_X), (const bf16_t*)(ws + WS_WD), M, DM, DFF}; pg8::StaticOrder S; S.init(M, DM, G, bid, 2);
            pg8::EpiResidB<false> E{(const void*)(ws + WS_XB), (bf16_t*)(ws + WS_XB)};
            pg8::gemm_phase<pg8::EpiResidB<false>, pg8::StaticOrder, true, true>(ldsl, g, S, E, tid); }
        SEAM(pb + 9);
    }
    if ((ONLY_J < 0 || ONLY_J == 10) && IN(PH_FINAL)) { SITE(); phase_final_norm_b((const bf16_t*)(ws + WS_XB), A->out, A->in[I_FINAL_NORM], gw, NGW, lane); }
#undef IN
#undef INJ
#undef SEAM
#undef SITE
}

extern "C" void kernel_launch(void* const* d_in, const int* in_sizes, int n_in, void* d_out, int out_size, void* d_ws, size_t ws_size, hipStream_t stream) {
    static int grid = 0;
    if (grid == 0) {
        if (n_in != 21 || out_size != M * DM || ws_size < WS_END) { fprintf(stderr, "kernel_launch: unexpected arguments (n_in %d, out %d, ws %zu, need %zu)\n", n_in, out_size, ws_size, (size_t)WS_END); grid = -1; return; }
        int dev = 0, cus = 0, per_cu = 0;
        if (hipGetDevice(&dev) != hipSuccess || hipDeviceGetAttribute(&cus, hipDeviceAttributeMultiprocessorCount, dev) != hipSuccess) { grid = -1; return; }
        if (hipFuncSetAttribute((const void*)mega, hipFuncAttributeMaxDynamicSharedMemorySize, LDS_BYTES) != hipSuccess) { fprintf(stderr, "kernel_launch: hipFuncSetAttribute failed\n"); grid = -1; return; }
        if (hipOccupancyMaxActiveBlocksPerMultiprocessor(&per_cu, (const void*)mega, NWAVES * 64, LDS_BYTES) != hipSuccess || per_cu < 1) fprintf(stderr, "kernel_launch: occupancy query reports %d\n", per_cu);
        (void)hipGetLastError();
        grid = cus;
    }
    if (grid < 0) return;
    (void)hipMemsetAsync((char*)d_ws + WS_CTL, 0, CTL_ZERO_BYTES, stream);
    Args a{};
    for (int i = 0; i < 21; ++i) a.in[i] = (const float*)d_in[i];
    a.out = (float*)d_out; a.ws = (unsigned char*)d_ws;
#ifndef N_CUT
#define N_CUT 1
#endif
#if N_CUT == 0
    for (int p = 0; p < PH_TOTAL; ++p) { a.ph_lo = p; a.ph_hi = p + 1; hipLaunchKernelGGL(mega, dim3(grid), dim3(NWAVES * 64), LDS_BYTES, stream, a); }
#else
    a.ph_lo = 0; a.ph_hi = PH_TOTAL; hipLaunchKernelGGL(mega, dim3(grid), dim3(NWAVES * 64), LDS_BYTES, stream, a);
#endif
}
```
